# Optimizing an MI355X kernel written in HIP

```python
import jax
import jax.numpy as jnp
from jax import lax
import numpy as np

D_MODEL = 2048
BATCH = 4
SEQ = 2048
DEPTH = 2

GRID_W = 64
CTX_LEN = 256

NA_HEADS = 16
NA_HEAD_DIM = 64
NA_WIN_R_MAX = 8
NA_WIN_C = 16
NA_W = NA_HEADS * NA_HEAD_DIM

GLA_HEADS = 4
GLA_DK = 128
GLA_DV = 256
GLA_QK = GLA_HEADS * GLA_DK
GLA_V = GLA_HEADS * GLA_DV
GLA_GATE_RANK = 16
GLA_GATE_TAU = 16.0
GLA_CHUNK = 64

RW_HEADS = 16
RW_HEAD = 64
RW_W = RW_HEADS * RW_HEAD
RW_DECAY_RANK = 96
RW_A_RANK = 96
RW_GATE_RANK = 256
RW_SPLITS = (RW_W, RW_W, RW_W, 2 * RW_DECAY_RANK, 2 * RW_A_RANK, RW_GATE_RANK)
RW_IN = sum(RW_SPLITS)
RW_GN_EPS = 64e-5

N_BRANCH = 3
BRANCH_W = 1024
IN_SPLITS = (NA_W, NA_W, NA_W, GLA_QK, GLA_QK, GLA_V, GLA_V, 2 * GLA_GATE_RANK, RW_IN, N_BRANCH * D_MODEL)
D_IN = sum(IN_SPLITS)

N_EXPERTS = 16
N_GROUPS = 4
EXPERTS_PER_GROUP = N_EXPERTS // N_GROUPS
TOP_K = 2
D_EXPERT = 512

ROPE_BASE = 10000.0
EPS = 1e-6
F32 = jnp.float32

kernel_name = 'hybrid_na_gla_rwkv7_grouped_moe_dit'


def split_at(z, sizes):
    return jnp.split(z, np.cumsum(sizes)[:-1].tolist(), axis=-1)


def rms_norm(x, g):
    xf = x.astype(F32)
    y = xf * lax.rsqrt(jnp.mean(xf * xf, axis=-1, keepdims=True) + EPS)
    return (y * g.astype(F32)).astype(x.dtype)


def axial_angles(pos, dim):
    inv = ROPE_BASE ** (-jnp.arange(0, dim, 2, dtype=F32) / dim)
    ang = pos.astype(F32)[:, None] * inv[None, :]
    return jnp.cos(ang), jnp.sin(ang)


def rotate_half(x, cos, sin):
    x1, x2 = jnp.split(x, 2, axis=-1)
    cos = cos[None, :, None, :]
    sin = sin[None, :, None, :]
    return jnp.concatenate([x1 * cos - x2 * sin, x1 * sin + x2 * cos], axis=-1)


def rope_2d(x, rows, cols):
    half = x.shape[-1] // 2
    xr, xc = jnp.split(x.astype(F32), 2, axis=-1)
    xr = rotate_half(xr, *axial_angles(rows, half))
    xc = rotate_half(xc, *axial_angles(cols, half))
    return jnp.concatenate([xr, xc], axis=-1).astype(x.dtype)


def flip(t):
    return jnp.flip(t, axis=1)


def na_mixer(zl, zc, q_norm, k_norm, rpb, with_ctx):
    B, S, _ = zl[0].shape
    scale = NA_HEAD_DIM ** -0.5

    def heads(t):
        return t.reshape(t.shape[0], t.shape[1], NA_HEADS, NA_HEAD_DIM)

    ql = rms_norm(heads(zl[0]), q_norm) * scale
    kl = rms_norm(heads(zl[1]), k_norm)
    vl = heads(zl[2])
    qc = rms_norm(heads(zc[0]), q_norm) * scale
    kc = rms_norm(heads(zc[1]), k_norm)
    vc = heads(zc[2])

    n_rows = S // GRID_W
    win_r = min(NA_WIN_R_MAX, n_rows)
    n_loc = win_r * NA_WIN_C

    def grid(t):
        return t.reshape(B, n_rows, GRID_W, NA_HEADS, NA_HEAD_DIM)

    qg, kg, vg = grid(ql), grid(kl), grid(vl)
    col = np.arange(GRID_W)
    col_start = np.clip(col - NA_WIN_C // 2, 0, GRID_W - NA_WIN_C)
    col_idx = col_start[:, None] + np.arange(NA_WIN_C)[None, :]
    dc_idx = col_idx - col[:, None] + NA_WIN_C - 1
    rpb_c = rpb[:, :, dc_idx]

    def row_block(r):
        rs = jnp.clip(r - win_r // 2, 0, n_rows - win_r)
        q_r = lax.dynamic_index_in_dim(qg, r, axis=1, keepdims=False)
        k_win = lax.dynamic_slice_in_dim(kg, rs, win_r, axis=1)[:, :, col_idx]
        v_win = lax.dynamic_slice_in_dim(vg, rs, win_r, axis=1)[:, :, col_idx]
        dr_idx = rs + jnp.arange(win_r) - r + NA_WIN_R_MAX - 1
        bias = jnp.take(rpb_c, dr_idx, axis=1).transpose(0, 2, 1, 3)
        s_loc = jnp.einsum('bqhd,bnqjhd->bhqnj', q_r, k_win).astype(F32) + bias.astype(F32)[None]
        s_ctx = jnp.einsum('bqhd,blhd->bhql', q_r, kc).astype(F32)
        scores = jnp.concatenate([s_loc.reshape(B, NA_HEADS, GRID_W, n_loc), s_ctx], axis=-1)
        p = jax.nn.softmax(scores, axis=-1).astype(vl.dtype)
        p_loc = p[..., :n_loc].reshape(B, NA_HEADS, GRID_W, win_r, NA_WIN_C)
        return (jnp.einsum('bhqnj,bnqjhd->bqhd', p_loc, v_win)
                + jnp.einsum('bhql,blhd->bqhd', p[..., n_loc:], vc))

    o = lax.map(row_block, jnp.arange(n_rows))
    y = o.transpose(1, 0, 2, 3, 4).reshape(B, S, NA_W)
    yc = None
    if with_ctx:
        pc = jax.nn.softmax(jnp.einsum('bqhd,blhd->bhql', qc, kc).astype(F32), axis=-1).astype(vc.dtype)
        yc = jnp.einsum('bhql,blhd->bqhd', pc, vc).reshape(B, -1, NA_W)
    return y, yc


def gla_scan(q, k, v, log_a, s0):
    q, k, v, log_a = (t.astype(F32) for t in (q, k, v, log_a))
    B, T, H, dk = q.shape
    dv = v.shape[-1]
    C = GLA_CHUNK
    N = T // C

    def chunks(t):
        return t.reshape(B, N, C, H, t.shape[-1])

    q, k, v, log_a = chunks(q), chunks(k), chunks(v), chunks(log_a)
    b = jnp.cumsum(log_a, axis=2)
    b_last = b[:, :, -1:]
    b_ref = b[:, :, C // 2:C // 2 + 1]
    qi = q * jnp.exp(b - b_ref)
    kj = k * jnp.exp(b_ref - b)
    att = jnp.einsum('bnihd,bnjhd->bnhij', qi, kj)
    att = jnp.where(jnp.tril(jnp.ones((C, C), dtype=bool)), att, 0.0)
    y = jnp.einsum('bnhij,bnjhv->bnihv', att, v)
    kv = jnp.einsum('bnjhd,bnjhv->bnhdv', k * jnp.exp(b_last - b), v)
    decay = jnp.exp(b_last[:, :, 0])

    def step(s, inp):
        dec, kv_n = inp
        return dec[..., None] * s + kv_n, s

    s_fin, s_prev = lax.scan(step, s0, (jnp.moveaxis(decay, 1, 0), jnp.moveaxis(kv, 1, 0)))
    s_prev = jnp.moveaxis(s_prev, 0, 1)
    y = y + jnp.einsum('bnihd,bnhdv->bnihv', q * jnp.exp(b), s_prev)
    return y.reshape(B, T, H, dv), s_fin


def gla_mixer(zl, zc, rows, cols, gate_w2, gate_b, norm_g, with_ctx):
    def prep(z, pos):
        q, k, v, r, gd = z
        B, T, _ = q.shape
        q = q.reshape(B, T, GLA_HEADS, GLA_DK) * GLA_DK ** -0.5
        k = k.reshape(B, T, GLA_HEADS, GLA_DK)
        if pos is not None:
            q = rope_2d(q, pos[0], pos[1])
            k = rope_2d(k, pos[0], pos[1])
        v = v.reshape(B, T, GLA_HEADS, GLA_DV)
        gds = jnp.split(gd, 2, axis=-1)
        log_a = []
        for d in range(2):
            pre = (gds[d] @ gate_w2[d] + gate_b[d]).astype(F32)
            log_a.append((jax.nn.log_sigmoid(pre) / GLA_GATE_TAU).reshape(B, T, GLA_HEADS, GLA_DK))
        return q, k, v, r, log_a

    ql, kl, vl, rl, lal = prep(zl, (rows, cols))
    qc, kc, vc, rc, lac = prep(zc, None)
    B = ql.shape[0]
    s0 = jnp.zeros((B, GLA_HEADS, GLA_DK, GLA_DV), F32)
    yc_f, sc_f = gla_scan(qc, kc, vc, lac[0], s0)
    yc_b, sc_b = gla_scan(flip(qc), flip(kc), flip(vc), flip(lac[1]), s0)
    yl_f, _ = gla_scan(ql, kl, vl, lal[0], sc_f)
    yl_b, _ = gla_scan(flip(ql), flip(kl), flip(vl), flip(lal[1]), sc_b)

    def finish(y_f, y_b_rev, r):
        y = rms_norm(y_f + flip(y_b_rev), norm_g)
        return (y.reshape(r.shape) * jax.nn.silu(r.astype(F32))).astype(r.dtype)

    y = finish(yl_f, yl_b, rl)
    yc = finish(yc_f, yc_b, rc) if with_ctx else None
    return y, yc


def token_shift(z, mu):
    prev = jnp.pad(z[:, :-1], ((0, 0), (1, 0), (0, 0)))
    nxt = jnp.pad(z[:, 1:], ((0, 0), (0, 1), (0, 0)))
    return z + mu * (0.5 * (prev + nxt) - z)


def rwkv_scan(r, w, k, v, kk, a, s0):
    def step(s, inp):
        r_t, w_t, k_t, v_t, kk_t, a_t = inp
        sa = jnp.einsum('bhvk,bhk->bhv', s, kk_t)
        s = (s * w_t[:, :, None, :] - sa[..., None] * (kk_t * a_t)[:, :, None, :]
             + v_t[..., None] * k_t[:, :, None, :])
        return s, jnp.einsum('bhvk,bhk->bhv', s, r_t)

    xs = tuple(jnp.moveaxis(t, 1, 0) for t in (r, w, k, v, kk, a))
    s_fin, ys = lax.scan(step, s0, xs)
    return jnp.moveaxis(ys, 0, 1), s_fin


def rwkv_prep(z, mu, w0, w2, a0, a2, g2, k_k, k_a):
    B, T, _ = z.shape
    z = token_shift(z, mu)
    r, k, v, wd, ad, gd = split_at(z, RW_SPLITS)

    def heads(t):
        return t.reshape(B, T, RW_HEADS, RW_HEAD).astype(F32)

    kk = heads(k * k_k)
    kk = kk * lax.rsqrt(jnp.sum(kk * kk, axis=-1, keepdims=True) + EPS)
    wds = jnp.split(wd, 2, axis=-1)
    ads = jnp.split(ad, 2, axis=-1)
    per_dir = []
    for d in range(2):
        w_log = (-jax.nn.softplus(-(w0[d] + jnp.tanh(wds[d]) @ w2[d])) - 0.5).astype(F32)
        decay = jnp.exp(-jnp.exp(w_log))
        a = jax.nn.sigmoid(a0[d] + ads[d] @ a2[d])
        k_d = k * (1.0 + (a - 1.0) * k_a)
        per_dir.append((heads(decay), heads(k_d), heads(a)))
    g = jax.nn.sigmoid(gd) @ g2
    return heads(r), heads(k), heads(v), kk, per_dir, g


def rwkv_mixer(zl, zc, mu, w0, w2, a0, a2, g2, k_k, k_a, r_k, gn_g, gn_b, with_ctx):
    rl, kl, vl, kkl, dl, gl = rwkv_prep(zl, mu, w0, w2, a0, a2, g2, k_k, k_a)
    rc, kc, vc, kkc, dcx, gc = rwkv_prep(zc, mu, w0, w2, a0, a2, g2, k_k, k_a)
    B = rl.shape[0]
    s0 = jnp.zeros((B, RW_HEADS, RW_HEAD, RW_HEAD), F32)
    yc_f, sc_f = rwkv_scan(rc, dcx[0][0], dcx[0][1], vc, kkc, dcx[0][2], s0)
    yc_b, sc_b = rwkv_scan(flip(rc), flip(dcx[1][0]), flip(dcx[1][1]), flip(vc), flip(kkc), flip(dcx[1][2]), s0)
    yl_f, _ = rwkv_scan(rl, dl[0][0], dl[0][1], vl, kkl, dl[0][2], sc_f)
    yl_b, _ = rwkv_scan(flip(rl), flip(dl[1][0]), flip(dl[1][1]), flip(vl), flip(kkl), flip(dl[1][2]), sc_b)
    gamma = gn_g.astype(F32).reshape(RW_HEADS, RW_HEAD)
    beta = gn_b.astype(F32).reshape(RW_HEADS, RW_HEAD)

    def finish(y_f, y_b_rev, r, k, v, g):
        y = y_f + flip(y_b_rev)
        mean = jnp.mean(y, axis=-1, keepdims=True)
        var = jnp.mean(jnp.square(y - mean), axis=-1, keepdims=True)
        y = (y - mean) * lax.rsqrt(var + RW_GN_EPS) * gamma + beta
        y = y + jnp.sum(r * k * r_k.astype(F32), axis=-1, keepdims=True) * v
        return (y.reshape(g.shape) * g.astype(F32)).astype(g.dtype)

    y = finish(yl_f, yl_b, rl, kl, vl, gl)
    yc = finish(yc_f, yc_b, rc, kc, vc, gc) if with_ctx else None
    return y, yc


def merge_branches(ys, gates, w_branch, w_out):
    y = jnp.stack(ys, axis=-2)
    proj = jnp.einsum('btiw,iwd->btid', y, w_branch)
    g = jax.nn.sigmoid(gates.reshape(gates.shape[:-1] + (N_BRANCH, D_MODEL)))
    return jnp.sum(g * proj, axis=-2) @ w_out


def token_mixers(h, hc, rows, cols, p, with_ctx):
    zl = split_at(h @ p['w_in'], IN_SPLITS)
    zc = split_at(hc @ p['w_in'], IN_SPLITS)
    y_na, yc_na = na_mixer(zl[0:3], zc[0:3], p['na_q_norm'], p['na_k_norm'], p['na_rpb'], with_ctx)
    y_gla, yc_gla = gla_mixer(zl[3:8], zc[3:8], rows, cols, p['gla_gate_w2'], p['gla_gate_b'],
                              p['gla_norm_g'], with_ctx)
    y_rw, yc_rw = rwkv_mixer(zl[8], zc[8], p['rw_mu'], p['rw_w0'], p['rw_w2'], p['rw_a0'], p['rw_a2'],
                             p['rw_g2'], p['rw_k_k'], p['rw_k_a'], p['rw_r_k'], p['rw_gn_g'],
                             p['rw_gn_b'], with_ctx)
    y = merge_branches((y_na, y_gla, y_rw), zl[9], p['w_branch'], p['w_out'])
    yc = merge_branches((yc_na, yc_gla, yc_rw), zc[9], p['w_branch'], p['w_out']) if with_ctx else None
    return y, yc


def moe_ffn(h, router_w, router_bias, w_gate, w_up, w_down):
    shp = h.shape
    t = h.reshape(-1, shp[-1])
    s = jax.nn.sigmoid(t.astype(F32) @ router_w.astype(F32))
    biased = s + router_bias.astype(F32)
    grp = biased.reshape(-1, N_GROUPS, EXPERTS_PER_GROUP)
    grp_score = jnp.sum(lax.top_k(grp, TOP_K)[0], axis=-1)
    g_sel = jnp.argmax(grp_score, axis=-1)
    in_group = (jnp.arange(N_EXPERTS) // EXPERTS_PER_GROUP)[None, :] == g_sel[:, None]
    _, idx = lax.top_k(jnp.where(in_group, biased, -jnp.inf), TOP_K)
    w_sel = jnp.take_along_axis(s, idx, axis=-1)
    w_sel = w_sel / jnp.sum(w_sel, axis=-1, keepdims=True)
    comb = jnp.sum(jax.nn.one_hot(idx, N_EXPERTS, dtype=F32) * w_sel[..., None], axis=1)
    act = jax.nn.silu(jnp.einsum('td,edf->tef', t, w_gate)) * jnp.einsum('td,edf->tef', t, w_up)
    y = jnp.einsum('tef,efd->td', act * comb[..., None].astype(act.dtype), w_down)
    return y.reshape(shp)


def setup_inputs(seed: int = 0) -> dict:
    key = jax.random.key(seed)
    ks = iter(jax.random.split(key, 48))
    L, D = DEPTH, D_MODEL

    def nrm(shape, scale):
        return scale * jax.random.normal(next(ks), shape, F32)

    def gain(shape):
        return 1.0 + nrm(shape, 0.02)

    return {
        'x': nrm((BATCH, SEQ, D), 1.0),
        'c': nrm((BATCH, D), 1.0),
        'ctx': nrm((BATCH, CTX_LEN, D), 1.0),
        'c_ctx': nrm((D,), 1.0),
        'ada_w': nrm((L, D, 6 * D), 0.5 * D ** -0.5),
        'ada_b': nrm((L, 6 * D), 0.02),
        'norm1_g': gain((L, D)),
        'norm2_g': gain((L, D)),
        'w_in': nrm((L, D, D_IN), D ** -0.5),
        'na_q_norm': gain((L, NA_HEAD_DIM)),
        'na_k_norm': gain((L, NA_HEAD_DIM)),
        'na_rpb': nrm((L, NA_HEADS, 2 * NA_WIN_R_MAX - 1, 2 * NA_WIN_C - 1), 0.1),
        'gla_gate_w2': nrm((L, 2, GLA_GATE_RANK, GLA_QK), GLA_GATE_RANK ** -0.5),
        'gla_gate_b': nrm((L, 2, GLA_QK), 0.1),
        'gla_norm_g': gain((L, GLA_DV)),
        'rw_mu': jax.random.uniform(next(ks), (L, RW_IN), F32),
        'rw_w0': jax.random.uniform(next(ks), (L, 2, RW_W), F32, -6.0, -1.0),
        'rw_w2': nrm((L, 2, RW_DECAY_RANK, RW_W), 0.1 * RW_DECAY_RANK ** -0.5),
        'rw_a0': nrm((L, 2, RW_W), 0.1),
        'rw_a2': nrm((L, 2, RW_A_RANK, RW_W), 0.3 * RW_A_RANK ** -0.5),
        'rw_g2': nrm((L, RW_GATE_RANK, RW_W), RW_GATE_RANK ** -0.5),
        'rw_k_k': 0.85 + nrm((L, RW_W), 0.05),
        'rw_k_a': 1.0 + nrm((L, RW_W), 0.05),
        'rw_r_k': nrm((L, RW_HEADS, RW_HEAD), 0.1),
        'rw_gn_g': gain((L, RW_W)),
        'rw_gn_b': nrm((L, RW_W), 0.02),
        'w_branch': nrm((L, N_BRANCH, BRANCH_W, D), BRANCH_W ** -0.5),
        'w_out': nrm((L, D, D), D ** -0.5),
        'router_w': nrm((D, N_EXPERTS), D ** -0.5),
        'router_bias': nrm((N_EXPERTS,), 0.01),
        'moe_w_gate': nrm((L, N_EXPERTS, D, D_EXPERT), D ** -0.5),
        'moe_w_up': nrm((L, N_EXPERTS, D, D_EXPERT), D ** -0.5),
        'moe_w_down': nrm((L, N_EXPERTS, D_EXPERT, D), D_EXPERT ** -0.5),
    }


def reference(x, c, ctx, c_ctx, ada_w, ada_b, norm1_g, norm2_g, w_in, na_q_norm, na_k_norm, na_rpb,
              gla_gate_w2, gla_gate_b, gla_norm_g, rw_mu, rw_w0, rw_w2, rw_a0, rw_a2, rw_g2,
              rw_k_k, rw_k_a, rw_r_k, rw_gn_g, rw_gn_b, w_branch, w_out, router_w, router_bias,
              moe_w_gate, moe_w_up, moe_w_down):
    S = x.shape[1]
    t = jnp.arange(S, dtype=jnp.int32)
    rows = t // GRID_W
    cols = t % GRID_W
    for l in range(DEPTH):
        with_ctx = l < DEPTH - 1
        p = {
            'w_in': w_in[l], 'na_q_norm': na_q_norm[l], 'na_k_norm': na_k_norm[l], 'na_rpb': na_rpb[l],
            'gla_gate_w2': gla_gate_w2[l], 'gla_gate_b': gla_gate_b[l], 'gla_norm_g': gla_norm_g[l],
            'rw_mu': rw_mu[l], 'rw_w0': rw_w0[l], 'rw_w2': rw_w2[l], 'rw_a0': rw_a0[l], 'rw_a2': rw_a2[l],
            'rw_g2': rw_g2[l], 'rw_k_k': rw_k_k[l], 'rw_k_a': rw_k_a[l], 'rw_r_k': rw_r_k[l],
            'rw_gn_g': rw_gn_g[l], 'rw_gn_b': rw_gn_b[l], 'w_branch': w_branch[l], 'w_out': w_out[l],
        }
        mod = jax.nn.silu(c) @ ada_w[l] + ada_b[l]
        mod_c = jax.nn.silu(c_ctx) @ ada_w[l] + ada_b[l]
        sh1, sc1, g1, sh2, sc2, g2 = jnp.split(mod[:, None, :], 6, axis=-1)
        csh1, csc1, cg1, csh2, csc2, cg2 = jnp.split(mod_c, 6)

        h = rms_norm(x, norm1_g[l]) * (1.0 + sc1) + sh1
        hc = rms_norm(ctx, norm1_g[l]) * (1.0 + csc1) + csh1
        y, yc = token_mixers(h, hc, rows, cols, p, with_ctx)
        x = x + g1 * y
        h2 = rms_norm(x, norm2_g[l]) * (1.0 + sc2) + sh2
        x = x + g2 * moe_ffn(h2, router_w, router_bias, moe_w_gate[l], moe_w_up[l], moe_w_down[l])

        if with_ctx:
            ctx = ctx + cg1 * yc
            hc2 = rms_norm(ctx, norm2_g[l]) * (1.0 + csc2) + csh2
            ctx = ctx + cg2 * moe_ffn(hc2, router_w, router_bias, moe_w_gate[l], moe_w_up[l], moe_w_down[l])
    return x
```

```cpp
#ifndef CPU_TEST
#include <hip/hip_runtime.h>
#define HD __host__ __device__ __forceinline__
#else
#define HD inline
#endif
#include <cmath>
#include <cstdint>
#include <cstddef>
#include <cstdio>

#ifdef CFG_SMALL
constexpr int D_MODEL = 48, BATCH = 2, GRID_W = 32, SEQ = 384, DEPTH = 2, CTX_LEN = 64;
constexpr int NA_HEADS = 2, NA_HD = 16;
constexpr int GLA_HEADS = 2, GLA_DK = 8, GLA_DV = 16, GLA_RANK = 4;
constexpr int RW_HEADS = 2, RW_HEAD = 16, RW_DR = 6, RW_AR = 6, RW_GR = 8;
constexpr int D_EXPERT = 12;
#else
constexpr int D_MODEL = 2048, BATCH = 4, GRID_W = 64, SEQ = 2048, DEPTH = 2, CTX_LEN = 256;
constexpr int NA_HEADS = 16, NA_HD = 64;
constexpr int GLA_HEADS = 4, GLA_DK = 128, GLA_DV = 256, GLA_RANK = 16;
constexpr int RW_HEADS = 16, RW_HEAD = 64, RW_DR = 96, RW_AR = 96, RW_GR = 256;
constexpr int D_EXPERT = 512;
#endif
constexpr int NA_WIN_R_MAX = 8, NA_WIN_C = 16;
constexpr int NA_W = NA_HEADS * NA_HD;
constexpr int GLA_QK = GLA_HEADS * GLA_DK, GLA_V = GLA_HEADS * GLA_DV;
constexpr float GLA_TAU = 16.0f;
constexpr int RW_W = RW_HEADS * RW_HEAD;
constexpr int RW_IN = 3 * RW_W + 2 * RW_DR + 2 * RW_AR + RW_GR;
constexpr int RW_LOW = 2 * RW_DR + 2 * RW_AR + RW_GR;
constexpr float RW_GN_EPS = 64e-5f;
constexpr int BW = NA_W;
static_assert(GLA_V == BW && RW_W == BW, "branch widths");
constexpr int N_EXPERTS = 16, N_GROUPS = 4, EPG = 4;
constexpr float EPS = 1e-6f;
constexpr int D6 = 6 * D_MODEL;
constexpr int ZO_NAQ = 0, ZO_NAK = NA_W, ZO_NAV = 2 * NA_W;
constexpr int ZO_GQ = 3 * NA_W, ZO_GK = ZO_GQ + GLA_QK, ZO_GV = ZO_GK + GLA_QK, ZO_GR = ZO_GV + GLA_V, ZO_GGD = ZO_GR + GLA_V;
constexpr int ZO_RW = ZO_GGD + 2 * GLA_RANK, ZO_GATE = ZO_RW + RW_IN, D_IN = ZO_GATE + 3 * D_MODEL;
constexpr int RO_R = 0, RO_K = RW_W, RO_V = 2 * RW_W, RO_WD = 3 * RW_W, RO_AD = RO_WD + 2 * RW_DR, RO_GD = RO_AD + 2 * RW_AR;
#ifdef CFG_SMALL
constexpr int ZLD = D_IN;
#else
constexpr int ZLD = 16128;
static_assert(D_IN == 16032, "D_IN");
#endif
constexpr int R_LAT = BATCH * SEQ, R_CTX = BATCH * CTX_LEN, R_ALL = R_LAT + R_CTX;
constexpr int NMOD = BATCH + 1;

typedef unsigned short bf16_t;
HD float bf2f(bf16_t b) { union { unsigned u; float f; } v; v.u = ((unsigned)b) << 16; return v.f; }
HD bf16_t f2bf(float f) { union { unsigned u; float f; } v; v.f = f; unsigned u = v.u; if ((u & 0x7fffffffu) > 0x7f800000u) return (bf16_t)0x7fc0; u += 0x7FFFu + ((u >> 16) & 1u); return (bf16_t)(u >> 16); }
HD float ldf(const float* p, size_t i) { return p[i]; }
HD float ldf(const bf16_t* p, size_t i) { return bf2f(p[i]); }
HD void stf(float* p, size_t i, float v) { p[i] = v; }
HD void stf(bf16_t* p, size_t i, float v) { p[i] = f2bf(v); }

#ifdef CPU_TEST
typedef float ZT; typedef float AT;
#else
typedef bf16_t ZT; typedef bf16_t AT;
#endif

HD float sigmoidf_(float x) { return 1.0f / (1.0f + expf(-x)); }
HD float siluf_(float x) { return x / (1.0f + expf(-x)); }
HD float softplusf_(float x) { return (x > 0.f ? x : 0.f) + log1pf(expf(-fabsf(x))); }

struct Ptrs {
    const float *x, *c, *ctx, *c_ctx, *ada_w, *ada_b, *norm1_g, *norm2_g, *w_in, *na_q_norm, *na_k_norm, *na_rpb, *gla_gate_w2, *gla_gate_b, *gla_norm_g,
        *rw_mu, *rw_w0, *rw_w2, *rw_a0, *rw_a2, *rw_g2, *rw_k_k, *rw_k_a, *rw_r_k, *rw_gn_g, *rw_gn_b, *w_branch, *w_out, *router_w, *router_bias,
        *moe_w_gate, *moe_w_up, *moe_w_down;
    float* out;
    float* MOD;
    float* X;
    float* RSTD;
    AT* H;
    ZT* Z;
    AT* Y3;
    float *GQ, *GK, *GA, *GY;
    float *LOW, *KK, *RS, *G, *DEC, *KD, *BB, *RY;
    float* MF;
    int* SELI;
    float* SELW;
    float* ACT;
};

HD int row_bt(int r) { return r < R_LAT ? r / SEQ : BATCH; }
HD int rows_out(int l) { return l < DEPTH - 1 ? R_ALL : R_LAT; }
HD bool row_first(int r) { return r < R_LAT ? (r % SEQ == 0) : ((r - R_LAT) % CTX_LEN == 0); }
HD bool row_last(int r) { return r < R_LAT ? (r % SEQ == SEQ - 1) : ((r - R_LAT) % CTX_LEN == CTX_LEN - 1); }
HD const float* modp(const Ptrs& p, int l, int bt, int k) { return p.MOD + (((size_t)l * NMOD + bt) * 6 + k) * D_MODEL; }
HD int scan_row(int b, int d, int st) {
    if (st < CTX_LEN) return R_LAT + b * CTX_LEN + (d ? CTX_LEN - 1 - st : st);
    const int t = st - CTX_LEN; return b * SEQ + (d ? SEQ - 1 - t : t);
}

struct FMod { Ptrs p;
    HD void operator()(long i) const {
        const int j = (int)(i % D6); const int bt = (int)((i / D6) % NMOD); const int l = (int)(i / ((long)D6 * NMOD));
        const float* cv = bt < BATCH ? p.c + (size_t)bt * D_MODEL : p.c_ctx;
        const float* w = p.ada_w + (size_t)l * D_MODEL * D6 + j;
        float acc = p.ada_b[(size_t)l * D6 + j];
        for (int k = 0; k < D_MODEL; ++k) acc += siluf_(cv[k]) * w[(size_t)k * D6];
        p.MOD[((size_t)l * NMOD + bt) * D6 + j] = acc;
    } };
struct FCopyX { Ptrs p;
    HD void operator()(long i) const { const size_t n = (size_t)R_LAT * D_MODEL; p.X[i] = (size_t)i < n ? p.x[i] : p.ctx[i - n]; } };
struct FRstd { Ptrs p;
    HD void operator()(long r) const { const float* xr = p.X + (size_t)r * D_MODEL; float s = 0.f; for (int d = 0; d < D_MODEL; ++d) s += xr[d] * xr[d]; p.RSTD[r] = 1.0f / sqrtf(s / D_MODEL + EPS); } };
struct FNormMod { Ptrs p; int l, which;
    HD void operator()(long i) const {
        const int r = (int)(i / D_MODEL), d = (int)(i % D_MODEL); const int bt = row_bt(r);
        const float g = (which ? p.norm2_g : p.norm1_g)[(size_t)l * D_MODEL + d];
        const float sh = modp(p, l, bt, which ? 3 : 0)[d], sc = modp(p, l, bt, which ? 4 : 1)[d];
        stf(p.H, (size_t)i, p.X[i] * p.RSTD[r] * g * (1.0f + sc) + sh);
    } };

struct FNaAttn { Ptrs p; int l; int pad_;
    HD void operator()(long i) const {
        const int r = (int)(i / NA_HEADS), h = (int)(i % NA_HEADS);
        const ZT* zr = p.Z + (size_t)r * ZLD;
        float q[NA_HD], acc[NA_HD];
        float ssq = 0.f;
#pragma unroll
        for (int d = 0; d < NA_HD; ++d) { q[d] = ldf(zr, ZO_NAQ + h * NA_HD + d); ssq += q[d] * q[d]; }
        const float rq = 1.0f / sqrtf(ssq / NA_HD + EPS) * (1.0f / sqrtf((float)NA_HD));
#pragma unroll
        for (int d = 0; d < NA_HD; ++d) { q[d] = q[d] * rq * p.na_q_norm[l * NA_HD + d] * p.na_k_norm[l * NA_HD + d]; acc[d] = 0.f; }
        float m = -INFINITY, ls = 0.f;
        auto key = [&](int kr, float bias) {
            const ZT* zk = p.Z + (size_t)kr * ZLD;
            float dot = 0.f, ks = 0.f;
#pragma unroll
            for (int d = 0; d < NA_HD; ++d) { const float kv = ldf(zk, ZO_NAK + h * NA_HD + d); dot += q[d] * kv; ks += kv * kv; }
            const float s = dot / sqrtf(ks / NA_HD + EPS) + bias;
            const float mn = s > m ? s : m; const float corr = expf(m - mn), pe = expf(s - mn);
            ls = ls * corr + pe;
#pragma unroll
            for (int d = 0; d < NA_HD; ++d) acc[d] = acc[d] * corr + pe * ldf(zk, ZO_NAV + h * NA_HD + d);
            m = mn;
        };
        int b;
        if (r < R_LAT) {
            b = r / SEQ; const int t = r % SEQ, gr = t / GRID_W, gc = t % GRID_W;
            constexpr int n_rows = SEQ / GRID_W; constexpr int win_r = NA_WIN_R_MAX < n_rows ? NA_WIN_R_MAX : n_rows;
            int rs = gr - win_r / 2; rs = rs < 0 ? 0 : (rs > n_rows - win_r ? n_rows - win_r : rs);
            int cs = gc - NA_WIN_C / 2; cs = cs < 0 ? 0 : (cs > GRID_W - NA_WIN_C ? GRID_W - NA_WIN_C : cs);
            const float* rp = p.na_rpb + ((size_t)l * NA_HEADS + h) * (2 * NA_WIN_R_MAX - 1) * (2 * NA_WIN_C - 1);
            for (int n = 0; n < win_r; ++n)
                for (int j = 0; j < NA_WIN_C; ++j)
                    key(b * SEQ + (rs + n) * GRID_W + cs + j, rp[(rs + n - gr + NA_WIN_R_MAX - 1) * (2 * NA_WIN_C - 1) + (cs + j - gc + NA_WIN_C - 1)]);
        } else b = (r - R_LAT) / CTX_LEN;
        for (int c = 0; c < CTX_LEN; ++c) key(R_LAT + b * CTX_LEN + c, 0.f);
        const float inv = 1.0f / ls;
#pragma unroll
        for (int d = 0; d < NA_HD; ++d) stf(p.Y3, (size_t)r * BW + h * NA_HD + d, acc[d] * inv);
    } };

struct FGlaPrep { Ptrs p; int l; int pad_;
    HD void operator()(long i) const {
        const int r = (int)(i / GLA_QK), j = (int)(i % GLA_QK), ii = j % GLA_DK, hb = j - ii;
        const ZT* zr = p.Z + (size_t)r * ZLD;
        const float qs = 1.0f / sqrtf((float)GLA_DK);
        float qv = ldf(zr, ZO_GQ + j) * qs, kv = ldf(zr, ZO_GK + j);
        if (r < R_LAT) {
            constexpr int half = GLA_DK / 2, hh2 = half / 2;
            const int t = r % SEQ; const int sect = ii / half, i2 = ii % half, f = i2 % hh2;
            const float pos = (float)(sect == 0 ? t / GRID_W : t % GRID_W);
            const float ang = pos * powf(10000.0f, -(float)(2 * f) / (float)half);
            const float cs = cosf(ang), sn = sinf(ang);
            const int pj = hb + sect * half + (i2 < hh2 ? i2 + hh2 : i2 - hh2);
            const float qp = ldf(zr, ZO_GQ + pj) * qs, kp = ldf(zr, ZO_GK + pj);
            if (i2 < hh2) { qv = qv * cs - qp * sn; kv = kv * cs - kp * sn; } else { qv = qp * sn + qv * cs; kv = kp * sn + kv * cs; }
        }
        p.GQ[i] = qv; p.GK[i] = kv;
        for (int d = 0; d < 2; ++d) {
            float pre = p.gla_gate_b[((size_t)l * 2 + d) * GLA_QK + j];
            for (int k = 0; k < GLA_RANK; ++k) pre += ldf(zr, ZO_GGD + d * GLA_RANK + k) * p.gla_gate_w2[(((size_t)l * 2 + d) * GLA_RANK + k) * GLA_QK + j];
            p.GA[(size_t)d * R_ALL * GLA_QK + i] = expf(-softplusf_(-pre) / GLA_TAU);
        }
    } };
struct FGlaScan { Ptrs p; int l; int pad_;
    HD void operator()(long i) const {
        const int vc = (int)(i % GLA_DV); const int ch = (int)(i / GLA_DV); const int d = ch % 2, hh = (ch / 2) % GLA_HEADS, b = ch / (2 * GLA_HEADS);
        float s[GLA_DK];
#pragma unroll
        for (int k = 0; k < GLA_DK; ++k) s[k] = 0.f;
        const float* ga = p.GA + (size_t)d * R_ALL * GLA_QK;
        float* gy = p.GY + (size_t)d * R_ALL * GLA_V;
        for (int st = 0; st < CTX_LEN + SEQ; ++st) {
            const int r = scan_row(b, d, st);
            const size_t o = (size_t)r * GLA_QK + hh * GLA_DK;
            const float v = ldf(p.Z, (size_t)r * ZLD + ZO_GV + hh * GLA_DV + vc);
            float y = 0.f;
#pragma unroll
            for (int k = 0; k < GLA_DK; ++k) { s[k] = ga[o + k] * s[k] + p.GK[o + k] * v; y += p.GQ[o + k] * s[k]; }
            gy[(size_t)r * GLA_V + hh * GLA_DV + vc] = y;
        }
    } };
struct FGlaFinish { Ptrs p; int l; int pad_;
    HD void operator()(long i) const {
        const int r = (int)(i / GLA_HEADS), hh = (int)(i % GLA_HEADS);
        const size_t o = (size_t)r * GLA_V + hh * GLA_DV; const float* y0 = p.GY + o; const float* y1 = p.GY + (size_t)R_ALL * GLA_V + o;
        float ss = 0.f; for (int v = 0; v < GLA_DV; ++v) { const float y = y0[v] + y1[v]; ss += y * y; }
        const float rn = 1.0f / sqrtf(ss / GLA_DV + EPS);
        for (int v = 0; v < GLA_DV; ++v) {
            const float y = (y0[v] + y1[v]) * rn * p.gla_norm_g[(size_t)l * GLA_DV + v];
            stf(p.Y3, (size_t)R_ALL * BW + o + v, y * siluf_(ldf(p.Z, (size_t)r * ZLD + ZO_GR + hh * GLA_DV + v)));
        }
    } };

HD float rwz(const Ptrs& p, int l, int r, int col) {
    const size_t o = (size_t)r * ZLD + ZO_RW + col;
    const float z0 = ldf(p.Z, o), zp = row_first(r) ? 0.f : ldf(p.Z, o - ZLD), zn = row_last(r) ? 0.f : ldf(p.Z, o + ZLD);
    return z0 + p.rw_mu[(size_t)l * RW_IN + col] * (0.5f * (zp + zn) - z0);
}
struct FRwLow { Ptrs p; int l; int pad_;
    HD void operator()(long i) const {
        const int r = (int)(i / RW_LOW), q = (int)(i % RW_LOW);
        const float z = rwz(p, l, r, RO_WD + q);
        p.LOW[i] = q < 2 * RW_DR ? tanhf(z) : (q < 2 * RW_DR + 2 * RW_AR ? z : sigmoidf_(z));
    } };
struct FRwHead { Ptrs p; int l; int pad_;
    HD void operator()(long i) const {
        const int r = (int)(i / RW_HEADS), h = (int)(i % RW_HEADS);
        float ss = 0.f;
        for (int j = 0; j < RW_HEAD; ++j) { const float k = rwz(p, l, r, RO_K + h * RW_HEAD + j) * p.rw_k_k[(size_t)l * RW_W + h * RW_HEAD + j]; ss += k * k; }
        const float rn = 1.0f / sqrtf(ss + EPS);
        for (int j = 0; j < RW_HEAD; ++j) { const int c = h * RW_HEAD + j;
            p.KK[(size_t)r * RW_W + c] = rwz(p, l, r, RO_K + c) * p.rw_k_k[(size_t)l * RW_W + c] * rn;
            p.RS[(size_t)r * RW_W + c] = rwz(p, l, r, RO_R + c); }
    } };
struct FRwG { Ptrs p; int l; int pad_;
    HD void operator()(long i) const {
        const int r = (int)(i / RW_W), j = (int)(i % RW_W);
        const float* lo = p.LOW + (size_t)r * RW_LOW + 2 * RW_DR + 2 * RW_AR; float acc = 0.f;
        for (int q = 0; q < RW_GR; ++q) acc += lo[q] * p.rw_g2[((size_t)l * RW_GR + q) * RW_W + j];
        p.G[i] = acc;
    } };
struct FRwDir { Ptrs p; int l, d;
    HD void operator()(long i) const {
        const int r = (int)(i / RW_W), j = (int)(i % RW_W);
        const float* lo = p.LOW + (size_t)r * RW_LOW;
        float wpre = p.rw_w0[((size_t)l * 2 + d) * RW_W + j];
        for (int q = 0; q < RW_DR; ++q) wpre += lo[d * RW_DR + q] * p.rw_w2[(((size_t)l * 2 + d) * RW_DR + q) * RW_W + j];
        const float w_log = -softplusf_(-wpre) - 0.5f;
        float apre = p.rw_a0[((size_t)l * 2 + d) * RW_W + j];
        for (int q = 0; q < RW_AR; ++q) apre += lo[2 * RW_DR + d * RW_AR + q] * p.rw_a2[(((size_t)l * 2 + d) * RW_AR + q) * RW_W + j];
        const float a = sigmoidf_(apre);
        const float kraw = rwz(p, l, r, RO_K + j);
        p.DEC[i] = expf(-expf(w_log));
        p.KD[i] = kraw * (1.0f + (a - 1.0f) * p.rw_k_a[(size_t)l * RW_W + j]);
        p.BB[i] = p.KK[i] * a;
    } };
struct FRwScan { Ptrs p; int l, d;
    HD void operator()(long i) const {
        const int vi = (int)(i % RW_HEAD); const int bh = (int)(i / RW_HEAD); const int h = bh % RW_HEADS, b = bh / RW_HEADS;
        float s[RW_HEAD];
#pragma unroll
        for (int j = 0; j < RW_HEAD; ++j) s[j] = 0.f;
        float* ry = p.RY + (size_t)d * R_ALL * RW_W;
        for (int st = 0; st < CTX_LEN + SEQ; ++st) {
            const int r = scan_row(b, d, st);
            const size_t o = (size_t)r * RW_W + h * RW_HEAD;
            const float v = rwz(p, l, r, RO_V + h * RW_HEAD + vi);
            float sa = 0.f;
#pragma unroll
            for (int j = 0; j < RW_HEAD; ++j) sa += s[j] * p.KK[o + j];
            float y = 0.f;
#pragma unroll
            for (int j = 0; j < RW_HEAD; ++j) { s[j] = s[j] * p.DEC[o + j] - sa * p.BB[o + j] + v * p.KD[o + j]; y += s[j] * p.RS[o + j]; }
            ry[o + vi] = y;
        }
    } };
struct FRwFinish { Ptrs p; int l; int pad_;
    HD void operator()(long i) const {
        const int r = (int)(i / RW_HEADS), h = (int)(i % RW_HEADS);
        const size_t o = (size_t)r * RW_W + h * RW_HEAD; const float* y0 = p.RY + o; const float* y1 = p.RY + (size_t)R_ALL * RW_W + o;
        float mean = 0.f; for (int j = 0; j < RW_HEAD; ++j) mean += y0[j] + y1[j];
        mean /= RW_HEAD;
        float var = 0.f, bonus = 0.f;
        for (int j = 0; j < RW_HEAD; ++j) { const float dv = y0[j] + y1[j] - mean; var += dv * dv;
            bonus += p.RS[o + j] * rwz(p, l, r, RO_K + h * RW_HEAD + j) * p.rw_r_k[((size_t)l * RW_HEADS + h) * RW_HEAD + j]; }
        const float rn = 1.0f / sqrtf(var / RW_HEAD + RW_GN_EPS);
        for (int j = 0; j < RW_HEAD; ++j) { const int c = h * RW_HEAD + j;
            float y = (y0[j] + y1[j] - mean) * rn * p.rw_gn_g[(size_t)l * RW_W + c] + p.rw_gn_b[(size_t)l * RW_W + c];
            y += bonus * rwz(p, l, r, RO_V + c);
            stf(p.Y3, (size_t)2 * R_ALL * BW + (size_t)r * BW + c, y * p.G[(size_t)r * RW_W + c]); }
    } };

struct FRouter { Ptrs p; int l; int pad_;
    HD void operator()(long r) const {
        const int bt = row_bt((int)r); const float* xr = p.X + (size_t)r * D_MODEL; const float rstd = p.RSTD[r];
        const float* sh = modp(p, l, bt, 3); const float* sc = modp(p, l, bt, 4); const float* g = p.norm2_g + (size_t)l * D_MODEL;
        float lg[N_EXPERTS];
#pragma unroll
        for (int e = 0; e < N_EXPERTS; ++e) lg[e] = 0.f;
        for (int d = 0; d < D_MODEL; ++d) { const float h = xr[d] * rstd * g[d] * (1.0f + sc[d]) + sh[d]; const float* w = p.router_w + (size_t)d * N_EXPERTS;
#pragma unroll
            for (int e = 0; e < N_EXPERTS; ++e) lg[e] += h * w[e]; }
        float s[N_EXPERTS], bz[N_EXPERTS];
#pragma unroll
        for (int e = 0; e < N_EXPERTS; ++e) { s[e] = sigmoidf_(lg[e]); bz[e] = s[e] + p.router_bias[e]; }
        int gsel = 0; float gbest = -INFINITY;
#pragma unroll
        for (int gi = 0; gi < N_GROUPS; ++gi) {
            float m1 = -INFINITY, m2 = -INFINITY;
#pragma unroll
            for (int k = 0; k < EPG; ++k) { const float v = bz[gi * EPG + k]; if (v > m1) { m2 = m1; m1 = v; } else if (v > m2) m2 = v; }
            const float sc2 = m1 + m2; if (sc2 > gbest) { gbest = sc2; gsel = gi; }
        }
        int i1 = 0, i2 = 0; float v1 = -INFINITY, v2 = -INFINITY, s1 = 0.f, s2 = 0.f;
#pragma unroll
        for (int e = 0; e < N_EXPERTS; ++e) { if (e / EPG != gsel) continue; const float v = bz[e];
            if (v > v1) { v2 = v1; i2 = i1; s2 = s1; v1 = v; i1 = e; s1 = s[e]; } else if (v > v2) { v2 = v; i2 = e; s2 = s[e]; } }
        const float inv = 1.0f / (s1 + s2);
        p.SELI[2 * r] = i1; p.SELI[2 * r + 1] = i2; p.SELW[2 * r] = s1 * inv; p.SELW[2 * r + 1] = s2 * inv;
    } };
struct FMoeUp { Ptrs p; int l; int pad_;
    HD void operator()(long i) const {
        const int j = (int)(i % D_EXPERT), k = (int)((i / D_EXPERT) % 2), r = (int)(i / (2 * D_EXPERT));
        const int e = p.SELI[2 * r + k];
        const size_t wo = ((size_t)l * N_EXPERTS + e) * D_MODEL * D_EXPERT + j;
        const float* wg = p.moe_w_gate + wo; const float* wu = p.moe_w_up + wo; const AT* h = p.H + (size_t)r * D_MODEL;
        float g = 0.f, u = 0.f;
        for (int d = 0; d < D_MODEL; ++d) { const float hv = ldf(h, d); g += hv * wg[(size_t)d * D_EXPERT]; u += hv * wu[(size_t)d * D_EXPERT]; }
        p.ACT[i] = siluf_(g) * u * p.SELW[2 * r + k];
    } };
struct FMoeDown { Ptrs p; int l; int pad_;
    HD void operator()(long i) const {
        const int r = (int)(i / D_MODEL), d = (int)(i % D_MODEL);
        float acc = 0.f;
        for (int k = 0; k < 2; ++k) { const int e = p.SELI[2 * r + k];
            const float* wd = p.moe_w_down + ((size_t)l * N_EXPERTS + e) * D_EXPERT * D_MODEL + d; const float* a = p.ACT + ((size_t)r * 2 + k) * D_EXPERT;
            for (int j = 0; j < D_EXPERT; ++j) acc += a[j] * wd[(size_t)j * D_MODEL]; }
        p.X[i] += modp(p, l, row_bt(r), 5)[d] * acc;
    } };
struct FOut { Ptrs p; HD void operator()(long i) const { p.out[i] = p.X[i]; } };

struct GIn { Ptrs p; int l; int M, N, K;
    HD float a(int m, int k) const { return ldf(p.H, (size_t)m * D_MODEL + k); }
    HD float b(int k, int n) const { return p.w_in[((size_t)l * D_MODEL + k) * D_IN + n]; }
    HD void epi(int m, int n, float acc) const { stf(p.Z, (size_t)m * ZLD + n, acc); } };
struct GBranch { Ptrs p; int l, br; int M, N, K; int pad_;
    HD float a(int m, int k) const { return ldf(p.Y3, ((size_t)br * R_ALL + m) * BW + k); }
    HD float b(int k, int n) const { return p.w_branch[(((size_t)l * 3 + br) * BW + k) * D_MODEL + n]; }
    HD void epi(int m, int n, float acc) const { const float g = sigmoidf_(ldf(p.Z, (size_t)m * ZLD + ZO_GATE + br * D_MODEL + n)); float* o = p.MF + (size_t)m * D_MODEL + n; *o = (br ? *o : 0.f) + g * acc; } };
struct GOut { Ptrs p; int l; int M, N, K;
    HD float a(int m, int k) const { return p.MF[(size_t)m * D_MODEL + k]; }
    HD float b(int k, int n) const { return p.w_out[((size_t)l * D_MODEL + k) * D_MODEL + n]; }
    HD void epi(int m, int n, float acc) const { p.X[(size_t)m * D_MODEL + n] += modp(p, l, row_bt(m), 2)[n] * acc; } };

static_assert(sizeof(FNaAttn) % 8 == 0 && sizeof(GBranch) % 8 == 0 && sizeof(FRwDir) % 8 == 0 && sizeof(GIn) % 8 == 0 && sizeof(FMod) % 8 == 0, "no tail padding in by-value kernel arguments");
struct WsMap { size_t total; };
inline size_t ws_carve(Ptrs& p, char* base) {
    size_t off = 0;
    auto take = [&](size_t bytes) { char* q = base ? base + off : nullptr; off += (bytes + 255) & ~(size_t)255; return q; };
    p.MOD = (float*)take((size_t)DEPTH * NMOD * D6 * 4);
    p.X = (float*)take((size_t)R_ALL * D_MODEL * 4);
    p.RSTD = (float*)take((size_t)R_ALL * 4);
    p.H = (AT*)take((size_t)R_ALL * D_MODEL * sizeof(AT));
    p.Z = (ZT*)take((size_t)R_ALL * ZLD * sizeof(ZT));
    p.Y3 = (AT*)take((size_t)3 * R_ALL * BW * sizeof(AT));
    const size_t u0 = off;
    p.GQ = (float*)take((size_t)R_ALL * GLA_QK * 4); p.GK = (float*)take((size_t)R_ALL * GLA_QK * 4); p.GA = (float*)take((size_t)2 * R_ALL * GLA_QK * 4);
    p.GY = (float*)take((size_t)2 * R_ALL * GLA_V * 4);
    p.LOW = (float*)take((size_t)R_ALL * RW_LOW * 4);
    p.KK = (float*)take((size_t)R_ALL * RW_W * 4); p.RS = (float*)take((size_t)R_ALL * RW_W * 4); p.G = (float*)take((size_t)R_ALL * RW_W * 4);
    p.DEC = (float*)take((size_t)R_ALL * RW_W * 4); p.KD = (float*)take((size_t)R_ALL * RW_W * 4); p.BB = (float*)take((size_t)R_ALL * RW_W * 4);
    p.RY = (float*)take((size_t)2 * R_ALL * RW_W * 4);
    const size_t u1 = off; off = u0;
    p.MF = (float*)take((size_t)R_ALL * D_MODEL * 4);
    p.SELI = (int*)take((size_t)R_ALL * 2 * 4); p.SELW = (float*)take((size_t)R_ALL * 2 * 4);
    p.ACT = (float*)take((size_t)R_ALL * 2 * D_EXPERT * 4);
    if (off < u1) off = u1;
    return off;
}

template <class Exec> void run_forward(Exec& ex, const Ptrs& p) {
    ex.items(FMod{p}, (long)DEPTH * NMOD * D6);
    ex.items(FCopyX{p}, (long)R_ALL * D_MODEL);
    for (int l = 0; l < DEPTH; ++l) {
        const int ro = rows_out(l);
        ex.items(FRstd{p}, R_ALL);
        ex.items(FNormMod{p, l, 0}, (long)R_ALL * D_MODEL);
        ex.gemm(GIn{p, l, R_ALL, D_IN, D_MODEL});
        ex.items(FNaAttn{p, l}, (long)ro * NA_HEADS);
        ex.items(FGlaPrep{p, l}, (long)R_ALL * GLA_QK);
        ex.items(FGlaScan{p, l}, (long)BATCH * GLA_HEADS * 2 * GLA_DV);
        ex.items(FGlaFinish{p, l}, (long)ro * GLA_HEADS);
        ex.items(FRwLow{p, l}, (long)R_ALL * RW_LOW);
        ex.items(FRwHead{p, l}, (long)R_ALL * RW_HEADS);
        ex.items(FRwG{p, l}, (long)R_ALL * RW_W);
        for (int d = 0; d < 2; ++d) {
            ex.items(FRwDir{p, l, d}, (long)R_ALL * RW_W);
            ex.items(FRwScan{p, l, d}, (long)BATCH * RW_HEADS * RW_HEAD);
        }
        ex.items(FRwFinish{p, l}, (long)ro * RW_HEADS);
        ex.mark(l, 0);
        for (int br = 0; br < 3; ++br) ex.gemm(GBranch{p, l, br, ro, D_MODEL, BW});
        ex.gemm(GOut{p, l, ro, D_MODEL, D_MODEL});
        ex.mark(l, 1);
        ex.items(FRstd{p}, ro);
        ex.items(FRouter{p, l}, ro);
        ex.items(FNormMod{p, l, 1}, (long)ro * D_MODEL);
        ex.items(FMoeUp{p, l}, (long)ro * 2 * D_EXPERT);
        ex.items(FMoeDown{p, l}, (long)ro * D_MODEL);
        ex.mark(l, 2);
    }
    ex.items(FOut{p}, (long)R_LAT * D_MODEL);
}

inline void fill_inputs(Ptrs& p, void* const* d_in) {
    const float** f = (const float**)d_in;
    p.x = f[0]; p.c = f[1]; p.ctx = f[2]; p.c_ctx = f[3]; p.ada_w = f[4]; p.ada_b = f[5]; p.norm1_g = f[6]; p.norm2_g = f[7]; p.w_in = f[8];
    p.na_q_norm = f[9]; p.na_k_norm = f[10]; p.na_rpb = f[11]; p.gla_gate_w2 = f[12]; p.gla_gate_b = f[13]; p.gla_norm_g = f[14];
    p.rw_mu = f[15]; p.rw_w0 = f[16]; p.rw_w2 = f[17]; p.rw_a0 = f[18]; p.rw_a2 = f[19]; p.rw_g2 = f[20]; p.rw_k_k = f[21]; p.rw_k_a = f[22]; p.rw_r_k = f[23];
    p.rw_gn_g = f[24]; p.rw_gn_b = f[25]; p.w_branch = f[26]; p.w_out = f[27]; p.router_w = f[28]; p.router_bias = f[29];
    p.moe_w_gate = f[30]; p.moe_w_up = f[31]; p.moe_w_down = f[32];
}

#ifndef CPU_TEST
template <class F> __global__ void __launch_bounds__(256) k_items(F f, long n) {
    for (long i = (long)blockIdx.x * blockDim.x + threadIdx.x; i < n; i += (long)gridDim.x * blockDim.x) f(i);
}
template <class G> __global__ void __launch_bounds__(256) k_gemm(G g) {
    __shared__ float As[16][68], Bs[16][68];
    const int tid = threadIdx.x, tx = tid & 15, ty = tid >> 4;
    const int ntn = (g.N + 63) / 64; const int m0 = (blockIdx.x / ntn) * 64, n0 = (blockIdx.x % ntn) * 64;
    float acc[4][4];
#pragma unroll
    for (int i = 0; i < 4; ++i)
#pragma unroll
        for (int j = 0; j < 4; ++j) acc[i][j] = 0.f;
    for (int k0 = 0; k0 < g.K; k0 += 16) {
#pragma unroll
        for (int q = 0; q < 4; ++q) {
            { const int e = tid + q * 256, kk = e & 15, mm = e >> 4; const int m = m0 + mm, k = k0 + kk; As[kk][mm] = (m < g.M && k < g.K) ? g.a(m, k) : 0.f; }
            { const int e = tid + q * 256, nn = e & 63, kk = e >> 6; const int n = n0 + nn, k = k0 + kk; Bs[kk][nn] = (n < g.N && k < g.K) ? g.b(k, n) : 0.f; }
        }
        __syncthreads();
#pragma unroll
        for (int kk = 0; kk < 16; ++kk) {
            float av[4], bv[4];
#pragma unroll
            for (int i = 0; i < 4; ++i) { av[i] = As[kk][ty * 4 + i]; bv[i] = Bs[kk][tx * 4 + i]; }
#pragma unroll
            for (int i = 0; i < 4; ++i)
#pragma unroll
                for (int j = 0; j < 4; ++j) acc[i][j] += av[i] * bv[j];
        }
        __syncthreads();
    }
#pragma unroll
    for (int i = 0; i < 4; ++i)
#pragma unroll
        for (int j = 0; j < 4; ++j) { const int m = m0 + ty * 4 + i, n = n0 + tx * 4 + j; if (m < g.M && n < g.N) g.epi(m, n, acc[i][j]); }
}
struct GpuExec {
    hipStream_t st;
    void mark(int, int) {}
    template <class F> void items(const F& f, long n) {
        long blocks = (n + 255) / 256; if (blocks > 65536) blocks = 65536; if (blocks < 1) blocks = 1;
        hipLaunchKernelGGL(k_items<F>, dim3((unsigned)blocks), dim3(256), 0, st, f, n);
    }
    template <class G> void gemm(const G& g) {
        const int blocks = ((g.M + 63) / 64) * ((g.N + 63) / 64);
        hipLaunchKernelGGL(k_gemm<G>, dim3(blocks), dim3(256), 0, st, g);
    }
};

extern "C" void kernel_launch(void* const* d_in, const int* in_sizes, int n_in, void* d_out, int out_size, void* d_ws, size_t ws_size, hipStream_t stream) {
    Ptrs p{};
    fill_inputs(p, d_in);
    p.out = (float*)d_out;
    const size_t need = ws_carve(p, (char*)d_ws);
    if (need > ws_size) { fprintf(stderr, "workspace too small: need %zu have %zu\n", need, ws_size); return; }
    GpuExec ex{stream};
    run_forward(ex, p);
}
#endif
```

```cpp
#ifndef CPU_TEST
#include <hip/hip_runtime.h>
#define HD __host__ __device__ __forceinline__
#else
#define HD inline
#endif
#include <cmath>
#include <cstdint>
#include <cstddef>
#include <cstdio>

#ifdef CFG_SMALL
constexpr int D_MODEL = 48, BATCH = 2, GRID_W = 32, SEQ = 384, DEPTH = 2, CTX_LEN = 64;
constexpr int NA_HEADS = 2, NA_HD = 16;
constexpr int GLA_HEADS = 2, GLA_DK = 8, GLA_DV = 16, GLA_RANK = 4;
constexpr int RW_HEADS = 2, RW_HEAD = 16, RW_DR = 6, RW_AR = 6, RW_GR = 8;
constexpr int D_EXPERT = 12;
#else
constexpr int D_MODEL = 2048, BATCH = 4, GRID_W = 64, SEQ = 2048, DEPTH = 2, CTX_LEN = 256;
constexpr int NA_HEADS = 16, NA_HD = 64;
constexpr int GLA_HEADS = 4, GLA_DK = 128, GLA_DV = 256, GLA_RANK = 16;
constexpr int RW_HEADS = 16, RW_HEAD = 64, RW_DR = 96, RW_AR = 96, RW_GR = 256;
constexpr int D_EXPERT = 512;
#endif
constexpr int NA_WIN_R_MAX = 8, NA_WIN_C = 16;
constexpr int NA_W = NA_HEADS * NA_HD;
constexpr int GLA_QK = GLA_HEADS * GLA_DK, GLA_V = GLA_HEADS * GLA_DV;
constexpr float GLA_TAU = 16.0f;
constexpr int RW_W = RW_HEADS * RW_HEAD;
constexpr int RW_IN = 3 * RW_W + 2 * RW_DR + 2 * RW_AR + RW_GR;
constexpr int RW_LOW = 2 * RW_DR + 2 * RW_AR + RW_GR;
constexpr float RW_GN_EPS = 64e-5f;
constexpr int BW = NA_W;
static_assert(GLA_V == BW && RW_W == BW, "branch widths");
constexpr int N_EXPERTS = 16, N_GROUPS = 4, EPG = 4;
constexpr float EPS = 1e-6f;
constexpr int D6 = 6 * D_MODEL;
constexpr int ZO_NAQ = 0, ZO_NAK = NA_W, ZO_NAV = 2 * NA_W;
constexpr int ZO_GQ = 3 * NA_W, ZO_GK = ZO_GQ + GLA_QK, ZO_GV = ZO_GK + GLA_QK, ZO_GR = ZO_GV + GLA_V, ZO_GGD = ZO_GR + GLA_V;
constexpr int ZO_RW = ZO_GGD + 2 * GLA_RANK, ZO_GATE = ZO_RW + RW_IN, D_IN = ZO_GATE + 3 * D_MODEL;
constexpr int RO_R = 0, RO_K = RW_W, RO_V = 2 * RW_W, RO_WD = 3 * RW_W, RO_AD = RO_WD + 2 * RW_DR, RO_GD = RO_AD + 2 * RW_AR;
#ifdef CFG_SMALL
constexpr int ZLD = D_IN;
#else
constexpr int ZLD = 16128;
static_assert(D_IN == 16032, "D_IN");
#endif
constexpr int R_LAT = BATCH * SEQ, R_CTX = BATCH * CTX_LEN, R_ALL = R_LAT + R_CTX;
constexpr int NMOD = BATCH + 1;

typedef unsigned short bf16_t;
HD float bf2f(bf16_t b) { union { unsigned u; float f; } v; v.u = ((unsigned)b) << 16; return v.f; }
HD bf16_t f2bf(float f) { union { unsigned u; float f; } v; v.f = f; unsigned u = v.u; if ((u & 0x7fffffffu) > 0x7f800000u) return (bf16_t)0x7fc0; u += 0x7FFFu + ((u >> 16) & 1u); return (bf16_t)(u >> 16); }
HD float ldf(const float* p, size_t i) { return p[i]; }
HD float ldf(const bf16_t* p, size_t i) { return bf2f(p[i]); }
HD void stf(float* p, size_t i, float v) { p[i] = v; }
HD void stf(bf16_t* p, size_t i, float v) { p[i] = f2bf(v); }

#ifdef CPU_TEST
typedef float ZT; typedef float AT;
#else
typedef bf16_t ZT; typedef bf16_t AT;
#endif

HD float sigmoidf_(float x) { return 1.0f / (1.0f + expf(-x)); }
HD float siluf_(float x) { return x / (1.0f + expf(-x)); }
HD float softplusf_(float x) { return (x > 0.f ? x : 0.f) + log1pf(expf(-fabsf(x))); }

struct Ptrs {
    const float *x, *c, *ctx, *c_ctx, *ada_w, *ada_b, *norm1_g, *norm2_g, *w_in, *na_q_norm, *na_k_norm, *na_rpb, *gla_gate_w2, *gla_gate_b, *gla_norm_g,
        *rw_mu, *rw_w0, *rw_w2, *rw_a0, *rw_a2, *rw_g2, *rw_k_k, *rw_k_a, *rw_r_k, *rw_gn_g, *rw_gn_b, *w_branch, *w_out, *router_w, *router_bias,
        *moe_w_gate, *moe_w_up, *moe_w_down;
    float* out;
    float* MOD;
    float* X;
    float* RSTD;
    AT* H;
    ZT* Z;
    AT* Y3;
    float *GQ, *GK, *GA, *GY;
    float *LOW, *KK, *RS, *G, *DEC, *KD, *BB, *RY;
    float* MF;
    int* SELI;
    float* SELW;
    float* ACT;
    bf16_t *WT_IN, *WT_BR, *WT_OUT;
    bf16_t* MB;
    unsigned* BAR;
};

HD int row_bt(int r) { return r < R_LAT ? r / SEQ : BATCH; }
HD int rows_out(int l) { return l < DEPTH - 1 ? R_ALL : R_LAT; }
HD bool row_first(int r) { return r < R_LAT ? (r % SEQ == 0) : ((r - R_LAT) % CTX_LEN == 0); }
HD bool row_last(int r) { return r < R_LAT ? (r % SEQ == SEQ - 1) : ((r - R_LAT) % CTX_LEN == CTX_LEN - 1); }
HD const float* modp(const Ptrs& p, int l, int bt, int k) { return p.MOD + (((size_t)l * NMOD + bt) * 6 + k) * D_MODEL; }
HD int scan_row(int b, int d, int st) {
    if (st < CTX_LEN) return R_LAT + b * CTX_LEN + (d ? CTX_LEN - 1 - st : st);
    const int t = st - CTX_LEN; return b * SEQ + (d ? SEQ - 1 - t : t);
}

struct FMod { Ptrs p;
    HD void operator()(long i) const {
        const int j = (int)(i % D6); const int bt = (int)((i / D6) % NMOD); const int l = (int)(i / ((long)D6 * NMOD));
        const float* cv = bt < BATCH ? p.c + (size_t)bt * D_MODEL : p.c_ctx;
        const float* w = p.ada_w + (size_t)l * D_MODEL * D6 + j;
        float acc = p.ada_b[(size_t)l * D6 + j];
        for (int k = 0; k < D_MODEL; ++k) acc += siluf_(cv[k]) * w[(size_t)k * D6];
        p.MOD[((size_t)l * NMOD + bt) * D6 + j] = acc;
    } };
struct FCopyX { Ptrs p;
    HD void operator()(long i) const { const size_t n = (size_t)R_LAT * D_MODEL; p.X[i] = (size_t)i < n ? p.x[i] : p.ctx[i - n]; } };
struct FRstd { Ptrs p;
    HD void operator()(long r) const { const float* xr = p.X + (size_t)r * D_MODEL; float s = 0.f; for (int d = 0; d < D_MODEL; ++d) s += xr[d] * xr[d]; p.RSTD[r] = 1.0f / sqrtf(s / D_MODEL + EPS); } };
struct FNormMod { Ptrs p; int l, which;
    HD void operator()(long i) const {
        const int r = (int)(i / D_MODEL), d = (int)(i % D_MODEL); const int bt = row_bt(r);
        const float g = (which ? p.norm2_g : p.norm1_g)[(size_t)l * D_MODEL + d];
        const float sh = modp(p, l, bt, which ? 3 : 0)[d], sc = modp(p, l, bt, which ? 4 : 1)[d];
        stf(p.H, (size_t)i, p.X[i] * p.RSTD[r] * g * (1.0f + sc) + sh);
    } };

struct FNaAttn { Ptrs p; int l; int pad_;
    HD void operator()(long i) const {
        const int r = (int)(i / NA_HEADS), h = (int)(i % NA_HEADS);
        const ZT* zr = p.Z + (size_t)r * ZLD;
        float q[NA_HD], acc[NA_HD];
        float ssq = 0.f;
#pragma unroll
        for (int d = 0; d < NA_HD; ++d) { q[d] = ldf(zr, ZO_NAQ + h * NA_HD + d); ssq += q[d] * q[d]; }
        const float rq = 1.0f / sqrtf(ssq / NA_HD + EPS) * (1.0f / sqrtf((float)NA_HD));
#pragma unroll
        for (int d = 0; d < NA_HD; ++d) { q[d] = q[d] * rq * p.na_q_norm[l * NA_HD + d] * p.na_k_norm[l * NA_HD + d]; acc[d] = 0.f; }
        float m = -INFINITY, ls = 0.f;
        auto key = [&](int kr, float bias) {
            const ZT* zk = p.Z + (size_t)kr * ZLD;
            float dot = 0.f, ks = 0.f;
#pragma unroll
            for (int d = 0; d < NA_HD; ++d) { const float kv = ldf(zk, ZO_NAK + h * NA_HD + d); dot += q[d] * kv; ks += kv * kv; }
            const float s = dot / sqrtf(ks / NA_HD + EPS) + bias;
            const float mn = s > m ? s : m; const float corr = expf(m - mn), pe = expf(s - mn);
            ls = ls * corr + pe;
#pragma unroll
            for (int d = 0; d < NA_HD; ++d) acc[d] = acc[d] * corr + pe * ldf(zk, ZO_NAV + h * NA_HD + d);
            m = mn;
        };
        int b;
        if (r < R_LAT) {
            b = r / SEQ; const int t = r % SEQ, gr = t / GRID_W, gc = t % GRID_W;
            constexpr int n_rows = SEQ / GRID_W; constexpr int win_r = NA_WIN_R_MAX < n_rows ? NA_WIN_R_MAX : n_rows;
            int rs = gr - win_r / 2; rs = rs < 0 ? 0 : (rs > n_rows - win_r ? n_rows - win_r : rs);
            int cs = gc - NA_WIN_C / 2; cs = cs < 0 ? 0 : (cs > GRID_W - NA_WIN_C ? GRID_W - NA_WIN_C : cs);
            const float* rp = p.na_rpb + ((size_t)l * NA_HEADS + h) * (2 * NA_WIN_R_MAX - 1) * (2 * NA_WIN_C - 1);
            for (int n = 0; n < win_r; ++n)
                for (int j = 0; j < NA_WIN_C; ++j)
                    key(b * SEQ + (rs + n) * GRID_W + cs + j, rp[(rs + n - gr + NA_WIN_R_MAX - 1) * (2 * NA_WIN_C - 1) + (cs + j - gc + NA_WIN_C - 1)]);
        } else b = (r - R_LAT) / CTX_LEN;
        for (int c = 0; c < CTX_LEN; ++c) key(R_LAT + b * CTX_LEN + c, 0.f);
        const float inv = 1.0f / ls;
#pragma unroll
        for (int d = 0; d < NA_HD; ++d) stf(p.Y3, (size_t)r * BW + h * NA_HD + d, acc[d] * inv);
    } };

struct FGlaPrep { Ptrs p; int l; int pad_;
    HD void operator()(long i) const {
        const int r = (int)(i / GLA_QK), j = (int)(i % GLA_QK), ii = j % GLA_DK, hb = j - ii;
        const ZT* zr = p.Z + (size_t)r * ZLD;
        const float qs = 1.0f / sqrtf((float)GLA_DK);
        float qv = ldf(zr, ZO_GQ + j) * qs, kv = ldf(zr, ZO_GK + j);
        if (r < R_LAT) {
            constexpr int half = GLA_DK / 2, hh2 = half / 2;
            const int t = r % SEQ; const int sect = ii / half, i2 = ii % half, f = i2 % hh2;
            const float pos = (float)(sect == 0 ? t / GRID_W : t % GRID_W);
            const float ang = pos * powf(10000.0f, -(float)(2 * f) / (float)half);
            const float cs = cosf(ang), sn = sinf(ang);
            const int pj = hb + sect * half + (i2 < hh2 ? i2 + hh2 : i2 - hh2);
            const float qp = ldf(zr, ZO_GQ + pj) * qs, kp = ldf(zr, ZO_GK + pj);
            if (i2 < hh2) { qv = qv * cs - qp * sn; kv = kv * cs - kp * sn; } else { qv = qp * sn + qv * cs; kv = kp * sn + kv * cs; }
        }
        p.GQ[i] = qv; p.GK[i] = kv;
        for (int d = 0; d < 2; ++d) {
            float pre = p.gla_gate_b[((size_t)l * 2 + d) * GLA_QK + j];
            for (int k = 0; k < GLA_RANK; ++k) pre += ldf(zr, ZO_GGD + d * GLA_RANK + k) * p.gla_gate_w2[(((size_t)l * 2 + d) * GLA_RANK + k) * GLA_QK + j];
            p.GA[(size_t)d * R_ALL * GLA_QK + i] = expf(-softplusf_(-pre) / GLA_TAU);
        }
    } };
struct FGlaScan { Ptrs p; int l; int pad_;
    HD void operator()(long i) const {
        const int vc = (int)(i % GLA_DV); const int ch = (int)(i / GLA_DV); const int d = ch % 2, hh = (ch / 2) % GLA_HEADS, b = ch / (2 * GLA_HEADS);
        float s[GLA_DK];
#pragma unroll
        for (int k = 0; k < GLA_DK; ++k) s[k] = 0.f;
        const float* ga = p.GA + (size_t)d * R_ALL * GLA_QK;
        float* gy = p.GY + (size_t)d * R_ALL * GLA_V;
        for (int st = 0; st < CTX_LEN + SEQ; ++st) {
            const int r = scan_row(b, d, st);
            const size_t o = (size_t)r * GLA_QK + hh * GLA_DK;
            const float v = ldf(p.Z, (size_t)r * ZLD + ZO_GV + hh * GLA_DV + vc);
            float y = 0.f;
#pragma unroll
            for (int k = 0; k < GLA_DK; ++k) { s[k] = ga[o + k] * s[k] + p.GK[o + k] * v; y += p.GQ[o + k] * s[k]; }
            gy[(size_t)r * GLA_V + hh * GLA_DV + vc] = y;
        }
    } };
struct FGlaFinish { Ptrs p; int l; int pad_;
    HD void operator()(long i) const {
        const int r = (int)(i / GLA_HEADS), hh = (int)(i % GLA_HEADS);
        const size_t o = (size_t)r * GLA_V + hh * GLA_DV; const float* y0 = p.GY + o; const float* y1 = p.GY + (size_t)R_ALL * GLA_V + o;
        float ss = 0.f; for (int v = 0; v < GLA_DV; ++v) { const float y = y0[v] + y1[v]; ss += y * y; }
        const float rn = 1.0f / sqrtf(ss / GLA_DV + EPS);
        for (int v = 0; v < GLA_DV; ++v) {
            const float y = (y0[v] + y1[v]) * rn * p.gla_norm_g[(size_t)l * GLA_DV + v];
            stf(p.Y3, (size_t)R_ALL * BW + o + v, y * siluf_(ldf(p.Z, (size_t)r * ZLD + ZO_GR + hh * GLA_DV + v)));
        }
    } };

HD float rwz(const Ptrs& p, int l, int r, int col) {
    const size_t o = (size_t)r * ZLD + ZO_RW + col;
    const float z0 = ldf(p.Z, o), zp = row_first(r) ? 0.f : ldf(p.Z, o - ZLD), zn = row_last(r) ? 0.f : ldf(p.Z, o + ZLD);
    return z0 + p.rw_mu[(size_t)l * RW_IN + col] * (0.5f * (zp + zn) - z0);
}
struct FRwLow { Ptrs p; int l; int pad_;
    HD void operator()(long i) const {
        const int r = (int)(i / RW_LOW), q = (int)(i % RW_LOW);
        const float z = rwz(p, l, r, RO_WD + q);
        p.LOW[i] = q < 2 * RW_DR ? tanhf(z) : (q < 2 * RW_DR + 2 * RW_AR ? z : sigmoidf_(z));
    } };
struct FRwHead { Ptrs p; int l; int pad_;
    HD void operator()(long i) const {
        const int r = (int)(i / RW_HEADS), h = (int)(i % RW_HEADS);
        float ss = 0.f;
        for (int j = 0; j < RW_HEAD; ++j) { const float k = rwz(p, l, r, RO_K + h * RW_HEAD + j) * p.rw_k_k[(size_t)l * RW_W + h * RW_HEAD + j]; ss += k * k; }
        const float rn = 1.0f / sqrtf(ss + EPS);
        for (int j = 0; j < RW_HEAD; ++j) { const int c = h * RW_HEAD + j;
            p.KK[(size_t)r * RW_W + c] = rwz(p, l, r, RO_K + c) * p.rw_k_k[(size_t)l * RW_W + c] * rn;
            p.RS[(size_t)r * RW_W + c] = rwz(p, l, r, RO_R + c); }
    } };
struct FRwG { Ptrs p; int l; int pad_;
    HD void operator()(long i) const {
        const int r = (int)(i / RW_W), j = (int)(i % RW_W);
        const float* lo = p.LOW + (size_t)r * RW_LOW + 2 * RW_DR + 2 * RW_AR; float acc = 0.f;
        for (int q = 0; q < RW_GR; ++q) acc += lo[q] * p.rw_g2[((size_t)l * RW_GR + q) * RW_W + j];
        p.G[i] = acc;
    } };
struct FRwDir { Ptrs p; int l, d;
    HD void operator()(long i) const {
        const int r = (int)(i / RW_W), j = (int)(i % RW_W);
        const float* lo = p.LOW + (size_t)r * RW_LOW;
        float wpre = p.rw_w0[((size_t)l * 2 + d) * RW_W + j];
        for (int q = 0; q < RW_DR; ++q) wpre += lo[d * RW_DR + q] * p.rw_w2[(((size_t)l * 2 + d) * RW_DR + q) * RW_W + j];
        const float w_log = -softplusf_(-wpre) - 0.5f;
        float apre = p.rw_a0[((size_t)l * 2 + d) * RW_W + j];
        for (int q = 0; q < RW_AR; ++q) apre += lo[2 * RW_DR + d * RW_AR + q] * p.rw_a2[(((size_t)l * 2 + d) * RW_AR + q) * RW_W + j];
        const float a = sigmoidf_(apre);
        const float kraw = rwz(p, l, r, RO_K + j);
        p.DEC[i] = expf(-expf(w_log));
        p.KD[i] = kraw * (1.0f + (a - 1.0f) * p.rw_k_a[(size_t)l * RW_W + j]);
        p.BB[i] = p.KK[i] * a;
    } };
struct FRwScan { Ptrs p; int l, d;
    HD void operator()(long i) const {
        const int vi = (int)(i % RW_HEAD); const int bh = (int)(i / RW_HEAD); const int h = bh % RW_HEADS, b = bh / RW_HEADS;
        float s[RW_HEAD];
#pragma unroll
        for (int j = 0; j < RW_HEAD; ++j) s[j] = 0.f;
        float* ry = p.RY + (size_t)d * R_ALL * RW_W;
        for (int st = 0; st < CTX_LEN + SEQ; ++st) {
            const int r = scan_row(b, d, st);
            const size_t o = (size_t)r * RW_W + h * RW_HEAD;
            const float v = rwz(p, l, r, RO_V + h * RW_HEAD + vi);
            float sa = 0.f;
#pragma unroll
            for (int j = 0; j < RW_HEAD; ++j) sa += s[j] * p.KK[o + j];
            float y = 0.f;
#pragma unroll
            for (int j = 0; j < RW_HEAD; ++j) { s[j] = s[j] * p.DEC[o + j] - sa * p.BB[o + j] + v * p.KD[o + j]; y += s[j] * p.RS[o + j]; }
            ry[o + vi] = y;
        }
    } };
struct FRwFinish { Ptrs p; int l; int pad_;
    HD void operator()(long i) const {
        const int r = (int)(i / RW_HEADS), h = (int)(i % RW_HEADS);
        const size_t o = (size_t)r * RW_W + h * RW_HEAD; const float* y0 = p.RY + o; const float* y1 = p.RY + (size_t)R_ALL * RW_W + o;
        float mean = 0.f; for (int j = 0; j < RW_HEAD; ++j) mean += y0[j] + y1[j];
        mean /= RW_HEAD;
        float var = 0.f, bonus = 0.f;
        for (int j = 0; j < RW_HEAD; ++j) { const float dv = y0[j] + y1[j] - mean; var += dv * dv;
            bonus += p.RS[o + j] * rwz(p, l, r, RO_K + h * RW_HEAD + j) * p.rw_r_k[((size_t)l * RW_HEADS + h) * RW_HEAD + j]; }
        const float rn = 1.0f / sqrtf(var / RW_HEAD + RW_GN_EPS);
        for (int j = 0; j < RW_HEAD; ++j) { const int c = h * RW_HEAD + j;
            float y = (y0[j] + y1[j] - mean) * rn * p.rw_gn_g[(size_t)l * RW_W + c] + p.rw_gn_b[(size_t)l * RW_W + c];
            y += bonus * rwz(p, l, r, RO_V + c);
            stf(p.Y3, (size_t)2 * R_ALL * BW + (size_t)r * BW + c, y * p.G[(size_t)r * RW_W + c]); }
    } };

HD void route_select(const float (&lg)[N_EXPERTS], const float* router_bias, int& i1, int& i2, float& s1, float& s2) {
        float s[N_EXPERTS], bz[N_EXPERTS];
#pragma unroll
        for (int e = 0; e < N_EXPERTS; ++e) { s[e] = sigmoidf_(lg[e]); bz[e] = s[e] + router_bias[e]; }
        int gsel = 0; float gbest = -INFINITY;
#pragma unroll
        for (int gi = 0; gi < N_GROUPS; ++gi) {
            float m1 = -INFINITY, m2 = -INFINITY;
#pragma unroll
            for (int k = 0; k < EPG; ++k) { const float v = bz[gi * EPG + k]; if (v > m1) { m2 = m1; m1 = v; } else if (v > m2) m2 = v; }
            const float sc2 = m1 + m2; if (sc2 > gbest) { gbest = sc2; gsel = gi; }
        }
        int a1 = 0, a2 = 0; float t1 = 0.f, t2 = 0.f, v1 = -INFINITY, v2 = -INFINITY;
#pragma unroll
        for (int e = 0; e < N_EXPERTS; ++e) { const float v = (e / EPG == gsel) ? bz[e] : -INFINITY; const bool g1 = v > v1, g2 = v > v2;
            v2 = g1 ? v1 : (g2 ? v : v2); a2 = g1 ? a1 : (g2 ? e : a2); t2 = g1 ? t1 : (g2 ? s[e] : t2);
            v1 = g1 ? v : v1; a1 = g1 ? e : a1; t1 = g1 ? s[e] : t1; }
        i1 = a1; i2 = a2; s1 = t1; s2 = t2;
}
struct FRouter { Ptrs p; int l; int pad_;
    HD void operator()(long r) const {
        const int bt = row_bt((int)r); const float* xr = p.X + (size_t)r * D_MODEL; const float rstd = p.RSTD[r];
        const float* sh = modp(p, l, bt, 3); const float* sc = modp(p, l, bt, 4); const float* g = p.norm2_g + (size_t)l * D_MODEL;
        float lg[N_EXPERTS];
#pragma unroll
        for (int e = 0; e < N_EXPERTS; ++e) lg[e] = 0.f;
        for (int d = 0; d < D_MODEL; ++d) { const float h = xr[d] * rstd * g[d] * (1.0f + sc[d]) + sh[d]; const float* w = p.router_w + (size_t)d * N_EXPERTS;
#pragma unroll
            for (int e = 0; e < N_EXPERTS; ++e) lg[e] += h * w[e]; }
        int i1, i2; float s1, s2; route_select(lg, p.router_bias, i1, i2, s1, s2);
        const float inv = 1.0f / (s1 + s2);
        p.SELI[2 * r] = i1; p.SELI[2 * r + 1] = i2; p.SELW[2 * r] = s1 * inv; p.SELW[2 * r + 1] = s2 * inv;
    } };
struct FMoeUp { Ptrs p; int l; int pad_;
    HD void operator()(long i) const {
        const int j = (int)(i % D_EXPERT), k = (int)((i / D_EXPERT) % 2), r = (int)(i / (2 * D_EXPERT));
        const int e = p.SELI[2 * r + k];
        const size_t wo = ((size_t)l * N_EXPERTS + e) * D_MODEL * D_EXPERT + j;
        const float* wg = p.moe_w_gate + wo; const float* wu = p.moe_w_up + wo; const AT* h = p.H + (size_t)r * D_MODEL;
        float g = 0.f, u = 0.f;
        for (int d = 0; d < D_MODEL; ++d) { const float hv = ldf(h, d); g += hv * wg[(size_t)d * D_EXPERT]; u += hv * wu[(size_t)d * D_EXPERT]; }
        p.ACT[i] = siluf_(g) * u * p.SELW[2 * r + k];
    } };
struct FMoeDown { Ptrs p; int l; int pad_;
    HD void operator()(long i) const {
        const int r = (int)(i / D_MODEL), d = (int)(i % D_MODEL);
        float acc = 0.f;
        for (int k = 0; k < 2; ++k) { const int e = p.SELI[2 * r + k];
            const float* wd = p.moe_w_down + ((size_t)l * N_EXPERTS + e) * D_EXPERT * D_MODEL + d; const float* a = p.ACT + ((size_t)r * 2 + k) * D_EXPERT;
            for (int j = 0; j < D_EXPERT; ++j) acc += a[j] * wd[(size_t)j * D_MODEL]; }
        p.X[i] += modp(p, l, row_bt(r), 5)[d] * acc;
    } };
struct FOut { Ptrs p; HD void operator()(long i) const { p.out[i] = p.X[i]; } };

struct GIn { Ptrs p; int l; int M, N, K;
    HD float a(int m, int k) const { return ldf(p.H, (size_t)m * D_MODEL + k); }
    HD float b(int k, int n) const { return p.w_in[((size_t)l * D_MODEL + k) * D_IN + n]; }
    HD void epi(int m, int n, float acc) const { stf(p.Z, (size_t)m * ZLD + n, acc); } };
struct GBranch { Ptrs p; int l, br; int M, N, K; int pad_;
    HD float a(int m, int k) const { return ldf(p.Y3, ((size_t)br * R_ALL + m) * BW + k); }
    HD float b(int k, int n) const { return p.w_branch[(((size_t)l * 3 + br) * BW + k) * D_MODEL + n]; }
    HD void epi(int m, int n, float acc) const { const float g = sigmoidf_(ldf(p.Z, (size_t)m * ZLD + ZO_GATE + br * D_MODEL + n)); float* o = p.MF + (size_t)m * D_MODEL + n; *o = (br ? *o : 0.f) + g * acc; } };
struct GOut { Ptrs p; int l; int M, N, K;
    HD float a(int m, int k) const { return p.MF[(size_t)m * D_MODEL + k]; }
    HD float b(int k, int n) const { return p.w_out[((size_t)l * D_MODEL + k) * D_MODEL + n]; }
    HD void epi(int m, int n, float acc) const { p.X[(size_t)m * D_MODEL + n] += modp(p, l, row_bt(m), 2)[n] * acc; } };

static_assert(sizeof(FNaAttn) % 8 == 0 && sizeof(GBranch) % 8 == 0 && sizeof(FRwDir) % 8 == 0 && sizeof(GIn) % 8 == 0 && sizeof(FMod) % 8 == 0, "no tail padding in by-value kernel arguments");
struct WsMap { size_t total; };
inline size_t ws_carve(Ptrs& p, char* base) {
    size_t off = 0;
    auto take = [&](size_t bytes) { char* q = base ? base + off : nullptr; off += (bytes + 255) & ~(size_t)255; return q; };
    p.BAR = (unsigned*)take(16384);
    p.WT_IN = (bf16_t*)take((size_t)ZLD * D_MODEL * 2); p.WT_BR = (bf16_t*)take((size_t)3 * D_MODEL * BW * 2); p.WT_OUT = (bf16_t*)take((size_t)D_MODEL * D_MODEL * 2);
    p.MOD = (float*)take((size_t)DEPTH * NMOD * D6 * 4);
    p.X = (float*)take((size_t)R_ALL * D_MODEL * 4);
    p.RSTD = (float*)take((size_t)R_ALL * 4);
    p.H = (AT*)take((size_t)R_ALL * D_MODEL * sizeof(AT)); p.MB = (bf16_t*)p.H;
    p.Z = (ZT*)take((size_t)R_ALL * ZLD * sizeof(ZT));
    p.Y3 = (AT*)take((size_t)3 * R_ALL * BW * sizeof(AT));
    const size_t u0 = off;
    p.GQ = (float*)take((size_t)R_ALL * GLA_QK * 4); p.GK = (float*)take((size_t)R_ALL * GLA_QK * 4); p.GA = (float*)take((size_t)2 * R_ALL * GLA_QK * 4);
    p.GY = (float*)take((size_t)2 * R_ALL * GLA_V * 4);
    p.LOW = (float*)take((size_t)R_ALL * RW_LOW * 4);
    p.KK = (float*)take((size_t)R_ALL * RW_W * 4); p.RS = (float*)take((size_t)R_ALL * RW_W * 4); p.G = (float*)take((size_t)R_ALL * RW_W * 4);
    p.DEC = (float*)take((size_t)R_ALL * RW_W * 4); p.KD = (float*)take((size_t)R_ALL * RW_W * 4); p.BB = (float*)take((size_t)R_ALL * RW_W * 4);
    p.RY = (float*)take((size_t)2 * R_ALL * RW_W * 4);
    const size_t u1 = off; off = u0;
    p.MF = (float*)take((size_t)R_ALL * D_MODEL * 4);
    p.SELI = (int*)take((size_t)R_ALL * 2 * 4); p.SELW = (float*)take((size_t)R_ALL * 2 * 4);
    p.ACT = (float*)take((size_t)R_ALL * 2 * D_EXPERT * 4);
    if (off < u1) off = u1;
    return off;
}

template <class Exec> void run_forward(Exec& ex, const Ptrs& p) {
    ex.items(FMod{p}, (long)DEPTH * NMOD * D6);
    ex.items(FCopyX{p}, (long)R_ALL * D_MODEL);
    for (int l = 0; l < DEPTH; ++l) {
        const int ro = rows_out(l);
        ex.items(FRstd{p}, R_ALL);
        ex.items(FNormMod{p, l, 0}, (long)R_ALL * D_MODEL);
        ex.gemm(GIn{p, l, R_ALL, D_IN, D_MODEL});
        ex.items(FNaAttn{p, l}, (long)ro * NA_HEADS);
        ex.items(FGlaPrep{p, l}, (long)R_ALL * GLA_QK);
        ex.items(FGlaScan{p, l}, (long)BATCH * GLA_HEADS * 2 * GLA_DV);
        ex.items(FGlaFinish{p, l}, (long)ro * GLA_HEADS);
        ex.items(FRwLow{p, l}, (long)R_ALL * RW_LOW);
        ex.items(FRwHead{p, l}, (long)R_ALL * RW_HEADS);
        ex.items(FRwG{p, l}, (long)R_ALL * RW_W);
        for (int d = 0; d < 2; ++d) {
            ex.items(FRwDir{p, l, d}, (long)R_ALL * RW_W);
            ex.items(FRwScan{p, l, d}, (long)BATCH * RW_HEADS * RW_HEAD);
        }
        ex.items(FRwFinish{p, l}, (long)ro * RW_HEADS);
        ex.mark(l, 0);
        for (int br = 0; br < 3; ++br) ex.gemm(GBranch{p, l, br, ro, D_MODEL, BW});
        ex.gemm(GOut{p, l, ro, D_MODEL, D_MODEL});
        ex.mark(l, 1);
        ex.items(FRstd{p}, ro);
        ex.items(FRouter{p, l}, ro);
        ex.items(FNormMod{p, l, 1}, (long)ro * D_MODEL);
        ex.items(FMoeUp{p, l}, (long)ro * 2 * D_EXPERT);
        ex.items(FMoeDown{p, l}, (long)ro * D_MODEL);
        ex.mark(l, 2);
    }
    ex.items(FOut{p}, (long)R_LAT * D_MODEL);
}

inline void fill_inputs(Ptrs& p, void* const* d_in) {
    const float** f = (const float**)d_in;
    p.x = f[0]; p.c = f[1]; p.ctx = f[2]; p.c_ctx = f[3]; p.ada_w = f[4]; p.ada_b = f[5]; p.norm1_g = f[6]; p.norm2_g = f[7]; p.w_in = f[8];
    p.na_q_norm = f[9]; p.na_k_norm = f[10]; p.na_rpb = f[11]; p.gla_gate_w2 = f[12]; p.gla_gate_b = f[13]; p.gla_norm_g = f[14];
    p.rw_mu = f[15]; p.rw_w0 = f[16]; p.rw_w2 = f[17]; p.rw_a0 = f[18]; p.rw_a2 = f[19]; p.rw_g2 = f[20]; p.rw_k_k = f[21]; p.rw_k_a = f[22]; p.rw_r_k = f[23];
    p.rw_gn_g = f[24]; p.rw_gn_b = f[25]; p.w_branch = f[26]; p.w_out = f[27]; p.router_w = f[28]; p.router_bias = f[29];
    p.moe_w_gate = f[30]; p.moe_w_up = f[31]; p.moe_w_down = f[32];
}

#ifndef CPU_TEST
namespace pg8 {
#define PG8_LAS __attribute__((address_space(3)))
typedef unsigned short bf16_t;
typedef short bf16x8 __attribute__((ext_vector_type(8)));
typedef float f32x4 __attribute__((ext_vector_type(4)));
typedef unsigned u32x4 __attribute__((ext_vector_type(4)));
constexpr int BM = 256, BK = 64, HALF = 128, HTB = HALF * BK * 2  , STAGE_BYTES = 8 * HTB, NXCD = 8, WGM = 8;

__host__ __device__ __forceinline__ int lds_byte(int r, int c) { const int st = (r >> 4) * 2 + (c >> 5), rr = r & 15, cc = c & 31, ob = rr * 64 + cc * 2; return st * 1024 + (ob ^ (((ob >> 9) & 1) << 5)); }
__host__ __device__ __forceinline__ void stage_rc(int b, int& R, int& C) { const int st = b / 1024, sb = b % 1024, swz = sb ^ (((sb >> 9) & 1) << 5); R = (st >> 1) * 16 + swz / 64; C = (st & 1) * 32 + (swz % 64) / 2; }
__host__ __device__ __forceinline__ int perm32(int rho) { const int n = rho >> 4, i = rho & 15; return 8 * (i >> 2) + 4 * n + (i & 3); }

struct Unit { int pm, pn; };
struct Gemm { const bf16_t* A; const bf16_t* Bt; int M, N, K; };

struct StaticOrder {
    int nM, nN, nwg, G, c;
    __host__ __device__ void init(int M, int N, int G_, int c_) { nM = M / BM; nN = N / BM; nwg = nM * nN; G = G_; c = c_; }
    __host__ __device__ bool next(int i, Unit& u) const {
        const long L = (long)i * G + c; if (L >= nwg) return false;
        int wgid = (int)L; { const int q = nwg / NXCD, r = nwg % NXCD, xcd = wgid % NXCD, off = wgid / NXCD; wgid = (xcd < r ? xcd * (q + 1) : r * (q + 1) + (xcd - r) * q) + off; }
        const int nig = WGM * nN, gid = wgid / nig, fm = gid * WGM, gsz = (nM - fm) < WGM ? (nM - fm) : WGM;
        u.pm = fm + ((wgid % nig) % gsz); u.pn = (wgid % nig) / gsz; return true;
    }
    __device__ __forceinline__ void a_ready(const Unit&) const {}
    __device__ __forceinline__ void done(const Unit&) const {}
};

__device__ __forceinline__ unsigned cvt_pk_bf16(float lo, float hi) { unsigned r; asm volatile("v_cvt_pk_bf16_f32 %0, %1, %2" : "=v"(r) : "v"(lo), "v"(hi)); return r; }
template <class Epi, class Sched, bool ALIGN_EPI = false, bool SP2 = false>
__device__ __forceinline__ void gemm_phase(PG8_LAS unsigned char* lds, const Gemm g, const Sched& S, const Epi& E) {
    int tid_ = threadIdx.x; asm volatile("" : "+v"(tid_));
    const int tid = tid_, wid = __builtin_amdgcn_readfirstlane(tid >> 6), lane = tid & 63, wr = wid >> 2, wc = wid & 3, fr = lane & 15, fq = lane >> 4;
    const int K = g.K, nt = K / BK;
    unsigned voffA[2], voffB[2];
#pragma unroll
    for (int i = 0; i < 2; ++i) { int R, C; stage_rc(tid * 16 + i * 8192, R, C); const int Rb = Epi::PERM ? ((R & ~31) + perm32(R & 31)) : R;
        voffA[i] = (unsigned)(R * K + C) * 2u; voffB[i] = (unsigned)(Rb * K + C) * 2u; }
    const size_t kstep = (size_t)(BK * 2);
    const size_t hstep = (size_t)HALF * K * 2;
    const size_t tstep = 2 * hstep;
    const unsigned ldsw = (unsigned)wid * 1024u;
    const int aoff = lds_byte(wr * 64 + fr, fq * 8), boff = lds_byte(wc * 32 + fr, fq * 8);
#define PG8_SA(b, h) (((b) * 2 + (h)) * HTB)
#define PG8_SB(b, h) ((4 + (b) * 2 + (h)) * HTB)
#define PG8_STAGE(bufoff, gbase, voff) do { _Pragma("unroll") for (int _i = 0; _i < 2; ++_i) \
        __builtin_amdgcn_global_load_lds((const unsigned*)((const char*)(gbase) + (voff)[_i]), (PG8_LAS unsigned*)(lds + (bufoff) + ldsw + _i * 8192), 16, 0, 0); } while (0)
#define PG8_LDA(dst, b, h) do { _Pragma("unroll") for (int m = 0; m < 4; ++m) _Pragma("unroll") for (int k = 0; k < 2; ++k) dst[m][k] = *(const PG8_LAS bf16x8*)(lds + PG8_SA(b, h) + aoff + m * 2048 + k * 1024); } while (0)
#define PG8_LDB(dst, b, h) do { _Pragma("unroll") for (int n = 0; n < 2; ++n) _Pragma("unroll") for (int k = 0; k < 2; ++k) dst[n][k] = *(const PG8_LAS bf16x8*)(lds + PG8_SB(b, h) + boff + n * 2048 + k * 1024); } while (0)
#define PG8_MMA(ai, bj, At, Bt) do { __builtin_amdgcn_s_setprio(1); _Pragma("unroll") for (int m = 0; m < 4; ++m) _Pragma("unroll") for (int n = 0; n < 2; ++n) _Pragma("unroll") for (int k = 0; k < 2; ++k) \
        acc[ai][bj][m][n] = __builtin_amdgcn_mfma_f32_16x16x32_bf16(Bt[n][k], At[m][k], acc[ai][bj][m][n], 0, 0, 0); __builtin_amdgcn_s_setprio(0); } while (0)
#define PG8_WAIT_V(n) asm volatile("s_waitcnt vmcnt(" #n ")" ::: "memory")
#define PG8_WAIT_L(n) asm volatile("s_waitcnt lgkmcnt(" #n ")" ::: "memory")
#define PG8_BAR __builtin_amdgcn_s_barrier()
#define PG8_SCHED __builtin_amdgcn_sched_barrier(0)
    Unit cur, nxt; int ui = 0;
    if (!S.next(0, cur)) return;
    f32x4 acc[2][2][4][2];
#pragma unroll
    for (int a = 0; a < 2; ++a)
#pragma unroll
        for (int b = 0; b < 2; ++b)
#pragma unroll
            for (int m = 0; m < 4; ++m)
#pragma unroll
                for (int n = 0; n < 2; ++n) acc[a][b][m][n] = (f32x4){0.f, 0.f, 0.f, 0.f};
    bf16x8 At[4][2], B0[2][2], B1[2][2];
    const char* cA = (const char*)g.A + (size_t)cur.pm * tstep; const char* cB = (const char*)g.Bt + (size_t)cur.pn * tstep;
    S.a_ready(cur);
    if constexpr (SP2) {
        PG8_STAGE(PG8_SB(0, 0), cB, voffB); PG8_STAGE(PG8_SB(0, 1), cB + hstep, voffB); PG8_STAGE(PG8_SA(0, 0), cA, voffA); PG8_STAGE(PG8_SA(0, 1), cA + hstep, voffA);
        if (wr == 1) PG8_BAR;
        PG8_WAIT_V(2); PG8_BAR;
        PG8_STAGE(PG8_SB(1, 0), cB + kstep, voffB); PG8_STAGE(PG8_SA(1, 0), cA + kstep, voffA); PG8_STAGE(PG8_SB(1, 1), cB + hstep + kstep, voffB);
        PG8_WAIT_V(6); PG8_BAR;
    } else {
        PG8_STAGE(PG8_SB(0, 0), cB, voffB); PG8_STAGE(PG8_SA(0, 0), cA, voffA); PG8_STAGE(PG8_SB(0, 1), cB + hstep, voffB); PG8_STAGE(PG8_SA(0, 1), cA + hstep, voffA);
        if (wr == 1) PG8_BAR;
        PG8_WAIT_V(4); PG8_BAR;
        PG8_STAGE(PG8_SB(1, 0), cB + kstep, voffB); PG8_STAGE(PG8_SA(1, 0), cA + kstep, voffA); PG8_STAGE(PG8_SB(1, 1), cB + hstep + kstep, voffB);
        PG8_WAIT_V(6); PG8_BAR;
    }
    for (;;) {
        const bool has_next = S.next(ui + 1, nxt);
        const char* nA = has_next ? (const char*)g.A + (size_t)nxt.pm * tstep : cA; const char* nB = has_next ? (const char*)g.Bt + (size_t)nxt.pn * tstep : cB;
        for (int t = 0; t < nt; t += 2) {
            const bool last = (t == nt - 2);
            const char* a1 = cA + (size_t)(t + 1) * kstep;
            const char* a2 = last ? nA : cA + (size_t)(t + 2) * kstep; const char* b2 = last ? nB : cB + (size_t)(t + 2) * kstep;
            const char* a3 = a2 + kstep; const char* b3 = b2 + kstep;
            if (last && has_next) S.a_ready(nxt);
            if constexpr (SP2) {
            PG8_LDB(B0, 0, 0); PG8_LDB(B1, 0, 1); PG8_SCHED; PG8_LDA(At, 0, 0); PG8_STAGE(PG8_SA(1, 1), a1 + hstep, voffA);
            PG8_WAIT_V(8); PG8_WAIT_L(0); PG8_BAR; PG8_MMA(0, 0, At, B0); PG8_MMA(0, 1, At, B1); PG8_BAR; PG8_SCHED;
            PG8_LDA(At, 0, 1); PG8_STAGE(PG8_SB(0, 0), b2, voffB); PG8_STAGE(PG8_SB(0, 1), b2 + hstep, voffB); PG8_STAGE(PG8_SA(0, 0), a2, voffA);
            PG8_WAIT_V(8); PG8_WAIT_L(0); PG8_BAR; PG8_MMA(1, 0, At, B0); PG8_MMA(1, 1, At, B1); PG8_BAR; PG8_SCHED;
            PG8_LDB(B0, 1, 0); PG8_LDB(B1, 1, 1); PG8_SCHED; PG8_LDA(At, 1, 0); PG8_STAGE(PG8_SA(0, 1), a2 + hstep, voffA);
            PG8_WAIT_V(8); PG8_WAIT_L(0); PG8_BAR; PG8_MMA(0, 0, At, B0); PG8_MMA(0, 1, At, B1); PG8_BAR; PG8_SCHED;
            PG8_LDA(At, 1, 1); PG8_STAGE(PG8_SB(1, 0), b3, voffB); PG8_STAGE(PG8_SB(1, 1), b3 + hstep, voffB); PG8_STAGE(PG8_SA(1, 0), a3, voffA);
            PG8_WAIT_V(8); PG8_WAIT_L(0); PG8_BAR; PG8_MMA(1, 0, At, B0); PG8_MMA(1, 1, At, B1); PG8_BAR; PG8_SCHED;
            } else {
            PG8_LDB(B0, 0, 0); PG8_SCHED; PG8_LDA(At, 0, 0); PG8_STAGE(PG8_SA(1, 1), a1 + hstep, voffA);
            PG8_WAIT_L(8); PG8_BAR; PG8_WAIT_L(0); PG8_MMA(0, 0, At, B0); PG8_BAR; PG8_SCHED;
            PG8_LDB(B1, 0, 1); PG8_STAGE(PG8_SB(0, 0), b2, voffB);
            PG8_BAR; PG8_WAIT_L(0); PG8_MMA(0, 1, At, B1); PG8_BAR;
            PG8_LDA(At, 0, 1); PG8_STAGE(PG8_SA(0, 0), a2, voffA);
            PG8_BAR; PG8_WAIT_L(0); PG8_MMA(1, 0, At, B0); PG8_BAR; PG8_SCHED;
            PG8_STAGE(PG8_SB(0, 1), b2 + hstep, voffB);
            PG8_WAIT_V(6); PG8_BAR; PG8_MMA(1, 1, At, B1); PG8_BAR;
            PG8_LDB(B0, 1, 0); PG8_SCHED; PG8_LDA(At, 1, 0); PG8_STAGE(PG8_SA(0, 1), a2 + hstep, voffA);
            PG8_WAIT_L(8); PG8_BAR; PG8_WAIT_L(0); PG8_MMA(0, 0, At, B0); PG8_BAR; PG8_SCHED;
            PG8_LDB(B1, 1, 1); PG8_STAGE(PG8_SB(1, 0), b3, voffB);
            PG8_BAR; PG8_WAIT_L(0); PG8_MMA(0, 1, At, B1); PG8_BAR;
            PG8_LDA(At, 1, 1); PG8_STAGE(PG8_SA(1, 0), a3, voffA);
            PG8_BAR; PG8_WAIT_L(0); PG8_MMA(1, 0, At, B0); PG8_BAR; PG8_SCHED;
            PG8_STAGE(PG8_SB(1, 1), b3 + hstep, voffB);
            PG8_WAIT_V(6); PG8_BAR; PG8_MMA(1, 1, At, B1); PG8_BAR;
            }
        }
        if constexpr (ALIGN_EPI) { if (wr == 0) PG8_BAR; }
        if constexpr (!Epi::AFTER_DRAIN) { E(acc, cur, wr, wc, fr, fq); S.done(cur); }
        if (!has_next) break;
#pragma unroll
        for (int a = 0; a < 2; ++a)
#pragma unroll
            for (int b = 0; b < 2; ++b)
#pragma unroll
                for (int m = 0; m < 4; ++m)
#pragma unroll
                    for (int n = 0; n < 2; ++n) acc[a][b][m][n] = (f32x4){0.f, 0.f, 0.f, 0.f};
        cur = nxt; cA = nA; cB = nB; ++ui;
        if constexpr (ALIGN_EPI) { if (wr == 1) PG8_BAR; }
    }
    PG8_WAIT_V(0);
    if constexpr (!ALIGN_EPI) { if (wr == 0) PG8_BAR; }
    PG8_BAR;
    if constexpr (Epi::AFTER_DRAIN) { E.fused(acc, cur, wr, wc, fr, fq, lds, wid, lane); S.done(cur); }
#undef PG8_SA
#undef PG8_SB
#undef PG8_STAGE
#undef PG8_LDA
#undef PG8_LDB
#undef PG8_MMA
#undef PG8_WAIT_V
#undef PG8_WAIT_L
#undef PG8_BAR
#undef PG8_SCHED
}
}
#define XB_TMO      128
#define XB_XCNT(j)  (256  + 64 * (j))
#define XB_XSUB(j)  (1280 + 64 * (j))
#define XB_XGEN(j)  (2304 + 64 * (j))
#define XB_TOP      3328
#define XB_TOPGEN   3392
#define XCD_BAR_WORDS 3456
#define XB_SPIN_CAP (1u << 18)
#define LAS __attribute__((address_space(3)))

__device__ __forceinline__ unsigned xb_ld(unsigned* p)              { return __hip_atomic_load(p, __ATOMIC_RELAXED, __HIP_MEMORY_SCOPE_AGENT); }
__device__ __forceinline__ unsigned xb_add(unsigned* p, unsigned v) { return __hip_atomic_fetch_add(p, v, __ATOMIC_RELAXED, __HIP_MEMORY_SCOPE_AGENT); }
__device__ __forceinline__ unsigned xb_xcc_id() { return (unsigned)__builtin_amdgcn_s_getreg((3 << 11) | 20) & 0xFu; }
#define XB_SPIN(cond, bar) do { unsigned _sp = 0; while (cond) { __builtin_amdgcn_s_sleep(1); \
    if ((++_sp & 255u) == 0u) { if (xb_ld(&(bar)[XB_TMO])) break; if (_sp > XB_SPIN_CAP) { atomicAdd(&(bar)[XB_TMO], 1u); break; } } } } while (0)

struct XcdBarrier {
    unsigned* bar; unsigned x;
    volatile LAS unsigned* st;
};

__device__ __forceinline__ XcdBarrier xcd_barrier_post(unsigned* bar, volatile LAS unsigned* st) {
    XcdBarrier b; b.bar = bar; b.x = xb_xcc_id(); b.st = st;
    if (threadIdx.x == 0) (void)xb_add(&bar[XB_XCNT(b.x)], 1u);
    return b;
}
__device__ __forceinline__ void xcd_barrier_complete(unsigned* bar, unsigned x, unsigned& nloc, unsigned& nx) {
    const unsigned G = gridDim.x * gridDim.y * gridDim.z;
    unsigned sum, cnt, mine, sp = 0u;
    for (;;) {
        sum = 0u; cnt = 0u; mine = 0u;
#pragma unroll
        for (unsigned j = 0; j < 16; ++j) { const unsigned c = xb_ld(&bar[XB_XCNT(j)]); sum += c; cnt += (c > 0u) ? 1u : 0u; mine = (j == x) ? c : mine; }
        if (sum == G) break;
        __builtin_amdgcn_s_sleep(1);
        if ((++sp & 255u) == 0u) { if (xb_ld(&bar[XB_TMO])) break; if (sp > XB_SPIN_CAP) { atomicAdd(&bar[XB_TMO], 1u); break; } }
    }
    nloc = mine > 0u ? mine : 1u; nx = cnt > 0u ? cnt : 1u;
}

__device__ __forceinline__ void xcd_barrier(const XcdBarrier& b) {
    asm volatile("s_waitcnt vmcnt(0)" ::: "memory");
    __syncthreads();
    if (threadIdx.x == 0) {
        unsigned* bar = b.bar;
        __builtin_amdgcn_s_waitcnt(0);
        unsigned nloc = b.st[0], nx = b.st[1];
        if (nloc == 0u) { xcd_barrier_complete(bar, b.x, nloc, nx); b.st[0] = nloc; b.st[1] = nx; }
        const unsigned old = xb_add(&bar[XB_XSUB(b.x)], 1u);
        const unsigned gen = old / nloc;
        if (old + 1u == (gen + 1u) * nloc) {
            __builtin_amdgcn_fence(__ATOMIC_RELEASE, "agent");
            asm volatile("s_waitcnt vmcnt(0)" ::: "memory");
            const unsigned og = xb_add(&bar[XB_TOP], 1u);
            const unsigned tg = og / nx;
            if (og + 1u == (tg + 1u) * nx) xb_add(&bar[XB_TOPGEN], 1u);
            else XB_SPIN(xb_ld(&bar[XB_TOPGEN]) == tg, bar);
            __builtin_amdgcn_fence(__ATOMIC_ACQUIRE, "agent");
            xb_add(&bar[XB_XGEN(b.x)], 1u);
            asm volatile("s_waitcnt vmcnt(0)" ::: "memory");
        } else {
            XB_SPIN(xb_ld(&bar[XB_XGEN(b.x)]) == gen, bar);
            __builtin_amdgcn_fence(__ATOMIC_ACQUIRE, "agent");
            asm volatile("s_waitcnt vmcnt(0)" ::: "memory");
        }
    }
    __syncthreads();
}

constexpr int MEGA_THREADS = 512;
constexpr int LDS_BYTES = pg8::STAGE_BYTES + 16;
typedef float f32x4 __attribute__((ext_vector_type(4)));
typedef unsigned u32x4 __attribute__((ext_vector_type(4)));
typedef unsigned u32x2 __attribute__((ext_vector_type(2)));

__device__ __forceinline__ int opaque_tid() { int t = threadIdx.x; asm volatile("" : "+v"(t)); return t; }
template <class F> __device__ __forceinline__ void run_items(const F& f, long n) {
    const int tid = opaque_tid(); const int lane = tid & 63, w = tid >> 6;
    const long nw = (long)gridDim.x * (MEGA_THREADS / 64);
    for (long gw = (long)w * gridDim.x + blockIdx.x; gw * 64 < n; gw += nw) { const long i = gw * 64 + lane; if (i < n) f(i); }
}

__device__ __forceinline__ float wave_sum(float v) {
#pragma unroll
    for (int o = 32; o > 0; o >>= 1) v += __shfl_xor(v, o, 64);
    return v;
}

__device__ __forceinline__ void norm_rows(const Ptrs& p, int l, int which, int nrows) {
    static_assert(D_MODEL == 2048, "norm_rows lane mapping");
    const int tid = opaque_tid(); const int lane = tid & 63, w = tid >> 6;
    const float* gain = (which ? p.norm2_g : p.norm1_g) + (size_t)l * D_MODEL;
    for (int r = w * gridDim.x + blockIdx.x; r < nrows; r += gridDim.x * (MEGA_THREADS / 64)) {
        const f32x4* xr = (const f32x4*)(p.X + (size_t)r * D_MODEL);
        f32x4 v[8]; float ss = 0.f;
#pragma unroll
        for (int i = 0; i < 8; ++i) { v[i] = xr[lane + 64 * i]; ss += v[i][0] * v[i][0] + v[i][1] * v[i][1] + v[i][2] * v[i][2] + v[i][3] * v[i][3]; }
        ss = wave_sum(ss);
        const float rstd = 1.0f / sqrtf(ss / D_MODEL + EPS);
        const int bt = row_bt(r);
        const f32x4* sh = (const f32x4*)modp(p, l, bt, which ? 3 : 0); const f32x4* sc = (const f32x4*)modp(p, l, bt, which ? 4 : 1); const f32x4* g4 = (const f32x4*)gain;
        float lg[N_EXPERTS];
#pragma unroll
        for (int e = 0; e < N_EXPERTS; ++e) lg[e] = 0.f;
#pragma unroll
        for (int i = 0; i < 8; ++i) {
            const int c = lane + 64 * i; const f32x4 g = g4[c], s = sc[c], b = sh[c]; f32x4 h;
#pragma unroll
            for (int k = 0; k < 4; ++k) h[k] = v[i][k] * rstd * g[k] * (1.0f + s[k]) + b[k];
            u32x2 pk; pk[0] = pg8::cvt_pk_bf16(h[0], h[1]); pk[1] = pg8::cvt_pk_bf16(h[2], h[3]);
            *(u32x2*)(p.H + (size_t)r * D_MODEL + 4 * c) = pk;
            if (which) {
#pragma unroll
                for (int k = 0; k < 4; ++k) { const f32x4* rw = (const f32x4*)(p.router_w + (size_t)(4 * c + k) * N_EXPERTS);
#pragma unroll
                    for (int q = 0; q < 4; ++q) { const f32x4 wv = rw[q]; lg[4 * q] += h[k] * wv[0]; lg[4 * q + 1] += h[k] * wv[1]; lg[4 * q + 2] += h[k] * wv[2]; lg[4 * q + 3] += h[k] * wv[3]; } }
            }
        }
        if (which) {
#pragma unroll
            for (int e = 0; e < N_EXPERTS; ++e) lg[e] = wave_sum(lg[e]);
            if (lane == 0) { int i1, i2; float s1, s2; route_select(lg, p.router_bias, i1, i2, s1, s2); const float inv = 1.0f / (s1 + s2);
                p.SELI[2 * r] = i1; p.SELI[2 * r + 1] = i2; p.SELW[2 * r] = s1 * inv; p.SELW[2 * r + 1] = s2 * inv; }
        }
    }
}

__device__ __forceinline__ void conv_wT(const float* __restrict__ W, bf16_t* __restrict__ Wt, int K, int N, int Npad, float* tile) {
    const int tn = Npad / 64, tk = K / 64, tid = opaque_tid();
    for (int t = blockIdx.x; t < tn * tk; t += gridDim.x) {
        const int nb = (t % tn) * 64, kb = (t / tn) * 64;
        { const int n = tid & 63, k0 = tid >> 6;
#pragma unroll
          for (int i = 0; i < 8; ++i) { const int k = k0 + 8 * i; tile[k * 65 + n] = (nb + n < N) ? W[(size_t)(kb + k) * N + nb + n] : 0.f; } }
        __syncthreads();
        { const int kp = (tid & 31) * 2, n0 = tid >> 5;
#pragma unroll
          for (int i = 0; i < 4; ++i) { const int n = n0 + 16 * i; *(unsigned*)(Wt + (size_t)(nb + n) * K + kb + kp) = pg8::cvt_pk_bf16(tile[kp * 65 + n], tile[(kp + 1) * 65 + n]); } }
        __syncthreads();
    }
}

struct EpiZ {
    static constexpr bool PERM = true, AFTER_DRAIN = false;
    bf16_t* O;
    __device__ __forceinline__ void operator()(const f32x4 (&acc)[2][2][4][2], const pg8::Unit& u, int wr, int wc, int fr, int fq) const {
        const int row0 = u.pm * 256 + wr * 64 + fr, col0 = u.pn * 256 + wc * 32 + 8 * fq;
#pragma unroll
        for (int ai = 0; ai < 2; ++ai)
#pragma unroll
            for (int m = 0; m < 4; ++m) { bf16_t* rowp = O + (size_t)(row0 + ai * 128 + m * 16) * ZLD + col0;
#pragma unroll
                for (int bj = 0; bj < 2; ++bj) { const f32x4 v0 = acc[ai][bj][m][0], v1 = acc[ai][bj][m][1];
                    u32x4 pk; pk[0] = pg8::cvt_pk_bf16(v0[0], v0[1]); pk[1] = pg8::cvt_pk_bf16(v0[2], v0[3]); pk[2] = pg8::cvt_pk_bf16(v1[0], v1[1]); pk[3] = pg8::cvt_pk_bf16(v1[2], v1[3]);
                    *(u32x4*)(rowp + bj * 128) = pk; } }
    }
};
template <int BR> struct EpiBranch {
    static constexpr bool PERM = false, AFTER_DRAIN = false;
    const bf16_t* Z; float* MF; bf16_t* MB;
    __device__ __forceinline__ void operator()(const f32x4 (&acc)[2][2][4][2], const pg8::Unit& u, int wr, int wc, int fr, int fq) const {
        const int row0 = u.pm * 256 + wr * 64 + fr, col0 = u.pn * 256 + wc * 32 + 4 * fq;
#pragma unroll
        for (int ai = 0; ai < 2; ++ai)
#pragma unroll
            for (int m = 0; m < 4; ++m) { const size_t row = (size_t)(row0 + ai * 128 + m * 16);
#pragma unroll
                for (int bj = 0; bj < 2; ++bj)
#pragma unroll
                    for (int n = 0; n < 2; ++n) { const int col = col0 + bj * 128 + n * 16;
                        const u32x2 gz = *(const u32x2*)(Z + row * ZLD + ZO_GATE + BR * D_MODEL + col);
                        f32x4 g; g[0] = __uint_as_float(gz[0] << 16); g[1] = __uint_as_float(gz[0] & 0xffff0000u); g[2] = __uint_as_float(gz[1] << 16); g[3] = __uint_as_float(gz[1] & 0xffff0000u);
                        f32x4 val;
#pragma unroll
                        for (int k = 0; k < 4; ++k) val[k] = acc[ai][bj][m][n][k] / (1.0f + __expf(-g[k]));
                        float* mp = MF + row * D_MODEL + col;
                        if (BR > 0) val += *(const f32x4*)mp;
                        if (BR < 2) *(f32x4*)mp = val;
                        else { u32x2 pk; pk[0] = pg8::cvt_pk_bf16(val[0], val[1]); pk[1] = pg8::cvt_pk_bf16(val[2], val[3]); *(u32x2*)(MB + row * D_MODEL + col) = pk; } }
            }
    }
};
struct EpiOut {
    static constexpr bool PERM = false, AFTER_DRAIN = false;
    float* X; const float* MODL;
    __device__ __forceinline__ void operator()(const f32x4 (&acc)[2][2][4][2], const pg8::Unit& u, int wr, int wc, int fr, int fq) const {
        const int row0 = u.pm * 256 + wr * 64 + fr, col0 = u.pn * 256 + wc * 32 + 4 * fq;
#pragma unroll
        for (int ai = 0; ai < 2; ++ai)
#pragma unroll
            for (int m = 0; m < 4; ++m) { const int row = row0 + ai * 128 + m * 16; const float* g1 = MODL + ((size_t)row_bt(row) * 6 + 2) * D_MODEL;
#pragma unroll
                for (int bj = 0; bj < 2; ++bj)
#pragma unroll
                    for (int n = 0; n < 2; ++n) { const int col = col0 + bj * 128 + n * 16; float* xp = X + (size_t)row * D_MODEL + col;
                        *(f32x4*)xp = *(const f32x4*)xp + *(const f32x4*)(g1 + col) * acc[ai][bj][m][n]; }
            }
    }
};

template <class Epi> __device__ __forceinline__ void gemm_call(LAS unsigned char* lds, const bf16_t* A, const bf16_t* Bt, int M, int N, int K, const Epi& E) {
    pg8::Gemm g{A, Bt, M, N, K}; pg8::StaticOrder S; S.init(M, N, (int)gridDim.x, (int)blockIdx.x);
    pg8::gemm_phase<Epi, pg8::StaticOrder, true, true>(lds, g, S, E);
}

__global__ void __launch_bounds__(MEGA_THREADS, 2) mega_fwd(Ptrs p) {
    extern __shared__ __attribute__((aligned(16))) unsigned char smem[];
    LAS unsigned char* lds = (LAS unsigned char*)smem;
    volatile LAS unsigned* stw = (volatile LAS unsigned*)(lds + pg8::STAGE_BYTES);
    if (threadIdx.x < 4) stw[threadIdx.x] = 0u;
    __syncthreads();
    const XcdBarrier bar = xcd_barrier_post(p.BAR, stw);
#define GRID_SYNC() xcd_barrier(bar)

    run_items(FMod{p}, (long)DEPTH * NMOD * D6);
    run_items(FCopyX{p}, (long)R_ALL * D_MODEL);
    for (int l = 0; l < DEPTH; ++l) {
        const int ro = rows_out(l);
        conv_wT(p.w_in + (size_t)l * D_MODEL * D_IN, p.WT_IN, D_MODEL, D_IN, ZLD, (float*)smem);
        for (int br = 0; br < 3; ++br) conv_wT(p.w_branch + ((size_t)l * 3 + br) * BW * D_MODEL, p.WT_BR + (size_t)br * D_MODEL * BW, BW, D_MODEL, D_MODEL, (float*)smem);
        conv_wT(p.w_out + (size_t)l * D_MODEL * D_MODEL, p.WT_OUT, D_MODEL, D_MODEL, D_MODEL, (float*)smem);
        GRID_SYNC();
        norm_rows(p, l, 0, R_ALL);
        GRID_SYNC();
        gemm_call(lds, p.H, p.WT_IN, R_ALL, ZLD, D_MODEL, EpiZ{p.Z});
        GRID_SYNC();
        run_items(FNaAttn{p, l}, (long)ro * NA_HEADS);
        run_items(FGlaPrep{p, l}, (long)R_ALL * GLA_QK);
        run_items(FRwLow{p, l}, (long)R_ALL * RW_LOW);
        run_items(FRwHead{p, l}, (long)R_ALL * RW_HEADS);
        GRID_SYNC();
        run_items(FGlaScan{p, l}, (long)BATCH * GLA_HEADS * 2 * GLA_DV);
        run_items(FRwG{p, l}, (long)R_ALL * RW_W);
        run_items(FRwDir{p, l, 0}, (long)R_ALL * RW_W);
        GRID_SYNC();
        run_items(FRwScan{p, l, 0}, (long)BATCH * RW_HEADS * RW_HEAD);
        GRID_SYNC();
        run_items(FRwDir{p, l, 1}, (long)R_ALL * RW_W);
        GRID_SYNC();
        run_items(FRwScan{p, l, 1}, (long)BATCH * RW_HEADS * RW_HEAD);
        GRID_SYNC();
        run_items(FGlaFinish{p, l}, (long)ro * GLA_HEADS);
        run_items(FRwFinish{p, l}, (long)ro * RW_HEADS);
        GRID_SYNC();
        gemm_call(lds, p.Y3, p.WT_BR, ro, D_MODEL, BW, EpiBranch<0>{p.Z, p.MF, p.MB});
        GRID_SYNC();
        gemm_call(lds, p.Y3 + (size_t)R_ALL * BW, p.WT_BR + (size_t)D_MODEL * BW, ro, D_MODEL, BW, EpiBranch<1>{p.Z, p.MF, p.MB});
        GRID_SYNC();
        gemm_call(lds, p.Y3 + (size_t)2 * R_ALL * BW, p.WT_BR + (size_t)2 * D_MODEL * BW, ro, D_MODEL, BW, EpiBranch<2>{p.Z, p.MF, p.MB});
        GRID_SYNC();
        gemm_call(lds, p.MB, p.WT_OUT, ro, D_MODEL, D_MODEL, EpiOut{p.X, p.MOD + (size_t)l * NMOD * D6});
        GRID_SYNC();
        norm_rows(p, l, 1, ro);
        GRID_SYNC();
        run_items(FMoeUp{p, l}, (long)ro * 2 * D_EXPERT);
        GRID_SYNC();
        run_items(FMoeDown{p, l}, (long)ro * D_MODEL);
        GRID_SYNC();
    }
    run_items(FOut{p}, (long)R_LAT * D_MODEL);
#undef GRID_SYNC
}

extern "C" void kernel_launch(void* const* d_in, const int* in_sizes, int n_in, void* d_out, int out_size, void* d_ws, size_t ws_size, hipStream_t stream) {
    static int grid = 0;
    Ptrs p{};
    fill_inputs(p, d_in);
    p.out = (float*)d_out;
    const size_t need = ws_carve(p, (char*)d_ws);
    if (grid == 0) {
        if (need > ws_size || n_in != 33) { fprintf(stderr, "kernel_launch: workspace %zu < %zu or n_in %d != 33; nothing launched\n", ws_size, need, n_in); grid = -1; return; }
        int dev = 0, cus = 0, per_cu = 0;
        if (hipGetDevice(&dev) != hipSuccess || hipDeviceGetAttribute(&cus, hipDeviceAttributeMultiprocessorCount, dev) != hipSuccess) { grid = -1; return; }
        if (hipFuncSetAttribute((const void*)mega_fwd, hipFuncAttributeMaxDynamicSharedMemorySize, LDS_BYTES) != hipSuccess) { fprintf(stderr, "kernel_launch: hipFuncSetAttribute failed\n"); grid = -1; return; }
        if (hipOccupancyMaxActiveBlocksPerMultiprocessor(&per_cu, (const void*)mega_fwd, MEGA_THREADS, LDS_BYTES) != hipSuccess || per_cu < 1) { fprintf(stderr, "kernel_launch: occupancy query says %d blocks per CU; nothing launched\n", per_cu); (void)hipGetLastError(); grid = -1; return; }
        grid = cus;
    }
    if (grid < 0) return;
    (void)hipMemsetAsync(p.BAR, 0, 16384, stream);
    hipLaunchKernelGGL(mega_fwd, dim3(grid), dim3(MEGA_THREADS), LDS_BYTES, stream, p);
}
#endif
```

```cpp
#ifndef CPU_TEST
#include <hip/hip_runtime.h>
#define HD __host__ __device__ __forceinline__
#else
#define HD inline
#endif
#include <cmath>
#include <cstdint>
#include <cstddef>
#include <cstdio>

#ifdef CFG_SMALL
constexpr int D_MODEL = 48, BATCH = 2, GRID_W = 32, SEQ = 384, DEPTH = 2, CTX_LEN = 64;
constexpr int NA_HEADS = 2, NA_HD = 16;
constexpr int GLA_HEADS = 2, GLA_DK = 8, GLA_DV = 16, GLA_RANK = 4;
constexpr int RW_HEADS = 2, RW_HEAD = 16, RW_DR = 6, RW_AR = 6, RW_GR = 8;
constexpr int D_EXPERT = 12;
#else
constexpr int D_MODEL = 2048, BATCH = 4, GRID_W = 64, SEQ = 2048, DEPTH = 2, CTX_LEN = 256;
constexpr int NA_HEADS = 16, NA_HD = 64;
constexpr int GLA_HEADS = 4, GLA_DK = 128, GLA_DV = 256, GLA_RANK = 16;
constexpr int RW_HEADS = 16, RW_HEAD = 64, RW_DR = 96, RW_AR = 96, RW_GR = 256;
constexpr int D_EXPERT = 512;
#endif
constexpr int NA_WIN_R_MAX = 8, NA_WIN_C = 16;
constexpr int NA_W = NA_HEADS * NA_HD;
constexpr int GLA_QK = GLA_HEADS * GLA_DK, GLA_V = GLA_HEADS * GLA_DV;
constexpr float GLA_TAU = 16.0f;
constexpr int RW_W = RW_HEADS * RW_HEAD;
constexpr int RW_IN = 3 * RW_W + 2 * RW_DR + 2 * RW_AR + RW_GR;
constexpr int RW_LOW = 2 * RW_DR + 2 * RW_AR + RW_GR;
constexpr float RW_GN_EPS = 64e-5f;
constexpr int BW = NA_W;
static_assert(GLA_V == BW && RW_W == BW, "branch widths");
constexpr int N_EXPERTS = 16, N_GROUPS = 4, EPG = 4;
constexpr float EPS = 1e-6f;
constexpr int D6 = 6 * D_MODEL;
constexpr int ZO_NAQ = 0, ZO_NAK = NA_W, ZO_NAV = 2 * NA_W;
constexpr int ZO_GQ = 3 * NA_W, ZO_GK = ZO_GQ + GLA_QK, ZO_GV = ZO_GK + GLA_QK, ZO_GR = ZO_GV + GLA_V, ZO_GGD = ZO_GR + GLA_V;
constexpr int ZO_RW = ZO_GGD + 2 * GLA_RANK, ZO_GATE = ZO_RW + RW_IN, D_IN = ZO_GATE + 3 * D_MODEL;
constexpr int RO_R = 0, RO_K = RW_W, RO_V = 2 * RW_W, RO_WD = 3 * RW_W, RO_AD = RO_WD + 2 * RW_DR, RO_GD = RO_AD + 2 * RW_AR;
#ifdef CFG_SMALL
constexpr int ZLD = D_IN;
#else
constexpr int ZLD = 16128;
static_assert(D_IN == 16032, "D_IN");
#endif
constexpr int R_LAT = BATCH * SEQ, R_CTX = BATCH * CTX_LEN, R_ALL = R_LAT + R_CTX;
constexpr int NMOD = BATCH + 1;
constexpr int MOE_TILES = (R_ALL * 2 + N_EXPERTS * 255) / 256 + 1, MOE_ROWS = MOE_TILES * 256;
constexpr int CNT_WORD0 = 3456;

typedef unsigned short bf16_t;
HD float bf2f(bf16_t b) { union { unsigned u; float f; } v; v.u = ((unsigned)b) << 16; return v.f; }
HD bf16_t f2bf(float f) { union { unsigned u; float f; } v; v.f = f; unsigned u = v.u; if ((u & 0x7fffffffu) > 0x7f800000u) return (bf16_t)0x7fc0; u += 0x7FFFu + ((u >> 16) & 1u); return (bf16_t)(u >> 16); }
HD float ldf(const float* p, size_t i) { return p[i]; }
HD float ldf(const bf16_t* p, size_t i) { return bf2f(p[i]); }
HD void stf(float* p, size_t i, float v) { p[i] = v; }
HD void stf(bf16_t* p, size_t i, float v) { p[i] = f2bf(v); }

#ifdef CPU_TEST
typedef float ZT; typedef float AT; typedef float RT;
#else
typedef bf16_t ZT; typedef bf16_t AT; typedef bf16_t RT;
#endif

#if defined(__HIP_DEVICE_COMPILE__)
#define EXPF_(x) __expf(x)
#define LOGF_(x) __logf(x)
#else
#define EXPF_(x) expf(x)
#define LOGF_(x) logf(x)
#endif
HD float sigmoidf_(float x) { return 1.0f / (1.0f + EXPF_(-x)); }
HD float siluf_(float x) { return x / (1.0f + EXPF_(-x)); }
HD float softplusf_(float x) { return (x > 0.f ? x : 0.f) + LOGF_(1.0f + EXPF_(-fabsf(x))); }

struct Ptrs {
    const float *x, *c, *ctx, *c_ctx, *ada_w, *ada_b, *norm1_g, *norm2_g, *w_in, *na_q_norm, *na_k_norm, *na_rpb, *gla_gate_w2, *gla_gate_b, *gla_norm_g,
        *rw_mu, *rw_w0, *rw_w2, *rw_a0, *rw_a2, *rw_g2, *rw_k_k, *rw_k_a, *rw_r_k, *rw_gn_g, *rw_gn_b, *w_branch, *w_out, *router_w, *router_bias,
        *moe_w_gate, *moe_w_up, *moe_w_down;
    float* out;
    float* MOD;
    float* X;
    float* RSTD;
    AT* H;
    ZT* Z;
    AT* Y3;
    RT *GQ, *GK, *GY; float* GA;
    bf16_t *QH, *KP, *KPT, *VTG; float* DL;
    bf16_t *QN, *KN, *VTN;
    float *G, *DEC;
    RT *LOW, *KK, *RS, *VS, *KD, *BB, *RY;
    float* MF;
    int* SELI;
    float* SELW;
    float* ACT;
    bf16_t *WT_IN, *WT_BR, *WT_OUT;
    bf16_t* MB;
    unsigned* BAR;
    bf16_t *WGU, *WD;
    bf16_t *HS, *ACTB;
    bf16_t* YK;
    int *POS, *ROWTOK, *TILE_E;
    float* ROWW;
};

HD int row_bt(int r) { return r < R_LAT ? r / SEQ : BATCH; }
HD int rows_out(int l) { return l < DEPTH - 1 ? R_ALL : R_LAT; }
HD bool row_first(int r) { return r < R_LAT ? (r % SEQ == 0) : ((r - R_LAT) % CTX_LEN == 0); }
HD bool row_last(int r) { return r < R_LAT ? (r % SEQ == SEQ - 1) : ((r - R_LAT) % CTX_LEN == CTX_LEN - 1); }
HD const float* modp(const Ptrs& p, int l, int bt, int k) { return p.MOD + (((size_t)l * NMOD + bt) * 6 + k) * D_MODEL; }
HD int scan_row(int b, int d, int st) {
    if (st < CTX_LEN) return R_LAT + b * CTX_LEN + (d ? CTX_LEN - 1 - st : st);
    const int t = st - CTX_LEN; return b * SEQ + (d ? SEQ - 1 - t : t);
}

struct FMod { Ptrs p;
    HD void operator()(long i) const {
        const int j = (int)(i % D6); const int bt = (int)((i / D6) % NMOD); const int l = (int)(i / ((long)D6 * NMOD));
        const float* cv = bt < BATCH ? p.c + (size_t)bt * D_MODEL : p.c_ctx;
        const float* w = p.ada_w + (size_t)l * D_MODEL * D6 + j;
        float acc = p.ada_b[(size_t)l * D6 + j];
        for (int k = 0; k < D_MODEL; ++k) acc += siluf_(cv[k]) * w[(size_t)k * D6];
        p.MOD[((size_t)l * NMOD + bt) * D6 + j] = acc;
    } };
struct FCopyX { Ptrs p;
    HD void operator()(long i) const { const size_t n = (size_t)R_LAT * D_MODEL; p.X[i] = (size_t)i < n ? p.x[i] : p.ctx[i - n]; } };
struct FRstd { Ptrs p;
    HD void operator()(long r) const { const float* xr = p.X + (size_t)r * D_MODEL; float s = 0.f; for (int d = 0; d < D_MODEL; ++d) s += xr[d] * xr[d]; p.RSTD[r] = 1.0f / sqrtf(s / D_MODEL + EPS); } };
struct FNormMod { Ptrs p; int l, which;
    HD void operator()(long i) const {
        const int r = (int)(i / D_MODEL), d = (int)(i % D_MODEL); const int bt = row_bt(r);
        const float g = (which ? p.norm2_g : p.norm1_g)[(size_t)l * D_MODEL + d];
        const float sh = modp(p, l, bt, which ? 3 : 0)[d], sc = modp(p, l, bt, which ? 4 : 1)[d];
        stf(p.H, (size_t)i, p.X[i] * p.RSTD[r] * g * (1.0f + sc) + sh);
    } };

struct FNaAttn { Ptrs p; int l; int pad_;
    HD void operator()(long i) const {
        const int r = (int)(i / NA_HEADS), h = (int)(i % NA_HEADS);
        const ZT* zr = p.Z + (size_t)r * ZLD;
        float q[NA_HD], acc[NA_HD];
        float ssq = 0.f;
#pragma unroll
        for (int d = 0; d < NA_HD; ++d) { q[d] = ldf(zr, ZO_NAQ + h * NA_HD + d); ssq += q[d] * q[d]; }
        const float rq = 1.0f / sqrtf(ssq / NA_HD + EPS) * (1.0f / sqrtf((float)NA_HD));
#pragma unroll
        for (int d = 0; d < NA_HD; ++d) { q[d] = q[d] * rq * p.na_q_norm[l * NA_HD + d] * p.na_k_norm[l * NA_HD + d]; acc[d] = 0.f; }
        float m = -INFINITY, ls = 0.f;
        auto key = [&](int kr, float bias) {
            const ZT* zk = p.Z + (size_t)kr * ZLD;
            float dot = 0.f, ks = 0.f;
#pragma unroll
            for (int d = 0; d < NA_HD; ++d) { const float kv = ldf(zk, ZO_NAK + h * NA_HD + d); dot += q[d] * kv; ks += kv * kv; }
            const float s = dot / sqrtf(ks / NA_HD + EPS) + bias;
            const float mn = s > m ? s : m; const float corr = expf(m - mn), pe = expf(s - mn);
            ls = ls * corr + pe;
#pragma unroll
            for (int d = 0; d < NA_HD; ++d) acc[d] = acc[d] * corr + pe * ldf(zk, ZO_NAV + h * NA_HD + d);
            m = mn;
        };
        int b;
        if (r < R_LAT) {
            b = r / SEQ; const int t = r % SEQ, gr = t / GRID_W, gc = t % GRID_W;
            constexpr int n_rows = SEQ / GRID_W; constexpr int win_r = NA_WIN_R_MAX < n_rows ? NA_WIN_R_MAX : n_rows;
            int rs = gr - win_r / 2; rs = rs < 0 ? 0 : (rs > n_rows - win_r ? n_rows - win_r : rs);
            int cs = gc - NA_WIN_C / 2; cs = cs < 0 ? 0 : (cs > GRID_W - NA_WIN_C ? GRID_W - NA_WIN_C : cs);
            const float* rp = p.na_rpb + ((size_t)l * NA_HEADS + h) * (2 * NA_WIN_R_MAX - 1) * (2 * NA_WIN_C - 1);
            for (int n = 0; n < win_r; ++n)
                for (int j = 0; j < NA_WIN_C; ++j)
                    key(b * SEQ + (rs + n) * GRID_W + cs + j, rp[(rs + n - gr + NA_WIN_R_MAX - 1) * (2 * NA_WIN_C - 1) + (cs + j - gc + NA_WIN_C - 1)]);
        } else b = (r - R_LAT) / CTX_LEN;
        for (int c = 0; c < CTX_LEN; ++c) key(R_LAT + b * CTX_LEN + c, 0.f);
        const float inv = 1.0f / ls;
#pragma unroll
        for (int d = 0; d < NA_HD; ++d) stf(p.Y3, (size_t)r * BW + h * NA_HD + d, acc[d] * inv);
    } };

struct FGlaPrep { Ptrs p; int l; int pad_;
    HD void operator()(long i) const {
        const int r = (int)(i / GLA_QK), j = (int)(i % GLA_QK), ii = j % GLA_DK, hb = j - ii;
        const ZT* zr = p.Z + (size_t)r * ZLD;
        const float qs = 1.0f / sqrtf((float)GLA_DK);
        float qv = ldf(zr, ZO_GQ + j) * qs, kv = ldf(zr, ZO_GK + j);
        if (r < R_LAT) {
            constexpr int half = GLA_DK / 2, hh2 = half / 2;
            const int t = r % SEQ; const int sect = ii / half, i2 = ii % half, f = i2 % hh2;
            const float pos = (float)(sect == 0 ? t / GRID_W : t % GRID_W);
            const float ang = pos * powf(10000.0f, -(float)(2 * f) / (float)half);
            const float cs = cosf(ang), sn = sinf(ang);
            const int pj = hb + sect * half + (i2 < hh2 ? i2 + hh2 : i2 - hh2);
            const float qp = ldf(zr, ZO_GQ + pj) * qs, kp = ldf(zr, ZO_GK + pj);
            if (i2 < hh2) { qv = qv * cs - qp * sn; kv = kv * cs - kp * sn; } else { qv = qp * sn + qv * cs; kv = kp * sn + kv * cs; }
        }
        stf(p.GQ, (size_t)i, qv); stf(p.GK, (size_t)i, kv);
        for (int d = 0; d < 2; ++d) {
            float pre = p.gla_gate_b[((size_t)l * 2 + d) * GLA_QK + j];
            for (int k = 0; k < GLA_RANK; ++k) pre += ldf(zr, ZO_GGD + d * GLA_RANK + k) * p.gla_gate_w2[(((size_t)l * 2 + d) * GLA_RANK + k) * GLA_QK + j];
            p.GA[(size_t)d * R_ALL * GLA_QK + i] = expf(-softplusf_(-pre) / GLA_TAU);
        }
    } };
struct FGlaScan { Ptrs p; int l; int pad_;
    HD void operator()(long i) const {
        const int vc = (int)(i % GLA_DV); const int ch = (int)(i / GLA_DV); const int d = ch % 2, hh = (ch / 2) % GLA_HEADS, b = ch / (2 * GLA_HEADS);
        float s[GLA_DK];
#pragma unroll
        for (int k = 0; k < GLA_DK; ++k) s[k] = 0.f;
        const float* ga = p.GA + (size_t)d * R_ALL * GLA_QK;
        RT* gy = p.GY + (size_t)d * R_ALL * GLA_V;
        for (int st = 0; st < CTX_LEN + SEQ; ++st) {
            const int r = scan_row(b, d, st);
            const size_t o = (size_t)r * GLA_QK + hh * GLA_DK;
            const float v = ldf(p.Z, (size_t)r * ZLD + ZO_GV + hh * GLA_DV + vc);
            float y = 0.f;
#pragma unroll
            for (int k = 0; k < GLA_DK; ++k) { s[k] = ga[o + k] * s[k] + ldf(p.GK, o + k) * v; y += ldf(p.GQ, o + k) * s[k]; }
            stf(gy, (size_t)r * GLA_V + hh * GLA_DV + vc, y);
        }
    } };
struct FGlaFinish { Ptrs p; int l; int pad_;
    HD void operator()(long i) const {
        const int r = (int)(i / GLA_HEADS), hh = (int)(i % GLA_HEADS);
        const size_t o = (size_t)r * GLA_V + hh * GLA_DV; const RT* y0 = p.GY + o; const RT* y1 = p.GY + (size_t)R_ALL * GLA_V + o;
        float ss = 0.f; for (int v = 0; v < GLA_DV; ++v) { const float y = ldf(y0, v) + ldf(y1, v); ss += y * y; }
        const float rn = 1.0f / sqrtf(ss / GLA_DV + EPS);
        for (int v = 0; v < GLA_DV; ++v) {
            const float y = (ldf(y0, v) + ldf(y1, v)) * rn * p.gla_norm_g[(size_t)l * GLA_DV + v];
            stf(p.Y3, (size_t)R_ALL * BW + o + v, y * siluf_(ldf(p.Z, (size_t)r * ZLD + ZO_GR + hh * GLA_DV + v)));
        }
    } };

HD float rwz(const Ptrs& p, int l, int r, int col) {
    const size_t o = (size_t)r * ZLD + ZO_RW + col;
    const float z0 = ldf(p.Z, o), zp = row_first(r) ? 0.f : ldf(p.Z, o - ZLD), zn = row_last(r) ? 0.f : ldf(p.Z, o + ZLD);
    return z0 + p.rw_mu[(size_t)l * RW_IN + col] * (0.5f * (zp + zn) - z0);
}
struct FRwLow { Ptrs p; int l; int pad_;
    HD void operator()(long i) const {
        const int r = (int)(i / RW_LOW), q = (int)(i % RW_LOW);
        const float z = rwz(p, l, r, RO_WD + q);
        stf(p.LOW, (size_t)i, q < 2 * RW_DR ? tanhf(z) : (q < 2 * RW_DR + 2 * RW_AR ? z : sigmoidf_(z)));
    } };
struct FRwHead { Ptrs p; int l; int pad_;
    HD void operator()(long i) const {
        const int r = (int)(i / RW_HEADS), h = (int)(i % RW_HEADS);
        float ss = 0.f;
        for (int j = 0; j < RW_HEAD; ++j) { const float k = rwz(p, l, r, RO_K + h * RW_HEAD + j) * p.rw_k_k[(size_t)l * RW_W + h * RW_HEAD + j]; ss += k * k; }
        const float rn = 1.0f / sqrtf(ss + EPS);
        for (int j = 0; j < RW_HEAD; ++j) { const int c = h * RW_HEAD + j;
            stf(p.KK, (size_t)r * RW_W + c, rwz(p, l, r, RO_K + c) * p.rw_k_k[(size_t)l * RW_W + c] * rn);
            stf(p.RS, (size_t)r * RW_W + c, rwz(p, l, r, RO_R + c));
            stf(p.VS, (size_t)r * RW_W + c, rwz(p, l, r, RO_V + c)); }
    } };
struct FRwG { Ptrs p; int l; int pad_;
    HD void operator()(long i) const {
        const int r = (int)(i / RW_W), j = (int)(i % RW_W);
        const RT* lo = p.LOW + (size_t)r * RW_LOW + 2 * RW_DR + 2 * RW_AR; float acc = 0.f;
        for (int q = 0; q < RW_GR; ++q) acc += ldf(lo, q) * p.rw_g2[((size_t)l * RW_GR + q) * RW_W + j];
        p.G[i] = acc;
    } };
struct FRwDir { Ptrs p; int l, d;
    HD void operator()(long i) const {
        const int r = (int)(i / RW_W), j = (int)(i % RW_W);
        const RT* lo = p.LOW + (size_t)r * RW_LOW;
        float wpre = p.rw_w0[((size_t)l * 2 + d) * RW_W + j];
        for (int q = 0; q < RW_DR; ++q) wpre += ldf(lo, d * RW_DR + q) * p.rw_w2[(((size_t)l * 2 + d) * RW_DR + q) * RW_W + j];
        const float w_log = -softplusf_(-wpre) - 0.5f;
        float apre = p.rw_a0[((size_t)l * 2 + d) * RW_W + j];
        for (int q = 0; q < RW_AR; ++q) apre += ldf(lo, 2 * RW_DR + d * RW_AR + q) * p.rw_a2[(((size_t)l * 2 + d) * RW_AR + q) * RW_W + j];
        const float a = sigmoidf_(apre);
        const float kraw = rwz(p, l, r, RO_K + j);
        const size_t o = (size_t)d * R_ALL * RW_W + i;
        p.DEC[o] = EXPF_(-EXPF_(w_log));
        stf(p.KD, o, kraw * (1.0f + (a - 1.0f) * p.rw_k_a[(size_t)l * RW_W + j]));
        stf(p.BB, o, ldf(p.KK, (size_t)i) * a);
    } };
struct FRwScan { Ptrs p; int l, d;
    HD void operator()(long i) const {
        const int vi = (int)(i % RW_HEAD); const int bh = (int)(i / RW_HEAD); const int h = bh % RW_HEADS, b = bh / RW_HEADS;
        float s[RW_HEAD];
#pragma unroll
        for (int j = 0; j < RW_HEAD; ++j) s[j] = 0.f;
        const size_t od = (size_t)d * R_ALL * RW_W;
        for (int st = 0; st < CTX_LEN + SEQ; ++st) {
            const int r = scan_row(b, d, st);
            const size_t o = (size_t)r * RW_W + h * RW_HEAD;
            const float v = ldf(p.VS, o + vi);
            float sa = 0.f;
#pragma unroll
            for (int j = 0; j < RW_HEAD; ++j) sa += s[j] * ldf(p.KK, o + j);
            float y = 0.f;
#pragma unroll
            for (int j = 0; j < RW_HEAD; ++j) { s[j] = s[j] * p.DEC[od + o + j] - sa * ldf(p.BB, od + o + j) + v * ldf(p.KD, od + o + j); y += s[j] * ldf(p.RS, o + j); }
            stf(p.RY, od + o + vi, y);
        }
    } };
struct FRwFinish { Ptrs p; int l; int pad_;
    HD void operator()(long i) const {
        const int r = (int)(i / RW_HEADS), h = (int)(i % RW_HEADS);
        const size_t o = (size_t)r * RW_W + h * RW_HEAD; const RT* y0 = p.RY + o; const RT* y1 = p.RY + (size_t)R_ALL * RW_W + o;
        float mean = 0.f; for (int j = 0; j < RW_HEAD; ++j) mean += ldf(y0, j) + ldf(y1, j);
        mean /= RW_HEAD;
        float var = 0.f, bonus = 0.f;
        for (int j = 0; j < RW_HEAD; ++j) { const float dv = ldf(y0, j) + ldf(y1, j) - mean; var += dv * dv;
            bonus += ldf(p.RS, o + j) * rwz(p, l, r, RO_K + h * RW_HEAD + j) * p.rw_r_k[((size_t)l * RW_HEADS + h) * RW_HEAD + j]; }
        const float rn = 1.0f / sqrtf(var / RW_HEAD + RW_GN_EPS);
        for (int j = 0; j < RW_HEAD; ++j) { const int c = h * RW_HEAD + j;
            float y = (ldf(y0, j) + ldf(y1, j) - mean) * rn * p.rw_gn_g[(size_t)l * RW_W + c] + p.rw_gn_b[(size_t)l * RW_W + c];
            y += bonus * ldf(p.VS, (size_t)r * RW_W + c);
            stf(p.Y3, (size_t)2 * R_ALL * BW + (size_t)r * BW + c, y * p.G[(size_t)r * RW_W + c]); }
    } };

HD void route_select(const float (&lg)[N_EXPERTS], const float* router_bias, int& i1, int& i2, float& s1, float& s2) {
        float s[N_EXPERTS], bz[N_EXPERTS];
#pragma unroll
        for (int e = 0; e < N_EXPERTS; ++e) { s[e] = sigmoidf_(lg[e]); bz[e] = s[e] + router_bias[e]; }
        int gsel = 0; float gbest = -INFINITY;
#pragma unroll
        for (int gi = 0; gi < N_GROUPS; ++gi) {
            float m1 = -INFINITY, m2 = -INFINITY;
#pragma unroll
            for (int k = 0; k < EPG; ++k) { const float v = bz[gi * EPG + k]; if (v > m1) { m2 = m1; m1 = v; } else if (v > m2) m2 = v; }
            const float sc2 = m1 + m2; if (sc2 > gbest) { gbest = sc2; gsel = gi; }
        }
        int a1 = 0, a2 = 0; float t1 = 0.f, t2 = 0.f, v1 = -INFINITY, v2 = -INFINITY;
#pragma unroll
        for (int e = 0; e < N_EXPERTS; ++e) { const float v = (e / EPG == gsel) ? bz[e] : -INFINITY; const bool g1 = v > v1, g2 = v > v2;
            v2 = g1 ? v1 : (g2 ? v : v2); a2 = g1 ? a1 : (g2 ? e : a2); t2 = g1 ? t1 : (g2 ? s[e] : t2);
            v1 = g1 ? v : v1; a1 = g1 ? e : a1; t1 = g1 ? s[e] : t1; }
        i1 = a1; i2 = a2; s1 = t1; s2 = t2;
}
struct FRouter { Ptrs p; int l; int pad_;
    HD void operator()(long r) const {
        const int bt = row_bt((int)r); const float* xr = p.X + (size_t)r * D_MODEL; const float rstd = p.RSTD[r];
        const float* sh = modp(p, l, bt, 3); const float* sc = modp(p, l, bt, 4); const float* g = p.norm2_g + (size_t)l * D_MODEL;
        float lg[N_EXPERTS];
#pragma unroll
        for (int e = 0; e < N_EXPERTS; ++e) lg[e] = 0.f;
        for (int d = 0; d < D_MODEL; ++d) { const float h = xr[d] * rstd * g[d] * (1.0f + sc[d]) + sh[d]; const float* w = p.router_w + (size_t)d * N_EXPERTS;
#pragma unroll
            for (int e = 0; e < N_EXPERTS; ++e) lg[e] += h * w[e]; }
        int i1, i2; float s1, s2; route_select(lg, p.router_bias, i1, i2, s1, s2);
        const float inv = 1.0f / (s1 + s2);
        p.SELI[2 * r] = i1; p.SELI[2 * r + 1] = i2; p.SELW[2 * r] = s1 * inv; p.SELW[2 * r + 1] = s2 * inv;
    } };
struct FMoeUp { Ptrs p; int l; int pad_;
    HD void operator()(long i) const {
        const int j = (int)(i % D_EXPERT), k = (int)((i / D_EXPERT) % 2), r = (int)(i / (2 * D_EXPERT));
        const int e = p.SELI[2 * r + k];
        const size_t wo = ((size_t)l * N_EXPERTS + e) * D_MODEL * D_EXPERT + j;
        const float* wg = p.moe_w_gate + wo; const float* wu = p.moe_w_up + wo; const AT* h = p.H + (size_t)r * D_MODEL;
        float g = 0.f, u = 0.f;
        for (int d = 0; d < D_MODEL; ++d) { const float hv = ldf(h, d); g += hv * wg[(size_t)d * D_EXPERT]; u += hv * wu[(size_t)d * D_EXPERT]; }
        p.ACT[i] = siluf_(g) * u * p.SELW[2 * r + k];
    } };
struct FMoeDown { Ptrs p; int l; int pad_;
    HD void operator()(long i) const {
        const int r = (int)(i / D_MODEL), d = (int)(i % D_MODEL);
        float acc = 0.f;
        for (int k = 0; k < 2; ++k) { const int e = p.SELI[2 * r + k];
            const float* wd = p.moe_w_down + ((size_t)l * N_EXPERTS + e) * D_EXPERT * D_MODEL + d; const float* a = p.ACT + ((size_t)r * 2 + k) * D_EXPERT;
            for (int j = 0; j < D_EXPERT; ++j) acc += a[j] * wd[(size_t)j * D_MODEL]; }
        p.X[i] += modp(p, l, row_bt(r), 5)[d] * acc;
    } };
struct FOut { Ptrs p; HD void operator()(long i) const { p.out[i] = p.X[i]; } };

struct GIn { Ptrs p; int l; int M, N, K;
    HD float a(int m, int k) const { return ldf(p.H, (size_t)m * D_MODEL + k); }
    HD float b(int k, int n) const { return p.w_in[((size_t)l * D_MODEL + k) * D_IN + n]; }
    HD void epi(int m, int n, float acc) const { stf(p.Z, (size_t)m * ZLD + n, acc); } };
struct GBranch { Ptrs p; int l, br; int M, N, K; int pad_;
    HD float a(int m, int k) const { return ldf(p.Y3, ((size_t)br * R_ALL + m) * BW + k); }
    HD float b(int k, int n) const { return p.w_branch[(((size_t)l * 3 + br) * BW + k) * D_MODEL + n]; }
    HD void epi(int m, int n, float acc) const { const float g = sigmoidf_(ldf(p.Z, (size_t)m * ZLD + ZO_GATE + br * D_MODEL + n)); float* o = p.MF + (size_t)m * D_MODEL + n; *o = (br ? *o : 0.f) + g * acc; } };
struct GOut { Ptrs p; int l; int M, N, K;
    HD float a(int m, int k) const { return p.MF[(size_t)m * D_MODEL + k]; }
    HD float b(int k, int n) const { return p.w_out[((size_t)l * D_MODEL + k) * D_MODEL + n]; }
    HD void epi(int m, int n, float acc) const { p.X[(size_t)m * D_MODEL + n] += modp(p, l, row_bt(m), 2)[n] * acc; } };

static_assert(sizeof(FNaAttn) % 8 == 0 && sizeof(GBranch) % 8 == 0 && sizeof(FRwDir) % 8 == 0 && sizeof(GIn) % 8 == 0 && sizeof(FMod) % 8 == 0, "no tail padding in by-value kernel arguments");
struct WsMap { size_t total; };
inline size_t ws_carve(Ptrs& p, char* base) {
    size_t off = 0;
    auto take = [&](size_t bytes) { char* q = base ? base + off : nullptr; off += (bytes + 255) & ~(size_t)255; return q; };
    p.BAR = (unsigned*)take(16384);
    p.WT_IN = (bf16_t*)take((size_t)ZLD * D_MODEL * 2); p.WT_BR = (bf16_t*)take((size_t)3 * D_MODEL * BW * 2); p.WT_OUT = (bf16_t*)take((size_t)D_MODEL * D_MODEL * 2);
    p.MOD = (float*)take((size_t)DEPTH * NMOD * D6 * 4);
    p.X = (float*)take((size_t)R_ALL * D_MODEL * 4);
    p.RSTD = (float*)take((size_t)R_ALL * 4);
    p.H = (AT*)take((size_t)R_ALL * D_MODEL * sizeof(AT)); p.MB = (bf16_t*)p.H;
    p.Z = (ZT*)take((size_t)R_ALL * ZLD * sizeof(ZT));
    p.Y3 = (AT*)take((size_t)3 * R_ALL * BW * sizeof(AT));
    const size_t u0 = off;
    p.GQ = (RT*)take((size_t)R_ALL * GLA_QK * sizeof(RT)); p.GK = (RT*)take((size_t)R_ALL * GLA_QK * sizeof(RT)); p.GA = (float*)take((size_t)2 * R_ALL * GLA_QK * 4);
#ifdef CPU_TEST
    p.GY = (RT*)take((size_t)2 * R_ALL * GLA_V * sizeof(RT));
#else
    static_assert(2 * GLA_V * sizeof(RT) <= 2 * GLA_QK * 4, "GY fits over GA"); p.GY = (RT*)p.GA;
#endif
    p.QH = (bf16_t*)take((size_t)2 * R_ALL * GLA_QK * 2); p.KP = (bf16_t*)take((size_t)2 * R_ALL * GLA_QK * 2); p.KPT = (bf16_t*)take((size_t)2 * R_ALL * GLA_QK * 2);
    p.VTG = (bf16_t*)take((size_t)BATCH * GLA_V * (SEQ + CTX_LEN) * 2); p.DL = (float*)take((size_t)2 * (R_ALL / 64) * GLA_QK * 4);
    p.QN = (bf16_t*)take((size_t)R_ALL * NA_W * 2); p.KN = (bf16_t*)take((size_t)R_ALL * NA_W * 2); p.VTN = (bf16_t*)take((size_t)BATCH * NA_HEADS * NA_HD * (SEQ + CTX_LEN) * 2);
    p.LOW = (RT*)take((size_t)R_ALL * RW_LOW * sizeof(RT));
    p.KK = (RT*)take((size_t)R_ALL * RW_W * sizeof(RT)); p.RS = (RT*)take((size_t)R_ALL * RW_W * sizeof(RT)); p.VS = (RT*)take((size_t)R_ALL * RW_W * sizeof(RT));
    p.G = (float*)take((size_t)R_ALL * RW_W * 4);
    p.DEC = (float*)take((size_t)2 * R_ALL * RW_W * 4); p.KD = (RT*)take((size_t)2 * R_ALL * RW_W * sizeof(RT)); p.BB = (RT*)take((size_t)2 * R_ALL * RW_W * sizeof(RT));
    p.RY = (RT*)take((size_t)2 * R_ALL * RW_W * sizeof(RT));
    const size_t u1 = off; off = u0;
    p.MF = (float*)take((size_t)R_ALL * D_MODEL * 4);
    p.SELI = (int*)take((size_t)R_ALL * 2 * 4); p.SELW = (float*)take((size_t)R_ALL * 2 * 4);
    p.ACT = (float*)take((size_t)R_ALL * 2 * D_EXPERT * 4);
    p.WGU = (bf16_t*)take((size_t)N_EXPERTS * 2 * D_EXPERT * D_MODEL * 2); p.WD = (bf16_t*)take((size_t)N_EXPERTS * D_MODEL * D_EXPERT * 2);
    p.HS = (bf16_t*)take((size_t)MOE_ROWS * D_MODEL * 2); p.ACTB = (bf16_t*)take((size_t)MOE_ROWS * D_EXPERT * 2);
    p.YK = (bf16_t*)take((size_t)2 * R_ALL * D_MODEL * 2);
    p.POS = (int*)take((size_t)R_ALL * 2 * 4); p.ROWTOK = (int*)take((size_t)MOE_ROWS * 4); p.TILE_E = (int*)take((size_t)(MOE_TILES + 1) * 4); p.ROWW = (float*)take((size_t)MOE_ROWS * 4);
    if (off < u1) off = u1;
    return off;
}

template <class Exec> void run_forward(Exec& ex, const Ptrs& p) {
    ex.items(FMod{p}, (long)DEPTH * NMOD * D6);
    ex.items(FCopyX{p}, (long)R_ALL * D_MODEL);
    for (int l = 0; l < DEPTH; ++l) {
        const int ro = rows_out(l);
        ex.items(FRstd{p}, R_ALL);
        ex.items(FNormMod{p, l, 0}, (long)R_ALL * D_MODEL);
        ex.gemm(GIn{p, l, R_ALL, D_IN, D_MODEL});
        ex.items(FNaAttn{p, l}, (long)ro * NA_HEADS);
        ex.items(FGlaPrep{p, l}, (long)R_ALL * GLA_QK);
        ex.items(FGlaScan{p, l}, (long)BATCH * GLA_HEADS * 2 * GLA_DV);
        ex.items(FGlaFinish{p, l}, (long)ro * GLA_HEADS);
        ex.items(FRwLow{p, l}, (long)R_ALL * RW_LOW);
        ex.items(FRwHead{p, l}, (long)R_ALL * RW_HEADS);
        ex.items(FRwG{p, l}, (long)R_ALL * RW_W);
        for (int d = 0; d < 2; ++d) ex.items(FRwDir{p, l, d}, (long)R_ALL * RW_W);
        for (int d = 0; d < 2; ++d) ex.items(FRwScan{p, l, d}, (long)BATCH * RW_HEADS * RW_HEAD);
        ex.items(FRwFinish{p, l}, (long)ro * RW_HEADS);
        ex.mark(l, 0);
        for (int br = 0; br < 3; ++br) ex.gemm(GBranch{p, l, br, ro, D_MODEL, BW});
        ex.gemm(GOut{p, l, ro, D_MODEL, D_MODEL});
        ex.mark(l, 1);
        ex.items(FRstd{p}, ro);
        ex.items(FRouter{p, l}, ro);
        ex.items(FNormMod{p, l, 1}, (long)ro * D_MODEL);
        ex.items(FMoeUp{p, l}, (long)ro * 2 * D_EXPERT);
        ex.items(FMoeDown{p, l}, (long)ro * D_MODEL);
        ex.mark(l, 2);
    }
    ex.items(FOut{p}, (long)R_LAT * D_MODEL);
}

inline void fill_inputs(Ptrs& p, void* const* d_in) {
    const float** f = (const float**)d_in;
    p.x = f[0]; p.c = f[1]; p.ctx = f[2]; p.c_ctx = f[3]; p.ada_w = f[4]; p.ada_b = f[5]; p.norm1_g = f[6]; p.norm2_g = f[7]; p.w_in = f[8];
    p.na_q_norm = f[9]; p.na_k_norm = f[10]; p.na_rpb = f[11]; p.gla_gate_w2 = f[12]; p.gla_gate_b = f[13]; p.gla_norm_g = f[14];
    p.rw_mu = f[15]; p.rw_w0 = f[16]; p.rw_w2 = f[17]; p.rw_a0 = f[18]; p.rw_a2 = f[19]; p.rw_g2 = f[20]; p.rw_k_k = f[21]; p.rw_k_a = f[22]; p.rw_r_k = f[23];
    p.rw_gn_g = f[24]; p.rw_gn_b = f[25]; p.w_branch = f[26]; p.w_out = f[27]; p.router_w = f[28]; p.router_bias = f[29];
    p.moe_w_gate = f[30]; p.moe_w_up = f[31]; p.moe_w_down = f[32];
}

#ifndef CPU_TEST
namespace pg8 {
#define PG8_LAS __attribute__((address_space(3)))
typedef unsigned short bf16_t;
typedef short bf16x8 __attribute__((ext_vector_type(8)));
typedef float f32x4 __attribute__((ext_vector_type(4)));
typedef unsigned u32x4 __attribute__((ext_vector_type(4)));
constexpr int BM = 256, BK = 64, HALF = 128, HTB = HALF * BK * 2  , STAGE_BYTES = 8 * HTB, NXCD = 8, WGM = 8;

__host__ __device__ __forceinline__ int lds_byte(int r, int c) { const int st = (r >> 4) * 2 + (c >> 5), rr = r & 15, cc = c & 31, ob = rr * 64 + cc * 2; return st * 1024 + (ob ^ (((ob >> 9) & 1) << 5)); }
__host__ __device__ __forceinline__ void stage_rc(int b, int& R, int& C) { const int st = b / 1024, sb = b % 1024, swz = sb ^ (((sb >> 9) & 1) << 5); R = (st >> 1) * 16 + swz / 64; C = (st & 1) * 32 + (swz % 64) / 2; }
__host__ __device__ __forceinline__ int perm32(int rho) { const int n = rho >> 4, i = rho & 15; return 8 * (i >> 2) + 4 * n + (i & 3); }

struct Unit { int pm, pn; };
struct Gemm { const bf16_t* A; const bf16_t* Bt; int M, N, K; };

struct StaticOrder {
    int nM, nN, nwg, G, c;
    __host__ __device__ void init(int M, int N, int G_, int c_) { nM = M / BM; nN = N / BM; nwg = nM * nN; G = G_; c = c_; }
    __host__ __device__ bool next(int i, Unit& u) const {
        const long L = (long)i * G + c; if (L >= nwg) return false;
        int wgid = (int)L; { const int q = nwg / NXCD, r = nwg % NXCD, xcd = wgid % NXCD, off = wgid / NXCD; wgid = (xcd < r ? xcd * (q + 1) : r * (q + 1) + (xcd - r) * q) + off; }
        const int nig = WGM * nN, gid = wgid / nig, fm = gid * WGM, gsz = (nM - fm) < WGM ? (nM - fm) : WGM;
        u.pm = fm + ((wgid % nig) % gsz); u.pn = (wgid % nig) / gsz; return true;
    }
    __device__ __forceinline__ void a_ready(const Unit&) const {}
    __device__ __forceinline__ void done(const Unit&) const {}
};

__device__ __forceinline__ unsigned cvt_pk_bf16(float lo, float hi) { unsigned r; asm volatile("v_cvt_pk_bf16_f32 %0, %1, %2" : "=v"(r) : "v"(lo), "v"(hi)); return r; }
template <class Epi, class Sched, bool ALIGN_EPI = false, bool SP2 = false>
__device__ __forceinline__ void gemm_phase(PG8_LAS unsigned char* lds, const Gemm g, const Sched& S, const Epi& E, const int wv  ) {
    int tid_; asm volatile("v_mbcnt_lo_u32_b32 %0, -1, 0\n\tv_mbcnt_hi_u32_b32 %0, -1, %0" : "=v"(tid_)); tid_ += wv * 64;
    const int tid = tid_, wid = __builtin_amdgcn_readfirstlane(tid >> 6), lane = tid & 63, wr = wid >> 2, wc = wid & 3, fr = lane & 15, fq = lane >> 4;
    const int K = g.K, nt = K / BK;
    unsigned voffA[2], voffB[2];
#pragma unroll
    for (int i = 0; i < 2; ++i) { int R, C; stage_rc(tid * 16 + i * 8192, R, C); const int Rb = Epi::PERM ? ((R & ~31) + perm32(R & 31)) : R;
        voffA[i] = (unsigned)(R * K + C) * 2u; voffB[i] = (unsigned)(Rb * K + C) * 2u; }
    const size_t kstep = (size_t)(BK * 2);
    const size_t hstep = (size_t)HALF * K * 2;
    const size_t tstep = 2 * hstep;
    const unsigned ldsw = (unsigned)wid * 1024u;
    const int aoff = lds_byte(wr * 64 + fr, fq * 8), boff = lds_byte(wc * 32 + fr, fq * 8);
#define PG8_SA(b, h) (((b) * 2 + (h)) * HTB)
#define PG8_SB(b, h) ((4 + (b) * 2 + (h)) * HTB)
#define PG8_STAGE(bufoff, gbase, voff) do { _Pragma("unroll") for (int _i = 0; _i < 2; ++_i) \
        __builtin_amdgcn_global_load_lds((const unsigned*)((const char*)(gbase) + (voff)[_i]), (PG8_LAS unsigned*)(lds + (bufoff) + ldsw + _i * 8192), 16, 0, 0); } while (0)
#define PG8_LDA(dst, b, h) do { _Pragma("unroll") for (int m = 0; m < 4; ++m) _Pragma("unroll") for (int k = 0; k < 2; ++k) dst[m][k] = *(const PG8_LAS bf16x8*)(lds + PG8_SA(b, h) + aoff + m * 2048 + k * 1024); } while (0)
#define PG8_LDB(dst, b, h) do { _Pragma("unroll") for (int n = 0; n < 2; ++n) _Pragma("unroll") for (int k = 0; k < 2; ++k) dst[n][k] = *(const PG8_LAS bf16x8*)(lds + PG8_SB(b, h) + boff + n * 2048 + k * 1024); } while (0)
#define PG8_MMA(ai, bj, At, Bt) do { __builtin_amdgcn_s_setprio(1); _Pragma("unroll") for (int m = 0; m < 4; ++m) _Pragma("unroll") for (int n = 0; n < 2; ++n) _Pragma("unroll") for (int k = 0; k < 2; ++k) \
        acc[ai][bj][m][n] = __builtin_amdgcn_mfma_f32_16x16x32_bf16(Bt[n][k], At[m][k], acc[ai][bj][m][n], 0, 0, 0); __builtin_amdgcn_s_setprio(0); } while (0)
#define PG8_WAIT_V(n) asm volatile("s_waitcnt vmcnt(" #n ")" ::: "memory")
#define PG8_WAIT_L(n) asm volatile("s_waitcnt lgkmcnt(" #n ")" ::: "memory")
#define PG8_BAR __builtin_amdgcn_s_barrier()
#define PG8_SCHED __builtin_amdgcn_sched_barrier(0)
    Unit cur, nxt; int ui = 0;
    if (!S.next(0, cur)) return;
    f32x4 acc[2][2][4][2];
#pragma unroll
    for (int a = 0; a < 2; ++a)
#pragma unroll
        for (int b = 0; b < 2; ++b)
#pragma unroll
            for (int m = 0; m < 4; ++m)
#pragma unroll
                for (int n = 0; n < 2; ++n) acc[a][b][m][n] = (f32x4){0.f, 0.f, 0.f, 0.f};
    bf16x8 At[4][2], B0[2][2], B1[2][2];
    const char* cA = (const char*)g.A + (size_t)cur.pm * tstep; const char* cB = (const char*)g.Bt + (size_t)cur.pn * tstep;
    S.a_ready(cur);
    if constexpr (SP2) {
        PG8_STAGE(PG8_SB(0, 0), cB, voffB); PG8_STAGE(PG8_SB(0, 1), cB + hstep, voffB); PG8_STAGE(PG8_SA(0, 0), cA, voffA); PG8_STAGE(PG8_SA(0, 1), cA + hstep, voffA);
        if (wr == 1) PG8_BAR;
        PG8_WAIT_V(2); PG8_BAR;
        PG8_STAGE(PG8_SB(1, 0), cB + kstep, voffB); PG8_STAGE(PG8_SA(1, 0), cA + kstep, voffA); PG8_STAGE(PG8_SB(1, 1), cB + hstep + kstep, voffB);
        PG8_WAIT_V(6); PG8_BAR;
    } else {
        PG8_STAGE(PG8_SB(0, 0), cB, voffB); PG8_STAGE(PG8_SA(0, 0), cA, voffA); PG8_STAGE(PG8_SB(0, 1), cB + hstep, voffB); PG8_STAGE(PG8_SA(0, 1), cA + hstep, voffA);
        if (wr == 1) PG8_BAR;
        PG8_WAIT_V(4); PG8_BAR;
        PG8_STAGE(PG8_SB(1, 0), cB + kstep, voffB); PG8_STAGE(PG8_SA(1, 0), cA + kstep, voffA); PG8_STAGE(PG8_SB(1, 1), cB + hstep + kstep, voffB);
        PG8_WAIT_V(6); PG8_BAR;
    }
    for (;;) {
        const bool has_next = S.next(ui + 1, nxt);
        const char* nA = has_next ? (const char*)g.A + (size_t)nxt.pm * tstep : cA; const char* nB = has_next ? (const char*)g.Bt + (size_t)nxt.pn * tstep : cB;
        for (int t = 0; t < nt; t += 2) {
            const bool last = (t == nt - 2);
            const char* a1 = cA + (size_t)(t + 1) * kstep;
            const char* a2 = last ? nA : cA + (size_t)(t + 2) * kstep; const char* b2 = last ? nB : cB + (size_t)(t + 2) * kstep;
            const char* a3 = a2 + kstep; const char* b3 = b2 + kstep;
            if (last && has_next) S.a_ready(nxt);
            if constexpr (SP2) {
            PG8_LDB(B0, 0, 0); PG8_LDB(B1, 0, 1); PG8_SCHED; PG8_LDA(At, 0, 0); PG8_STAGE(PG8_SA(1, 1), a1 + hstep, voffA);
            PG8_WAIT_V(8); PG8_WAIT_L(0); PG8_BAR; PG8_MMA(0, 0, At, B0); PG8_MMA(0, 1, At, B1); PG8_BAR; PG8_SCHED;
            PG8_LDA(At, 0, 1); PG8_STAGE(PG8_SB(0, 0), b2, voffB); PG8_STAGE(PG8_SB(0, 1), b2 + hstep, voffB); PG8_STAGE(PG8_SA(0, 0), a2, voffA);
            PG8_WAIT_V(8); PG8_WAIT_L(0); PG8_BAR; PG8_MMA(1, 0, At, B0); PG8_MMA(1, 1, At, B1); PG8_BAR; PG8_SCHED;
            PG8_LDB(B0, 1, 0); PG8_LDB(B1, 1, 1); PG8_SCHED; PG8_LDA(At, 1, 0); PG8_STAGE(PG8_SA(0, 1), a2 + hstep, voffA);
            PG8_WAIT_V(8); PG8_WAIT_L(0); PG8_BAR; PG8_MMA(0, 0, At, B0); PG8_MMA(0, 1, At, B1); PG8_BAR; PG8_SCHED;
            PG8_LDA(At, 1, 1); PG8_STAGE(PG8_SB(1, 0), b3, voffB); PG8_STAGE(PG8_SB(1, 1), b3 + hstep, voffB); PG8_STAGE(PG8_SA(1, 0), a3, voffA);
            PG8_WAIT_V(8); PG8_WAIT_L(0); PG8_BAR; PG8_MMA(1, 0, At, B0); PG8_MMA(1, 1, At, B1); PG8_BAR; PG8_SCHED;
            } else {
            PG8_LDB(B0, 0, 0); PG8_SCHED; PG8_LDA(At, 0, 0); PG8_STAGE(PG8_SA(1, 1), a1 + hstep, voffA);
            PG8_WAIT_L(8); PG8_BAR; PG8_WAIT_L(0); PG8_MMA(0, 0, At, B0); PG8_BAR; PG8_SCHED;
            PG8_LDB(B1, 0, 1); PG8_STAGE(PG8_SB(0, 0), b2, voffB);
            PG8_BAR; PG8_WAIT_L(0); PG8_MMA(0, 1, At, B1); PG8_BAR;
            PG8_LDA(At, 0, 1); PG8_STAGE(PG8_SA(0, 0), a2, voffA);
            PG8_BAR; PG8_WAIT_L(0); PG8_MMA(1, 0, At, B0); PG8_BAR; PG8_SCHED;
            PG8_STAGE(PG8_SB(0, 1), b2 + hstep, voffB);
            PG8_WAIT_V(6); PG8_BAR; PG8_MMA(1, 1, At, B1); PG8_BAR;
            PG8_LDB(B0, 1, 0); PG8_SCHED; PG8_LDA(At, 1, 0); PG8_STAGE(PG8_SA(0, 1), a2 + hstep, voffA);
            PG8_WAIT_L(8); PG8_BAR; PG8_WAIT_L(0); PG8_MMA(0, 0, At, B0); PG8_BAR; PG8_SCHED;
            PG8_LDB(B1, 1, 1); PG8_STAGE(PG8_SB(1, 0), b3, voffB);
            PG8_BAR; PG8_WAIT_L(0); PG8_MMA(0, 1, At, B1); PG8_BAR;
            PG8_LDA(At, 1, 1); PG8_STAGE(PG8_SA(1, 0), a3, voffA);
            PG8_BAR; PG8_WAIT_L(0); PG8_MMA(1, 0, At, B0); PG8_BAR; PG8_SCHED;
            PG8_STAGE(PG8_SB(1, 1), b3 + hstep, voffB);
            PG8_WAIT_V(6); PG8_BAR; PG8_MMA(1, 1, At, B1); PG8_BAR;
            }
        }
        if constexpr (ALIGN_EPI) { if (wr == 0) PG8_BAR; }
        if constexpr (!Epi::AFTER_DRAIN) { E(acc, cur, wr, wc, fr, fq); S.done(cur); }
        if (!has_next) break;
#pragma unroll
        for (int a = 0; a < 2; ++a)
#pragma unroll
            for (int b = 0; b < 2; ++b)
#pragma unroll
                for (int m = 0; m < 4; ++m)
#pragma unroll
                    for (int n = 0; n < 2; ++n) acc[a][b][m][n] = (f32x4){0.f, 0.f, 0.f, 0.f};
        cur = nxt; cA = nA; cB = nB; ++ui;
        if constexpr (ALIGN_EPI) { if (wr == 1) PG8_BAR; }
    }
    PG8_WAIT_V(0);
    if constexpr (!ALIGN_EPI) { if (wr == 0) PG8_BAR; }
    PG8_BAR;
    if constexpr (Epi::AFTER_DRAIN) { E.fused(acc, cur, wr, wc, fr, fq, lds, wid, lane); S.done(cur); }
#undef PG8_SA
#undef PG8_SB
#undef PG8_STAGE
#undef PG8_LDA
#undef PG8_LDB
#undef PG8_MMA
#undef PG8_WAIT_V
#undef PG8_WAIT_L
#undef PG8_BAR
#undef PG8_SCHED
}
}
#define XB_TMO      128
#define XB_XCNT(j)  (256  + 64 * (j))
#define XB_XSUB(j)  (1280 + 64 * (j))
#define XB_XGEN(j)  (2304 + 64 * (j))
#define XB_TOP      3328
#define XB_TOPGEN   3392
#define XCD_BAR_WORDS 3456
#define XB_SPIN_CAP (1u << 18)
#define LAS __attribute__((address_space(3)))

__device__ __forceinline__ unsigned xb_ld(unsigned* p)              { return __hip_atomic_load(p, __ATOMIC_RELAXED, __HIP_MEMORY_SCOPE_AGENT); }
__device__ __forceinline__ unsigned xb_add(unsigned* p, unsigned v) { return __hip_atomic_fetch_add(p, v, __ATOMIC_RELAXED, __HIP_MEMORY_SCOPE_AGENT); }
__device__ __forceinline__ unsigned xb_xcc_id() { return (unsigned)__builtin_amdgcn_s_getreg((3 << 11) | 20) & 0xFu; }
#define XB_SPIN(cond, bar) do { unsigned _sp = 0; while (cond) { __builtin_amdgcn_s_sleep(1); \
    if ((++_sp & 255u) == 0u) { if (xb_ld(&(bar)[XB_TMO])) break; if (_sp > XB_SPIN_CAP) { atomicAdd(&(bar)[XB_TMO], 1u); break; } } } } while (0)

struct XcdBarrier {
    unsigned* bar; unsigned x; int wv;
    volatile LAS unsigned* st;
};

__device__ __forceinline__ XcdBarrier xcd_barrier_post(unsigned* bar, volatile LAS unsigned* st) {
    XcdBarrier b; b.bar = bar; b.x = xb_xcc_id(); b.st = st; b.wv = __builtin_amdgcn_readfirstlane(threadIdx.x >> 6);
    if (threadIdx.x == 0) (void)xb_add(&bar[XB_XCNT(b.x)], 1u);
    return b;
}
__device__ __forceinline__ void xcd_barrier_complete(unsigned* bar, unsigned x, unsigned& nloc, unsigned& nx) {
    const unsigned G = gridDim.x * gridDim.y * gridDim.z;
    unsigned sum, cnt, mine, sp = 0u;
    for (;;) {
        sum = 0u; cnt = 0u; mine = 0u;
#pragma unroll
        for (unsigned j = 0; j < 16; ++j) { const unsigned c = xb_ld(&bar[XB_XCNT(j)]); sum += c; cnt += (c > 0u) ? 1u : 0u; mine = (j == x) ? c : mine; }
        if (sum == G) break;
        __builtin_amdgcn_s_sleep(1);
        if ((++sp & 255u) == 0u) { if (xb_ld(&bar[XB_TMO])) break; if (sp > XB_SPIN_CAP) { atomicAdd(&bar[XB_TMO], 1u); break; } }
    }
    nloc = mine > 0u ? mine : 1u; nx = cnt > 0u ? cnt : 1u;
}

__device__ __forceinline__ void xcd_barrier(const XcdBarrier& b) {
    asm volatile("s_waitcnt vmcnt(0)" ::: "memory");
    __syncthreads();
    int xb_lane; asm volatile("v_mbcnt_lo_u32_b32 %0, -1, 0\n\tv_mbcnt_hi_u32_b32 %0, -1, %0" : "=v"(xb_lane));
    if (b.wv == 0 && xb_lane == 0) {
        unsigned* bar = b.bar;
        __builtin_amdgcn_s_waitcnt(0);
        unsigned nloc = b.st[0], nx = b.st[1];
        if (nloc == 0u) { xcd_barrier_complete(bar, b.x, nloc, nx); b.st[0] = nloc; b.st[1] = nx; }
        const unsigned old = xb_add(&bar[XB_XSUB(b.x)], 1u);
        const unsigned gen = old / nloc;
        if (old + 1u == (gen + 1u) * nloc) {
            __builtin_amdgcn_fence(__ATOMIC_RELEASE, "agent");
            asm volatile("s_waitcnt vmcnt(0)" ::: "memory");
            const unsigned og = xb_add(&bar[XB_TOP], 1u);
            const unsigned tg = og / nx;
            if (og + 1u == (tg + 1u) * nx) xb_add(&bar[XB_TOPGEN], 1u);
            else XB_SPIN(xb_ld(&bar[XB_TOPGEN]) == tg, bar);
            __builtin_amdgcn_fence(__ATOMIC_ACQUIRE, "agent");
            xb_add(&bar[XB_XGEN(b.x)], 1u);
            asm volatile("s_waitcnt vmcnt(0)" ::: "memory");
        } else {
            XB_SPIN(xb_ld(&bar[XB_XGEN(b.x)]) == gen, bar);
            __builtin_amdgcn_fence(__ATOMIC_ACQUIRE, "agent");
            asm volatile("s_waitcnt vmcnt(0)" ::: "memory");
        }
    }
    __syncthreads();
}

constexpr int MEGA_THREADS = 512;
constexpr int LDS_BYTES = pg8::STAGE_BYTES + 16;
typedef float f32x4 __attribute__((ext_vector_type(4)));
typedef unsigned u32x4 __attribute__((ext_vector_type(4)));
typedef unsigned u32x2 __attribute__((ext_vector_type(2)));

__device__ __forceinline__ int opaque_lane() { int l; asm volatile("v_mbcnt_lo_u32_b32 %0, -1, 0\n\tv_mbcnt_hi_u32_b32 %0, -1, %0" : "=v"(l)); return l; }
__device__ __forceinline__ int opaque_tid(int wv) { return wv * 64 + opaque_lane(); }
__device__ __forceinline__ int opaque_grid() { int g = gridDim.x; asm volatile("" : "+s"(g)); return g; }
__device__ __forceinline__ int opaque_block() { int b = blockIdx.x; asm volatile("" : "+s"(b)); return b; }
template <class F> __device__ __forceinline__ void run_items(int wv, const F& f, long n) {
    const int tid = opaque_tid(wv); const int lane = tid & 63, w = tid >> 6; const int G = opaque_grid(), B = opaque_block();
    const long nw = (long)G * (MEGA_THREADS / 64);
    for (long gw = (long)w * G + B; gw * 64 < n; gw += nw) { const long i = gw * 64 + lane; if (i < n) f(i); }
}

template <int CTRL> __device__ __forceinline__ float dpp_mov(float x) { return __int_as_float(__builtin_amdgcn_mov_dpp(__float_as_int(x), CTRL, 0xf, 0xf, true)); }
__device__ __forceinline__ float row16_sum(float x) {
    x += dpp_mov<0xB1>(x);
    x += dpp_mov<0x4E>(x);
    x += dpp_mov<0x141>(x);
    x += dpp_mov<0x140>(x);
    return x;
}
__device__ __forceinline__ float wave_sum(float v) {
    v = row16_sum(v);
    const int b = __float_as_int(v);
    return __int_as_float(__builtin_amdgcn_readlane(b, 0)) + __int_as_float(__builtin_amdgcn_readlane(b, 16)) + (__int_as_float(__builtin_amdgcn_readlane(b, 32)) + __int_as_float(__builtin_amdgcn_readlane(b, 48)));
}

typedef short bf16x8 __attribute__((ext_vector_type(8)));
typedef float f32x16 __attribute__((ext_vector_type(16)));
typedef float f32x4 __attribute__((ext_vector_type(4)));
typedef unsigned u32x4 __attribute__((ext_vector_type(4)));
typedef unsigned u32x2 __attribute__((ext_vector_type(2)));
typedef __bf16 bf16x2_t __attribute__((ext_vector_type(2)));
typedef float f32x2_t __attribute__((ext_vector_type(2)));
#define MFMA32(a, b, c) __builtin_amdgcn_mfma_f32_32x32x16_bf16((a), (b), (c), 0, 0, 0)
__device__ __forceinline__ unsigned pk2(float lo, float hi) { const f32x2_t v = {lo, hi}; return __builtin_bit_cast(unsigned, __builtin_convertvector(v, bf16x2_t)); }
__device__ __forceinline__ bf16x8 pack8(float a0, float a1, float a2, float a3, float a4, float a5, float a6, float a7) {
    u32x4 r; r[0] = pk2(a0, a1); r[1] = pk2(a2, a3); r[2] = pk2(a4, a5); r[3] = pk2(a6, a7); return __builtin_bit_cast(bf16x8, r); }
__device__ __forceinline__ bf16x8 ld8(const bf16_t* p) { return *(const bf16x8*)p; }
__device__ __forceinline__ bf16x8 ld4x2(const bf16_t* lo, const bf16_t* hi) { u32x4 r; const u32x2 a = *(const u32x2*)lo, b = *(const u32x2*)hi; r[0] = a[0]; r[1] = a[1]; r[2] = b[0]; r[3] = b[1]; return __builtin_bit_cast(bf16x8, r); }
__device__ __forceinline__ float half_swap_max(float x) { const auto t = __builtin_amdgcn_permlane32_swap(__float_as_uint(x), __float_as_uint(x), false, false); return fmaxf(__uint_as_float(t[0]), __uint_as_float(t[1])); }
__device__ __forceinline__ float half_swap_sum(float x) { const auto t = __builtin_amdgcn_permlane32_swap(__float_as_uint(x), __float_as_uint(x), false, false); return __uint_as_float(t[0]) + __uint_as_float(t[1]); }
constexpr int T_ALL = SEQ + CTX_LEN;
constexpr float LOG2E = 1.4426950408889634f;

struct FNaPrep { Ptrs p; int l; int pad_;
    __device__ __forceinline__ void operator()(long i) const {
        const int isk = (int)(i & 1), h = (int)((i >> 1) % NA_HEADS), r = (int)(i / (2 * NA_HEADS));
        const bf16_t* z = p.Z + (size_t)r * ZLD + (isk ? ZO_NAK : ZO_NAQ) + h * NA_HD;
        float v[NA_HD]; float ss = 0.f;
#pragma unroll
        for (int q = 0; q < NA_HD / 8; ++q) { const u32x4 w = *(const u32x4*)(z + 8 * q);
#pragma unroll
            for (int k = 0; k < 4; ++k) { v[8 * q + 2 * k] = __uint_as_float(w[k] << 16); v[8 * q + 2 * k + 1] = __uint_as_float(w[k] & 0xffff0000u); } }
#pragma unroll
        for (int d = 0; d < NA_HD; ++d) ss += v[d] * v[d];
        const float rn = 1.0f / sqrtf(ss / NA_HD + EPS) * (isk ? 1.0f : LOG2E / sqrtf((float)NA_HD));
        const float* g = (isk ? p.na_k_norm : p.na_q_norm) + l * NA_HD;
        bf16_t* o = (isk ? p.KN : p.QN) + (size_t)r * NA_W + h * NA_HD;
#pragma unroll
        for (int q = 0; q < NA_HD / 8; ++q) { u32x4 w;
#pragma unroll
            for (int k = 0; k < 4; ++k) w[k] = pk2(v[8 * q + 2 * k] * rn * g[8 * q + 2 * k], v[8 * q + 2 * k + 1] * rn * g[8 * q + 2 * k + 1]);
            *(u32x4*)(o + 8 * q) = w; }
    } };
struct FVt { Ptrs p; bf16_t* dst; int zoff, nheads, hd; int pad_;
    __device__ __forceinline__ void operator()(long i) const {
        const int dim = (int)(i % hd), tb = (int)((i / hd) % (T_ALL / 8)), bh = (int)(i / ((long)hd * (T_ALL / 8))), b = bh / nheads, h = bh % nheads;
        const int tok = tb * 8, row0 = tok < SEQ ? b * SEQ + tok : R_LAT + b * CTX_LEN + (tok - SEQ);
        const bf16_t* z = p.Z + (size_t)row0 * ZLD + zoff + h * hd + dim;
        u32x4 w;
#pragma unroll
        for (int k = 0; k < 4; ++k) w[k] = (unsigned)z[(size_t)(2 * k) * ZLD] | ((unsigned)z[(size_t)(2 * k + 1) * ZLD] << 16);
        *(u32x4*)(dst + ((size_t)bh * hd + dim) * T_ALL + tok) = w;
    } };

constexpr int GLA_NCH = (SEQ + CTX_LEN) / 64, GLA_CCH = CTX_LEN / 64;
static_assert(GLA_DK == 128 && GLA_DV == 256 && GLA_HEADS == 4 && SEQ % 64 == 0 && CTX_LEN % 64 == 0, "GLA kernel geometry");
__device__ __forceinline__ int gla_row0(int b, int cidx) { return cidx < GLA_CCH ? R_LAT + b * CTX_LEN + 64 * cidx : b * SEQ + 64 * (cidx - GLA_CCH); }
__device__ __forceinline__ int gla_tok0(int cidx) { return cidx < GLA_CCH ? SEQ + 64 * cidx : 64 * (cidx - GLA_CCH); }
struct FGlaChunk { Ptrs p;
    __device__ __forceinline__ void operator()(long i) const {
        const int j = (int)(i % GLA_QK), cidx = (int)((i / GLA_QK) % GLA_NCH), b = (int)((i / ((long)GLA_QK * GLA_NCH)) % BATCH), d = (int)(i / ((long)GLA_QK * GLA_NCH * BATCH));
        const int row0 = gla_row0(b, cidx);
        const size_t od = (size_t)d * R_ALL * GLA_QK;
        bf16_t* kpt = p.KPT + ((((size_t)(d * BATCH + b) * GLA_NCH + cidx) * GLA_QK + j) * 64);
        float A = 1.0f;
#pragma unroll 1
        for (int tb = 0; tb < 8; ++tb) {
            float kv[8];
#pragma unroll
            for (int u = 0; u < 8; ++u) { const int t = d ? 63 - (tb * 8 + u) : tb * 8 + u; const size_t o = (size_t)(row0 + t) * GLA_QK + j;
                A *= p.GA[od + o];
                const float q = bf2f(p.GQ[o]) * A, k = bf2f(p.GK[o]) * __builtin_amdgcn_rcpf(A);
                p.QH[od + o] = f2bf(q); p.KP[od + o] = f2bf(k); kv[d ? 7 - u : u] = k; }
            u32x4 w; w[0] = pk2(kv[0], kv[1]); w[1] = pk2(kv[2], kv[3]); w[2] = pk2(kv[4], kv[5]); w[3] = pk2(kv[6], kv[7]);
            *(u32x4*)(kpt + (d ? 56 - tb * 8 : tb * 8)) = w;
        }
        p.DL[((size_t)(d * BATCH + b) * GLA_NCH + cidx) * GLA_QK + j] = A;
    } };
__device__ __forceinline__ void gla_task(const Ptrs& p, int chain, int w, int lane) {
    const int c = lane & 31, hf = lane >> 5;
    const int d = chain & 1, hh = (chain >> 1) % GLA_HEADS, b = chain / (2 * GLA_HEADS);
    f32x16 S[4];
#pragma unroll
    for (int kb = 0; kb < 4; ++kb)
#pragma unroll
        for (int r = 0; r < 16; ++r) S[kb][r] = 0.f;
    const size_t od = (size_t)d * R_ALL * GLA_QK;
    const bf16_t* vt = p.VTG + ((size_t)(b * GLA_HEADS + hh) * GLA_DV + 32 * w + c) * T_ALL;
    for (int step = 0; step < GLA_NCH; ++step) {
        const int cidx = d ? (step < GLA_CCH ? GLA_CCH - 1 - step : GLA_NCH - 1 - (step - GLA_CCH)) : step;
        const int row0 = gla_row0(b, cidx), tok0 = gla_tok0(cidx);
        const bf16_t* qh = p.QH + od + (size_t)row0 * GLA_QK + hh * GLA_DK;
        const bf16_t* kp = p.KP + od + (size_t)row0 * GLA_QK + hh * GLA_DK;
        f32x16 y[2];
#pragma unroll
        for (int ib = 0; ib < 2; ++ib)
#pragma unroll
            for (int r = 0; r < 16; ++r) y[ib][r] = 0.f;
#pragma unroll
        for (int t3 = 0; t3 < 3; ++t3) {
            const int jb = (t3 == 2) ? 1 : 0, ib = (t3 == 0) ? 0 : 1;
            const int JB = d ? ib : jb, IB = d ? jb : ib;
            f32x16 at;
#pragma unroll
            for (int r = 0; r < 16; ++r) at[r] = 0.f;
#pragma unroll
            for (int ks = 0; ks < 8; ++ks) at = MFMA32(ld8(kp + (size_t)(32 * JB + c) * GLA_QK + ks * 16 + 8 * hf), ld8(qh + (size_t)(32 * IB + c) * GLA_QK + ks * 16 + 8 * hf), at);
            if (JB == IB) {
#pragma unroll
                for (int r = 0; r < 16; ++r) { const int jj = (r & 3) + 8 * (r >> 2) + 4 * hf; at[r] = (d ? jj >= c : jj <= c) ? at[r] : 0.f; }
            }
#pragma unroll
            for (int s = 0; s < 2; ++s) {
                const bf16x8 af = pack8(at[8 * s], at[8 * s + 1], at[8 * s + 2], at[8 * s + 3], at[8 * s + 4], at[8 * s + 5], at[8 * s + 6], at[8 * s + 7]);
                const bf16_t* vp = vt + tok0 + 32 * JB + 16 * s + 4 * hf;
                if (IB == 0) y[0] = MFMA32(af, ld4x2(vp, vp + 8), y[0]); else y[1] = MFMA32(af, ld4x2(vp, vp + 8), y[1]);
            }
        }
#pragma unroll
        for (int kb = 0; kb < 4; ++kb)
#pragma unroll
            for (int s = 0; s < 2; ++s) {
                const bf16x8 sf = pack8(S[kb][8 * s], S[kb][8 * s + 1], S[kb][8 * s + 2], S[kb][8 * s + 3], S[kb][8 * s + 4], S[kb][8 * s + 5], S[kb][8 * s + 6], S[kb][8 * s + 7]);
#pragma unroll
                for (int ib = 0; ib < 2; ++ib) { const bf16_t* qp = qh + (size_t)(32 * ib + c) * GLA_QK + 32 * kb + 16 * s + 4 * hf; y[ib] = MFMA32(ld4x2(qp, qp + 8), sf, y[ib]); }
            }
        bf16_t* gy = p.GY + ((size_t)d * R_ALL + row0) * GLA_V + hh * GLA_DV + 32 * w + c;
#pragma unroll
        for (int ib = 0; ib < 2; ++ib)
#pragma unroll
            for (int r = 0; r < 16; ++r) gy[(size_t)(32 * ib + (r & 3) + 8 * (r >> 2) + 4 * hf) * GLA_V] = f2bf(y[ib][r]);
        const bf16_t* kt = p.KPT + (((size_t)(d * BATCH + b) * GLA_NCH + cidx) * GLA_QK + hh * GLA_DK) * 64;
        const float* dl = p.DL + ((size_t)(d * BATCH + b) * GLA_NCH + cidx) * GLA_QK + hh * GLA_DK;
#pragma unroll
        for (int kb = 0; kb < 4; ++kb) {
#pragma unroll
            for (int ks = 0; ks < 4; ++ks) S[kb] = MFMA32(ld8(kt + (size_t)(32 * kb + c) * 64 + 16 * ks + 8 * hf), ld8(vt + tok0 + 16 * ks + 8 * hf), S[kb]);
#pragma unroll
            for (int g = 0; g < 4; ++g) { const f32x4 dv = *(const f32x4*)(dl + 32 * kb + 8 * g + 4 * hf);
#pragma unroll
                for (int k = 0; k < 4; ++k) S[kb][4 * g + k] *= dv[k]; }
        }
    }
}
__device__ __forceinline__ void gla_phase(int wv, const Ptrs& p, int wg0) {
    const int tid = opaque_tid(wv), lane = tid & 63; const int B = opaque_block();
    if (B >= wg0 && B < wg0 + BATCH * GLA_HEADS * 2) gla_task(p, B - wg0, wv, lane);
}

constexpr int NA_LAT_UNITS = BATCH * NA_HEADS * (SEQ / GRID_W) * (GRID_W / 32);
constexpr int NA_CTX_UNITS = BATCH * NA_HEADS * (CTX_LEN / 32);
constexpr int NA_RPB_N = NA_HEADS * (2 * NA_WIN_R_MAX - 1) * (2 * NA_WIN_C - 1);
static_assert(GRID_W == 64 && NA_HD == 64 && SEQ / GRID_W == 32 && NA_HEADS == 16 && CTX_LEN % 32 == 0, "NA kernel geometry");
__device__ __forceinline__ void na_softmax_pv(const float (&s)[16], float& m, float& ls, f32x16& o0, f32x16& o1, const bf16_t* vtb, int c, int hh) {
    float bm = s[0];
#pragma unroll
    for (int r = 1; r < 16; ++r) bm = fmaxf(bm, s[r]);
    bm = half_swap_max(bm);
    const float mn = fmaxf(m, bm), ms = (mn == -INFINITY) ? 0.f : mn;
    const float alpha = __builtin_amdgcn_exp2f(m - ms);
    m = mn;
    float pv[16], psum = 0.f;
#pragma unroll
    for (int r = 0; r < 16; ++r) { pv[r] = __builtin_amdgcn_exp2f(s[r] - ms); psum += pv[r]; }
    ls = ls * alpha + psum;
#pragma unroll
    for (int r = 0; r < 16; ++r) { o0[r] *= alpha; o1[r] *= alpha; }
#pragma unroll
    for (int ks = 0; ks < 2; ++ks) {
        const bf16x8 pb = pack8(pv[8 * ks], pv[8 * ks + 1], pv[8 * ks + 2], pv[8 * ks + 3], pv[8 * ks + 4], pv[8 * ks + 5], pv[8 * ks + 6], pv[8 * ks + 7]);
        const bf16_t* v0 = vtb + (size_t)c * T_ALL + 16 * ks + 4 * hh;
        const bf16_t* v1 = vtb + (size_t)(32 + c) * T_ALL + 16 * ks + 4 * hh;
        o0 = MFMA32(ld4x2(v0, v0 + 8), pb, o0);
        o1 = MFMA32(ld4x2(v1, v1 + 8), pb, o1);
    }
}
__device__ __forceinline__ void na_unit(const Ptrs& p, int u, int lane, const LAS float* rpb) {
    const int c = lane & 31, hh = lane >> 5;
    int b, h, qrow, gr = 0, qc = 0, nloc;
    if (u < NA_LAT_UNITS) { const int qh = u & 1; gr = (u >> 1) & 31; h = (u >> 6) & 15; b = u >> 10; qc = 32 * qh + c; qrow = b * SEQ + gr * GRID_W + qc; nloc = NA_WIN_R_MAX; }
    else { const int v = u - NA_LAT_UNITS; h = (v >> 3) & 15; b = v >> 7; qrow = R_LAT + b * CTX_LEN + 32 * (v & 7) + c; nloc = 0; }
    bf16x8 qf[4];
#pragma unroll
    for (int ks = 0; ks < 4; ++ks) qf[ks] = ld8(p.QN + (size_t)qrow * NA_W + h * NA_HD + ks * 16 + 8 * hh);
    int rs = gr - NA_WIN_R_MAX / 2; rs = rs < 0 ? 0 : (rs > SEQ / GRID_W - NA_WIN_R_MAX ? SEQ / GRID_W - NA_WIN_R_MAX : rs);
    int cs = qc - NA_WIN_C / 2; cs = cs < 0 ? 0 : (cs > GRID_W - NA_WIN_C ? GRID_W - NA_WIN_C : cs);
    f32x16 o0, o1;
#pragma unroll
    for (int r = 0; r < 16; ++r) { o0[r] = 0.f; o1[r] = 0.f; }
    float m = -INFINITY, ls = 0.f;
    const bf16_t* vt = p.VTN + (size_t)(b * NA_HEADS + h) * NA_HD * T_ALL;
    for (int blk = 0; blk < 2 * nloc; ++blk) {
        const int n = blk >> 1, kb = blk & 1, tok0 = (rs + n) * GRID_W + 32 * kb;
        const bf16_t* kp = p.KN + (size_t)(b * SEQ + tok0 + c) * NA_W + h * NA_HD + 8 * hh;
        f32x16 S;
#pragma unroll
        for (int r = 0; r < 16; ++r) S[r] = 0.f;
#pragma unroll
        for (int ks = 0; ks < 4; ++ks) S = MFMA32(ld8(kp + ks * 16), qf[ks], S);
        const LAS float* rp = rpb + (h * (2 * NA_WIN_R_MAX - 1) + (rs + n - gr + NA_WIN_R_MAX - 1)) * (2 * NA_WIN_C - 1);
        float s[16];
#pragma unroll
        for (int r = 0; r < 16; ++r) { const int kc = 32 * kb + (r & 3) + 8 * (r >> 2) + 4 * hh; int idx = kc - qc + NA_WIN_C - 1; idx = idx < 0 ? 0 : (idx > 2 * NA_WIN_C - 2 ? 2 * NA_WIN_C - 2 : idx);
            s[r] = ((unsigned)(kc - cs) < (unsigned)NA_WIN_C) ? S[r] + rp[idx] : -INFINITY; }
        na_softmax_pv(s, m, ls, o0, o1, vt + tok0, c, hh);
    }
    for (int cb = 0; cb < CTX_LEN / 32; ++cb) {
        const bf16_t* kp = p.KN + (size_t)(R_LAT + b * CTX_LEN + 32 * cb + c) * NA_W + h * NA_HD + 8 * hh;
        f32x16 S;
#pragma unroll
        for (int r = 0; r < 16; ++r) S[r] = 0.f;
#pragma unroll
        for (int ks = 0; ks < 4; ++ks) S = MFMA32(ld8(kp + ks * 16), qf[ks], S);
        float s[16];
#pragma unroll
        for (int r = 0; r < 16; ++r) s[r] = S[r];
        na_softmax_pv(s, m, ls, o0, o1, vt + SEQ + 32 * cb, c, hh);
    }
    const float inv = 1.0f / half_swap_sum(ls);
    bf16_t* yo = p.Y3 + (size_t)qrow * BW + h * NA_HD + 4 * hh;
#pragma unroll
    for (int g = 0; g < 4; ++g) {
        u32x2 w0, w1; w0[0] = pk2(o0[4 * g] * inv, o0[4 * g + 1] * inv); w0[1] = pk2(o0[4 * g + 2] * inv, o0[4 * g + 3] * inv);
        w1[0] = pk2(o1[4 * g] * inv, o1[4 * g + 1] * inv); w1[1] = pk2(o1[4 * g + 2] * inv, o1[4 * g + 3] * inv);
        *(u32x2*)(yo + 8 * g) = w0; *(u32x2*)(yo + 32 + 8 * g) = w1;
    }
}
__device__ __forceinline__ void na_phase(int wv, const Ptrs& p, int l, LAS unsigned char* lds, int wg0, int nwg) {
    const int tid = opaque_tid(wv), lane = tid & 63; const int B = opaque_block();
    LAS float* rpb = (LAS float*)lds;
    __syncthreads();
    for (int i = tid; i < NA_RPB_N; i += MEGA_THREADS) rpb[i] = p.na_rpb[(size_t)l * NA_RPB_N + i] * LOG2E;
    __syncthreads();
    const int nunits = NA_LAT_UNITS + (l < DEPTH - 1 ? NA_CTX_UNITS : 0);
    if (B >= wg0 && B < wg0 + nwg)
        for (int u = wv * nwg + (B - wg0); u < nunits; u += nwg * (MEGA_THREADS / 64)) na_unit(p, u, lane, rpb);
}
__device__ __forceinline__ void norm_rows(int wv, const Ptrs& p, int l, int which, int nrows, bool addmoe) {
    static_assert(D_MODEL == 2048, "norm_rows lane mapping");
    const int tid = opaque_tid(wv); const int lane = tid & 63, w = tid >> 6;
    const float* gain = (which ? p.norm2_g : p.norm1_g) + (size_t)l * D_MODEL;
    const int G = opaque_grid(), B = opaque_block();
    for (int r = w * G + B; r < nrows; r += G * (MEGA_THREADS / 64)) {
        const f32x4* xr = (const f32x4*)(p.X + (size_t)r * D_MODEL);
        f32x4 v[8]; float ss = 0.f;
        const int bt = row_bt(r);
#pragma unroll
        for (int i = 0; i < 8; ++i) v[i] = xr[lane + 64 * i];
        if (addmoe) {
            const f32x4* g2p = (const f32x4*)modp(p, l - 1, bt, 5);
#pragma unroll
            for (int i = 0; i < 8; ++i) { const int c = lane + 64 * i;
                const u32x2 a = *(const u32x2*)(p.YK + (size_t)r * D_MODEL + 4 * c), b = *(const u32x2*)(p.YK + ((size_t)R_ALL + r) * D_MODEL + 4 * c); const f32x4 g = g2p[c];
                v[i][0] += g[0] * (__uint_as_float(a[0] << 16) + __uint_as_float(b[0] << 16)); v[i][1] += g[1] * (__uint_as_float(a[0] & 0xffff0000u) + __uint_as_float(b[0] & 0xffff0000u));
                v[i][2] += g[2] * (__uint_as_float(a[1] << 16) + __uint_as_float(b[1] << 16)); v[i][3] += g[3] * (__uint_as_float(a[1] & 0xffff0000u) + __uint_as_float(b[1] & 0xffff0000u));
                ((f32x4*)(p.X + (size_t)r * D_MODEL))[c] = v[i]; }
        }
#pragma unroll
        for (int i = 0; i < 8; ++i) ss += v[i][0] * v[i][0] + v[i][1] * v[i][1] + v[i][2] * v[i][2] + v[i][3] * v[i][3];
        ss = wave_sum(ss);
        const float rstd = 1.0f / sqrtf(ss / D_MODEL + EPS);
        const f32x4* sh = (const f32x4*)modp(p, l, bt, which ? 3 : 0); const f32x4* sc = (const f32x4*)modp(p, l, bt, which ? 4 : 1); const f32x4* g4 = (const f32x4*)gain;
        float lg[N_EXPERTS];
#pragma unroll
        for (int e = 0; e < N_EXPERTS; ++e) lg[e] = 0.f;
#pragma unroll
        for (int i = 0; i < 8; ++i) {
            const int c = lane + 64 * i; const f32x4 g = g4[c], s = sc[c], b = sh[c]; f32x4 h;
#pragma unroll
            for (int k = 0; k < 4; ++k) h[k] = v[i][k] * rstd * g[k] * (1.0f + s[k]) + b[k];
            u32x2 pk; pk[0] = pg8::cvt_pk_bf16(h[0], h[1]); pk[1] = pg8::cvt_pk_bf16(h[2], h[3]);
            *(u32x2*)(p.H + (size_t)r * D_MODEL + 4 * c) = pk;
            if (which) {
#pragma unroll
                for (int k = 0; k < 4; ++k) { const f32x4* rw = (const f32x4*)(p.router_w + (size_t)(4 * c + k) * N_EXPERTS);
#pragma unroll
                    for (int q = 0; q < 4; ++q) { const f32x4 wv = rw[q]; lg[4 * q] += h[k] * wv[0]; lg[4 * q + 1] += h[k] * wv[1]; lg[4 * q + 2] += h[k] * wv[2]; lg[4 * q + 3] += h[k] * wv[3]; } }
            }
        }
        if (which) {
#pragma unroll
            for (int e = 0; e < N_EXPERTS; ++e) lg[e] = wave_sum(lg[e]);
            if (lane == 0) { int i1, i2; float s1, s2; route_select(lg, p.router_bias, i1, i2, s1, s2); const float inv = 1.0f / (s1 + s2);
                p.SELI[2 * r] = i1; p.SELI[2 * r + 1] = i2; p.SELW[2 * r] = s1 * inv; p.SELW[2 * r + 1] = s2 * inv;
                unsigned* cnt = p.BAR + CNT_WORD0 + l * N_EXPERTS * 16;
                p.POS[2 * r] = (int)__hip_atomic_fetch_add(cnt + i1 * 16, 1u, __ATOMIC_RELAXED, __HIP_MEMORY_SCOPE_AGENT);
                p.POS[2 * r + 1] = (int)__hip_atomic_fetch_add(cnt + i2 * 16, 1u, __ATOMIC_RELAXED, __HIP_MEMORY_SCOPE_AGENT); }
        }
    }
}

__device__ __forceinline__ void conv_tile(const float* __restrict__ W, int ldw, int nvalid, bf16_t* __restrict__ Wt, int K, int kb, int nb, float* tile, int tid) {
    { const int n = tid & 63, k0 = tid >> 6;
#pragma unroll
      for (int i = 0; i < 8; ++i) { const int k = k0 + 8 * i; tile[k * 65 + n] = (nb + n < nvalid) ? W[(size_t)(kb + k) * ldw + nb + n] : 0.f; } }
    __syncthreads();
    { const int kp = (tid & 31) * 2, n0 = tid >> 5;
#pragma unroll
      for (int i = 0; i < 4; ++i) { const int n = n0 + 16 * i; *(unsigned*)(Wt + (size_t)(nb + n) * K + kb + kp) = pg8::cvt_pk_bf16(tile[kp * 65 + n], tile[(kp + 1) * 65 + n]); } }
    __syncthreads();
}
__device__ __forceinline__ void conv_wT(int wv, const float* __restrict__ W, bf16_t* __restrict__ Wt, int K, int N, int Npad, float* tile) {
    const int tn = Npad / 64, tk = K / 64, tid = opaque_tid(wv);
    const int G = opaque_grid(), B = opaque_block();
    for (int t = B; t < tn * tk; t += G) conv_tile(W, N, N, Wt, K, (t / tn) * 64, (t % tn) * 64, tile, tid);
}
__device__ __forceinline__ void conv_moe(int wv, const Ptrs& p, int l, float* tile) {
    const int tid = opaque_tid(wv); const int G = opaque_grid(), B = opaque_block();
    constexpr int TK = D_MODEL / 64, PER_E = 2 * D_EXPERT / 64 * TK;
    for (int t = B; t < N_EXPERTS * PER_E; t += G) {
        const int e = t / PER_E, q = t % PER_E, rt = q % (2 * D_EXPERT / 64), kt = q / (2 * D_EXPERT / 64);
        const int row = rt * 64, pn = row / 256, up = (row % 256) / 128, c0 = pn * 128 + (row % 128);
        const float* W = (up ? p.moe_w_up : p.moe_w_gate) + ((size_t)l * N_EXPERTS + e) * D_MODEL * D_EXPERT + c0;
        conv_tile(W, D_EXPERT, 64, p.WGU + ((size_t)e * 2 * D_EXPERT + row) * D_MODEL, D_MODEL, kt * 64, 0, tile, tid);
    }
    constexpr int TKD = D_EXPERT / 64, PER_ED = D_MODEL / 64 * TKD;
    for (int t = B; t < N_EXPERTS * PER_ED; t += G) {
        const int e = t / PER_ED, q = t % PER_ED, nt = q % (D_MODEL / 64), kt = q / (D_MODEL / 64);
        conv_tile(p.moe_w_down + ((size_t)l * N_EXPERTS + e) * D_EXPERT * D_MODEL, D_MODEL, D_MODEL, p.WD + (size_t)e * D_MODEL * D_EXPERT, D_EXPERT, kt * 64, nt * 64, tile, tid);
    }
}

struct EpiZ {
    static constexpr bool PERM = true, AFTER_DRAIN = false;
    bf16_t* O;
    __device__ __forceinline__ void operator()(const f32x4 (&acc)[2][2][4][2], const pg8::Unit& u, int wr, int wc, int fr, int fq) const {
        const int row0 = u.pm * 256 + wr * 64 + fr, col0 = u.pn * 256 + wc * 32 + 8 * fq;
#pragma unroll
        for (int ai = 0; ai < 2; ++ai)
#pragma unroll
            for (int m = 0; m < 4; ++m) { bf16_t* rowp = O + (size_t)(row0 + ai * 128 + m * 16) * ZLD + col0;
#pragma unroll
                for (int bj = 0; bj < 2; ++bj) { const f32x4 v0 = acc[ai][bj][m][0], v1 = acc[ai][bj][m][1];
                    u32x4 pk; pk[0] = pg8::cvt_pk_bf16(v0[0], v0[1]); pk[1] = pg8::cvt_pk_bf16(v0[2], v0[3]); pk[2] = pg8::cvt_pk_bf16(v1[0], v1[1]); pk[3] = pg8::cvt_pk_bf16(v1[2], v1[3]);
                    *(u32x4*)(rowp + bj * 128) = pk; } }
    }
};
template <int BR> struct EpiBranch {
    static constexpr bool PERM = false, AFTER_DRAIN = false;
    const bf16_t* Z; float* MF; bf16_t* MB;
    __device__ __forceinline__ void operator()(const f32x4 (&acc)[2][2][4][2], const pg8::Unit& u, int wr, int wc, int fr, int fq) const {
        const int row0 = u.pm * 256 + wr * 64 + fr, col0 = u.pn * 256 + wc * 32 + 4 * fq;
#pragma unroll
        for (int ai = 0; ai < 2; ++ai)
#pragma unroll
            for (int m = 0; m < 4; ++m) { const size_t row = (size_t)(row0 + ai * 128 + m * 16);
#pragma unroll
                for (int bj = 0; bj < 2; ++bj)
#pragma unroll
                    for (int n = 0; n < 2; ++n) { const int col = col0 + bj * 128 + n * 16;
                        const u32x2 gz = *(const u32x2*)(Z + row * ZLD + ZO_GATE + BR * D_MODEL + col);
                        f32x4 g; g[0] = __uint_as_float(gz[0] << 16); g[1] = __uint_as_float(gz[0] & 0xffff0000u); g[2] = __uint_as_float(gz[1] << 16); g[3] = __uint_as_float(gz[1] & 0xffff0000u);
                        f32x4 val;
#pragma unroll
                        for (int k = 0; k < 4; ++k) val[k] = acc[ai][bj][m][n][k] / (1.0f + __expf(-g[k]));
                        float* mp = MF + row * D_MODEL + col;
                        if (BR > 0) val += *(const f32x4*)mp;
                        if (BR < 2) *(f32x4*)mp = val;
                        else { u32x2 pk; pk[0] = pg8::cvt_pk_bf16(val[0], val[1]); pk[1] = pg8::cvt_pk_bf16(val[2], val[3]); *(u32x2*)(MB + row * D_MODEL + col) = pk; } }
            }
    }
};
struct EpiOut {
    static constexpr bool PERM = false, AFTER_DRAIN = false;
    float* X; const float* MODL;
    __device__ __forceinline__ void operator()(const f32x4 (&acc)[2][2][4][2], const pg8::Unit& u, int wr, int wc, int fr, int fq) const {
        const int row0 = u.pm * 256 + wr * 64 + fr, col0 = u.pn * 256 + wc * 32 + 4 * fq;
#pragma unroll
        for (int ai = 0; ai < 2; ++ai)
#pragma unroll
            for (int m = 0; m < 4; ++m) { const int row = row0 + ai * 128 + m * 16; const float* g1 = MODL + ((size_t)row_bt(row) * 6 + 2) * D_MODEL;
#pragma unroll
                for (int bj = 0; bj < 2; ++bj)
#pragma unroll
                    for (int n = 0; n < 2; ++n) { const int col = col0 + bj * 128 + n * 16; float* xp = X + (size_t)row * D_MODEL + col;
                        *(f32x4*)xp = *(const f32x4*)xp + *(const f32x4*)(g1 + col) * acc[ai][bj][m][n]; }
            }
    }
};


constexpr int RWS_T = 64;
constexpr int RWS_REC = 896;
constexpr int RWS_BUF = RWS_T * RWS_REC;
static_assert(2 * RWS_BUF <= pg8::STAGE_BYTES && (RWS_T * (RWS_REC / 16)) % MEGA_THREADS == 0 && (CTX_LEN + SEQ) % RWS_T == 0 && RW_HEAD == 64, "RWKV scan staging");
__device__ __forceinline__ void rw_scan_issue(const Ptrs& p, int b, int h, int d, int batch, LAS unsigned char* buf, int tid) {
    const size_t od = (size_t)d * R_ALL * RW_W;
#pragma unroll
    for (int q = 0; q < RWS_T * (RWS_REC / 16) / MEGA_THREADS; ++q) {
        const int id = q * MEGA_THREADS + tid, st = id / (RWS_REC / 16), c = id % (RWS_REC / 16);
        const int r = scan_row(b, d, batch * RWS_T + st);
        const size_t o = (size_t)r * RW_W + h * RW_HEAD;
        const char* src;
        if (c < 16) src = (const char*)(p.DEC + od + o) + c * 16;
        else { const int a = (c - 16) >> 3, cc = (c - 16) & 7;
            const bf16_t* base = a == 0 ? p.KK + o : a == 1 ? p.BB + od + o : a == 2 ? p.KD + od + o : a == 3 ? p.RS + o : p.VS + o;
            src = (const char*)base + cc * 16; }
        __builtin_amdgcn_global_load_lds((const unsigned*)src, (LAS unsigned*)(buf + (size_t)(q * MEGA_THREADS + (tid & ~63)) * 16), 16, 0, 0);
    }
}
__device__ __forceinline__ void rw_scan_chain(int wv, const Ptrs& p, int chain, LAS unsigned char* lds) {
    const int tid = opaque_tid(wv), cg = tid & 15, rp = tid >> 4;
    const int d = chain & 1, h = (chain >> 1) % RW_HEADS, b = chain / (2 * RW_HEADS);
    float s0[4], s1[4];
#pragma unroll
    for (int j = 0; j < 4; ++j) { s0[j] = 0.f; s1[j] = 0.f; }
    constexpr int NB = (CTX_LEN + SEQ) / RWS_T;
    __syncthreads();
    rw_scan_issue(p, b, h, d, 0, lds, tid);
    bf16_t* ry = p.RY + (size_t)d * R_ALL * RW_W + h * RW_HEAD + 2 * rp;
    for (int batch = 0; batch < NB; ++batch) {
        asm volatile("s_waitcnt vmcnt(0)" ::: "memory");
        __syncthreads();
        if (batch + 1 < NB) rw_scan_issue(p, b, h, d, batch + 1, lds + ((batch + 1) & 1) * RWS_BUF, tid);
        const LAS unsigned char* rec = lds + (batch & 1) * RWS_BUF;
        for (int s16 = 0; s16 < RWS_T; s16 += 16) {
            float yk0 = 0.f, yk1 = 0.f;
#pragma unroll
            for (int u = 0; u < 16; ++u) {
                const LAS unsigned char* rr = rec + (s16 + u) * RWS_REC;
                const f32x4 w = *(const LAS f32x4*)(rr + cg * 16);
                const u32x2 kkp = *(const LAS u32x2*)(rr + 256 + cg * 8), bbp = *(const LAS u32x2*)(rr + 384 + cg * 8), kdp = *(const LAS u32x2*)(rr + 512 + cg * 8), rsp = *(const LAS u32x2*)(rr + 640 + cg * 8);
                const unsigned vp = *(const LAS unsigned*)(rr + 768 + rp * 4);
                float kk[4], bb[4], kd[4], rs[4];
                kk[0] = __uint_as_float(kkp[0] << 16); kk[1] = __uint_as_float(kkp[0] & 0xffff0000u); kk[2] = __uint_as_float(kkp[1] << 16); kk[3] = __uint_as_float(kkp[1] & 0xffff0000u);
                bb[0] = __uint_as_float(bbp[0] << 16); bb[1] = __uint_as_float(bbp[0] & 0xffff0000u); bb[2] = __uint_as_float(bbp[1] << 16); bb[3] = __uint_as_float(bbp[1] & 0xffff0000u);
                kd[0] = __uint_as_float(kdp[0] << 16); kd[1] = __uint_as_float(kdp[0] & 0xffff0000u); kd[2] = __uint_as_float(kdp[1] << 16); kd[3] = __uint_as_float(kdp[1] & 0xffff0000u);
                rs[0] = __uint_as_float(rsp[0] << 16); rs[1] = __uint_as_float(rsp[0] & 0xffff0000u); rs[2] = __uint_as_float(rsp[1] << 16); rs[3] = __uint_as_float(rsp[1] & 0xffff0000u);
                const float v0 = __uint_as_float(vp << 16), v1 = __uint_as_float(vp & 0xffff0000u);
                float sa0 = s0[0] * kk[0] + s0[1] * kk[1] + (s0[2] * kk[2] + s0[3] * kk[3]);
                float sa1 = s1[0] * kk[0] + s1[1] * kk[1] + (s1[2] * kk[2] + s1[3] * kk[3]);
                sa0 = row16_sum(sa0); sa1 = row16_sum(sa1);
                float y0 = 0.f, y1 = 0.f;
#pragma unroll
                for (int j = 0; j < 4; ++j) {
                    s0[j] = s0[j] * w[j] + (v0 * kd[j] - sa0 * bb[j]); y0 += s0[j] * rs[j];
                    s1[j] = s1[j] * w[j] + (v1 * kd[j] - sa1 * bb[j]); y1 += s1[j] * rs[j];
                }
                y0 = row16_sum(y0); y1 = row16_sum(y1);
                yk0 = (cg == u) ? y0 : yk0; yk1 = (cg == u) ? y1 : yk1;
            }
            const int r = scan_row(b, d, batch * RWS_T + s16 + cg);
            *(unsigned*)(ry + (size_t)r * RW_W) = pg8::cvt_pk_bf16(yk0, yk1);
        }
    }
}

__device__ __forceinline__ void moe_gather(int wv, const Ptrs& p, int l, int ro, int* so  ) {
    const int tid = opaque_tid(wv), lane = tid & 63, w = tid >> 6;
    const unsigned* cnt = p.BAR + CNT_WORD0 + l * N_EXPERTS * 16;
    __syncthreads();
    if (tid == 0) { int o = 0; for (int e = 0; e < N_EXPERTS; ++e) { so[e] = o; const int c = (int)__hip_atomic_load(cnt + e * 16, __ATOMIC_RELAXED, __HIP_MEMORY_SCOPE_AGENT); so[32 + e] = c; o += (c + 255) & ~255; } so[N_EXPERTS] = o; }
    __syncthreads();
    const int ntiles = so[N_EXPERTS] / 256;
    if (opaque_block() == 0) {
        for (int t = tid; t < ntiles; t += MEGA_THREADS) { int e = 0; for (int q = 1; q < N_EXPERTS; ++q) if (so[q] <= t * 256) e = q; p.TILE_E[t] = e; }
        if (tid == 0) p.TILE_E[MOE_TILES] = ntiles;
    }
    if (opaque_block() < N_EXPERTS) { const int e = opaque_block(); for (int rr = so[e] + so[32 + e] + tid; rr < so[e + 1]; rr += MEGA_THREADS) { p.ROWTOK[rr] = -1; p.ROWW[rr] = 0.f; } }
    const int G = opaque_grid(), B = opaque_block();
    for (int it = w * G + B; it < ro * 2; it += G * (MEGA_THREADS / 64)) {
        const int e = p.SELI[it], dst = so[e] + p.POS[it];
        const u32x4* src = (const u32x4*)(p.H + (size_t)(it >> 1) * D_MODEL); u32x4* d = (u32x4*)(p.HS + (size_t)dst * D_MODEL);
#pragma unroll
        for (int i = 0; i < 4; ++i) d[lane + 64 * i] = src[lane + 64 * i];
        if (lane == 0) { p.ROWTOK[dst] = it; p.ROWW[dst] = p.SELW[it]; }
    }
}
struct MoeOrder {
    int ntiles, nN, G, c; const int* tile_e;
    __device__ __forceinline__ bool next(int i, pg8::Unit& u) const { const long L = (long)i * G + c; if (L >= (long)ntiles * nN) return false; const int t = (int)(L / nN); u.pm = t; u.pn = tile_e[t] * nN + (int)(L % nN); return true; }
    __device__ __forceinline__ void a_ready(const pg8::Unit&) const {}
    __device__ __forceinline__ void done(const pg8::Unit&) const {}
};
struct EpiMoeUp {
    static constexpr bool PERM = true, AFTER_DRAIN = false;
    bf16_t* ACTB; const float* ROWW;
    __device__ __forceinline__ void operator()(const f32x4 (&acc)[2][2][4][2], const pg8::Unit& u, int wr, int wc, int fr, int fq) const {
        const int row0 = u.pm * 256 + wr * 64 + fr, col0 = (u.pn & 3) * 128 + wc * 32 + 8 * fq;
        static_assert(2 * D_EXPERT / 256 == 4, "EpiMoeUp column tiles");
#pragma unroll
        for (int ai = 0; ai < 2; ++ai)
#pragma unroll
            for (int m = 0; m < 4; ++m) { const int row = row0 + ai * 128 + m * 16; const float w = ROWW[row];
                float a[8];
#pragma unroll
                for (int n = 0; n < 2; ++n)
#pragma unroll
                    for (int k = 0; k < 4; ++k) { const float g = acc[ai][0][m][n][k], uu = acc[ai][1][m][n][k]; a[4 * n + k] = g / (1.0f + __expf(-g)) * uu * w; }
                u32x4 pk; pk[0] = pg8::cvt_pk_bf16(a[0], a[1]); pk[1] = pg8::cvt_pk_bf16(a[2], a[3]); pk[2] = pg8::cvt_pk_bf16(a[4], a[5]); pk[3] = pg8::cvt_pk_bf16(a[6], a[7]);
                *(u32x4*)(ACTB + (size_t)row * D_EXPERT + col0) = pk; }
    }
};
struct EpiMoeDown {
    static constexpr bool PERM = true, AFTER_DRAIN = false;
    bf16_t* YK; const int* ROWTOK;
    __device__ __forceinline__ void operator()(const f32x4 (&acc)[2][2][4][2], const pg8::Unit& u, int wr, int wc, int fr, int fq) const {
        static_assert(D_MODEL / 256 == 8, "EpiMoeDown column tiles");
        const int row0 = u.pm * 256 + wr * 64 + fr, col0 = (u.pn & 7) * 256 + wc * 32 + 8 * fq;
#pragma unroll
        for (int ai = 0; ai < 2; ++ai)
#pragma unroll
            for (int m = 0; m < 4; ++m) { const int tok = ROWTOK[row0 + ai * 128 + m * 16];
                if (tok >= 0) { bf16_t* rowp = YK + ((size_t)(tok & 1) * R_ALL + (tok >> 1)) * D_MODEL + col0;
#pragma unroll
                    for (int bj = 0; bj < 2; ++bj) { const f32x4 v0 = acc[ai][bj][m][0], v1 = acc[ai][bj][m][1];
                        u32x4 pk; pk[0] = pg8::cvt_pk_bf16(v0[0], v0[1]); pk[1] = pg8::cvt_pk_bf16(v0[2], v0[3]); pk[2] = pg8::cvt_pk_bf16(v1[0], v1[1]); pk[3] = pg8::cvt_pk_bf16(v1[2], v1[3]);
                        *(u32x4*)(rowp + bj * 128) = pk; } } }
    }
};
template <class Epi> __device__ __forceinline__ void moe_gemm_call(int wv, LAS unsigned char* lds, const Ptrs& p, const bf16_t* A, const bf16_t* Bt, int nN, int K, const Epi& E) {
    pg8::Gemm g{A, Bt, 0, 0, K}; MoeOrder S{p.TILE_E[MOE_TILES], nN, opaque_grid(), opaque_block(), p.TILE_E};
    pg8::gemm_phase<Epi, MoeOrder, true, true>(lds, g, S, E, wv);
}
__device__ __forceinline__ void final_out(int wv, const Ptrs& p) {
    const int tid = opaque_tid(wv);
    const size_t n4 = (size_t)R_LAT * D_MODEL / 4;
    const int G = opaque_grid(), B = opaque_block();
    for (size_t i = (size_t)B * MEGA_THREADS + tid; i < n4; i += (size_t)G * MEGA_THREADS) {
        const int r = (int)(i / (D_MODEL / 4)), c = (int)(i % (D_MODEL / 4));
        const f32x4 g = ((const f32x4*)modp(p, DEPTH - 1, row_bt(r), 5))[c]; f32x4 v = ((const f32x4*)p.X)[i];
        const u32x2 a = *(const u32x2*)(p.YK + i * 4), b = *(const u32x2*)(p.YK + (size_t)R_ALL * D_MODEL + i * 4);
        v[0] += g[0] * (__uint_as_float(a[0] << 16) + __uint_as_float(b[0] << 16)); v[1] += g[1] * (__uint_as_float(a[0] & 0xffff0000u) + __uint_as_float(b[0] & 0xffff0000u));
        v[2] += g[2] * (__uint_as_float(a[1] << 16) + __uint_as_float(b[1] << 16)); v[3] += g[3] * (__uint_as_float(a[1] & 0xffff0000u) + __uint_as_float(b[1] & 0xffff0000u));
        ((f32x4*)p.out)[i] = v;
    }
}

template <class Epi> __device__ __forceinline__ void gemm_call(int wv, LAS unsigned char* lds, const bf16_t* A, const bf16_t* Bt, int M, int N, int K, const Epi& E) {
    pg8::Gemm g{A, Bt, M, N, K}; pg8::StaticOrder S; S.init(M, N, opaque_grid(), opaque_block());
    pg8::gemm_phase<Epi, pg8::StaticOrder, true, true>(lds, g, S, E, wv);
}

__global__ void __launch_bounds__(MEGA_THREADS, 2) mega_fwd(Ptrs p) {
    extern __shared__ __attribute__((aligned(16))) unsigned char smem[];
    LAS unsigned char* lds = (LAS unsigned char*)smem;
    volatile LAS unsigned* stw = (volatile LAS unsigned*)(lds + pg8::STAGE_BYTES);
    const int wv = __builtin_amdgcn_readfirstlane(threadIdx.x >> 6);
    if (threadIdx.x < 4) stw[threadIdx.x] = 0u;
    __syncthreads();
    const XcdBarrier bar = xcd_barrier_post(p.BAR, stw);
#define GRID_SYNC() xcd_barrier(bar)

    { run_items(wv, FMod{p}, (long)DEPTH * NMOD * D6); }
    { run_items(wv, FCopyX{p}, (long)R_ALL * D_MODEL); }
#pragma unroll
    for (int l = 0; l < DEPTH; ++l) {
        const int ro = rows_out(l);
        { conv_wT(wv, p.w_in + (size_t)l * D_MODEL * D_IN, p.WT_IN, D_MODEL, D_IN, ZLD, (float*)smem); }
        { for (int br = 0; br < 3; ++br) conv_wT(wv, p.w_branch + ((size_t)l * 3 + br) * BW * D_MODEL, p.WT_BR + (size_t)br * D_MODEL * BW, BW, D_MODEL, D_MODEL, (float*)smem); }
        { conv_wT(wv, p.w_out + (size_t)l * D_MODEL * D_MODEL, p.WT_OUT, D_MODEL, D_MODEL, D_MODEL, (float*)smem); }
        GRID_SYNC();
        { norm_rows(wv, p, l, 0, R_ALL, l > 0); }
        GRID_SYNC();
        { gemm_call(wv, lds, p.H, p.WT_IN, R_ALL, ZLD, D_MODEL, EpiZ{p.Z}); }
        GRID_SYNC();
        { run_items(wv, FNaPrep{p, l}, (long)R_ALL * NA_HEADS * 2); }
        { run_items(wv, FVt{p, p.VTN, ZO_NAV, NA_HEADS, NA_HD}, (long)BATCH * NA_HEADS * NA_HD * (T_ALL / 8)); }
        { run_items(wv, FGlaPrep{p, l}, (long)R_ALL * GLA_QK); }
        { run_items(wv, FRwLow{p, l}, (long)R_ALL * RW_LOW); }
        { run_items(wv, FRwHead{p, l}, (long)R_ALL * RW_HEADS); }
        { run_items(wv, FVt{p, p.VTG, ZO_GV, GLA_HEADS, GLA_DV}, (long)BATCH * GLA_V * (T_ALL / 8)); }
        GRID_SYNC();
        { na_phase(wv, p, l, lds, 0, opaque_grid()); }
        { run_items(wv, FGlaChunk{p}, (long)2 * BATCH * GLA_NCH * GLA_QK); }
        { run_items(wv, FRwG{p, l}, (long)R_ALL * RW_W); }
        { run_items(wv, FRwDir{p, l, 0}, (long)R_ALL * RW_W); }
        { run_items(wv, FRwDir{p, l, 1}, (long)R_ALL * RW_W); }
        GRID_SYNC();
        { for (int ch = opaque_block(); ch < BATCH * RW_HEADS * 2; ch += opaque_grid()) rw_scan_chain(wv, p, ch, lds); }
        { gla_phase(wv, p, 128); }
        GRID_SYNC();
        { run_items(wv, FGlaFinish{p, l}, (long)ro * GLA_HEADS); }
        { run_items(wv, FRwFinish{p, l}, (long)ro * RW_HEADS); }
        GRID_SYNC();
        { gemm_call(wv, lds, p.Y3, p.WT_BR, ro, D_MODEL, BW, EpiBranch<0>{p.Z, p.MF, p.MB}); }
        GRID_SYNC();
        { gemm_call(wv, lds, p.Y3 + (size_t)R_ALL * BW, p.WT_BR + (size_t)D_MODEL * BW, ro, D_MODEL, BW, EpiBranch<1>{p.Z, p.MF, p.MB}); }
        GRID_SYNC();
        { gemm_call(wv, lds, p.Y3 + (size_t)2 * R_ALL * BW, p.WT_BR + (size_t)2 * D_MODEL * BW, ro, D_MODEL, BW, EpiBranch<2>{p.Z, p.MF, p.MB}); }
        GRID_SYNC();
        { gemm_call(wv, lds, p.MB, p.WT_OUT, ro, D_MODEL, D_MODEL, EpiOut{p.X, p.MOD + (size_t)l * NMOD * D6}); }
        GRID_SYNC();
        { norm_rows(wv, p, l, 1, ro, false); }
        { conv_moe(wv, p, l, (float*)smem); }
        GRID_SYNC();
        { moe_gather(wv, p, l, ro, (int*)smem); }
        GRID_SYNC();
        { moe_gemm_call(wv, lds, p, p.HS, p.WGU, 4, D_MODEL, EpiMoeUp{p.ACTB, p.ROWW}); }
        GRID_SYNC();
        { moe_gemm_call(wv, lds, p, p.ACTB, p.WD, 8, D_EXPERT, EpiMoeDown{p.YK, p.ROWTOK}); }
        GRID_SYNC();
    }
    { final_out(wv, p); }
#undef GRID_SYNC
}

extern "C" void kernel_launch(void* const* d_in, const int* in_sizes, int n_in, void* d_out, int out_size, void* d_ws, size_t ws_size, hipStream_t stream) {
    static int grid = 0;
    Ptrs p{};
    fill_inputs(p, d_in);
    p.out = (float*)d_out;
    const size_t need = ws_carve(p, (char*)d_ws);
    if (grid == 0) {
        if (need > ws_size || n_in != 33) { fprintf(stderr, "kernel_launch: workspace %zu < %zu or n_in %d != 33; nothing launched\n", ws_size, need, n_in); grid = -1; return; }
        int dev = 0, cus = 0, per_cu = 0;
        if (hipGetDevice(&dev) != hipSuccess || hipDeviceGetAttribute(&cus, hipDeviceAttributeMultiprocessorCount, dev) != hipSuccess) { grid = -1; return; }
        if (hipFuncSetAttribute((const void*)mega_fwd, hipFuncAttributeMaxDynamicSharedMemorySize, LDS_BYTES) != hipSuccess) { fprintf(stderr, "kernel_launch: hipFuncSetAttribute failed\n"); grid = -1; return; }
        if (hipOccupancyMaxActiveBlocksPerMultiprocessor(&per_cu, (const void*)mega_fwd, MEGA_THREADS, LDS_BYTES) != hipSuccess || per_cu < 1) { fprintf(stderr, "kernel_launch: occupancy query says %d blocks per CU; nothing launched\n", per_cu); (void)hipGetLastError(); grid = -1; return; }
        grid = cus;
    }
    if (grid < 0) return;
    (void)hipMemsetAsync(p.BAR, 0, 16384, stream);
    hipLaunchKernelGGL(mega_fwd, dim3(grid), dim3(MEGA_THREADS), LDS_BYTES, stream, p);
}
#endif
```

```cpp
#ifndef CPU_TEST
#include <hip/hip_runtime.h>
#define HD __host__ __device__ __forceinline__
#else
#define HD inline
#endif
#include <cmath>
#include <cstdint>
#include <cstddef>
#include <cstdio>

#ifdef CFG_SMALL
constexpr int D_MODEL = 48, BATCH = 2, GRID_W = 32, SEQ = 384, DEPTH = 2, CTX_LEN = 64;
constexpr int NA_HEADS = 2, NA_HD = 16;
constexpr int GLA_HEADS = 2, GLA_DK = 8, GLA_DV = 16, GLA_RANK = 4;
constexpr int RW_HEADS = 2, RW_HEAD = 16, RW_DR = 6, RW_AR = 6, RW_GR = 8;
constexpr int D_EXPERT = 12;
#else
constexpr int D_MODEL = 2048, BATCH = 4, GRID_W = 64, SEQ = 2048, DEPTH = 2, CTX_LEN = 256;
constexpr int NA_HEADS = 16, NA_HD = 64;
constexpr int GLA_HEADS = 4, GLA_DK = 128, GLA_DV = 256, GLA_RANK = 16;
constexpr int RW_HEADS = 16, RW_HEAD = 64, RW_DR = 96, RW_AR = 96, RW_GR = 256;
constexpr int D_EXPERT = 512;
#endif
constexpr int NA_WIN_R_MAX = 8, NA_WIN_C = 16;
constexpr int NA_W = NA_HEADS * NA_HD;
constexpr int GLA_QK = GLA_HEADS * GLA_DK, GLA_V = GLA_HEADS * GLA_DV;
constexpr float GLA_TAU = 16.0f;
constexpr int RW_W = RW_HEADS * RW_HEAD;
constexpr int RW_IN = 3 * RW_W + 2 * RW_DR + 2 * RW_AR + RW_GR;
constexpr int RW_LOW = 2 * RW_DR + 2 * RW_AR + RW_GR;
constexpr float RW_GN_EPS = 64e-5f;
constexpr int BW = NA_W;
static_assert(GLA_V == BW && RW_W == BW, "branch widths");
constexpr int N_EXPERTS = 16, N_GROUPS = 4, EPG = 4;
constexpr float EPS = 1e-6f;
constexpr int D6 = 6 * D_MODEL;
constexpr int ZO_NAQ = 0, ZO_NAK = NA_W, ZO_NAV = 2 * NA_W;
constexpr int ZO_GQ = 3 * NA_W, ZO_GK = ZO_GQ + GLA_QK, ZO_GV = ZO_GK + GLA_QK, ZO_GR = ZO_GV + GLA_V, ZO_GGD = ZO_GR + GLA_V;
constexpr int ZO_RW = ZO_GGD + 2 * GLA_RANK, ZO_GATE = ZO_RW + RW_IN, D_IN = ZO_GATE + 3 * D_MODEL;
constexpr int RO_R = 0, RO_K = RW_W, RO_V = 2 * RW_W, RO_WD = 3 * RW_W, RO_AD = RO_WD + 2 * RW_DR, RO_GD = RO_AD + 2 * RW_AR;
#ifdef CFG_SMALL
constexpr int ZLD = D_IN;
#else
constexpr int ZLD = 16128;
static_assert(D_IN == 16032, "D_IN");
#endif
constexpr int R_LAT = BATCH * SEQ, R_CTX = BATCH * CTX_LEN, R_ALL = R_LAT + R_CTX;
constexpr int NMOD = BATCH + 1;
constexpr int MOE_TILES = (R_ALL * 2 + N_EXPERTS * 255) / 256 + 1, MOE_ROWS = MOE_TILES * 256;
constexpr int CNT_WORD0 = 3456;

typedef unsigned short bf16_t;
HD float bf2f(bf16_t b) { union { unsigned u; float f; } v; v.u = ((unsigned)b) << 16; return v.f; }
HD bf16_t f2bf(float f) { union { unsigned u; float f; } v; v.f = f; unsigned u = v.u; if ((u & 0x7fffffffu) > 0x7f800000u) return (bf16_t)0x7fc0; u += 0x7FFFu + ((u >> 16) & 1u); return (bf16_t)(u >> 16); }
HD float ldf(const float* p, size_t i) { return p[i]; }
HD float ldf(const bf16_t* p, size_t i) { return bf2f(p[i]); }
HD void stf(float* p, size_t i, float v) { p[i] = v; }
HD void stf(bf16_t* p, size_t i, float v) { p[i] = f2bf(v); }

#ifdef CPU_TEST
typedef float ZT; typedef float AT; typedef float RT;
#else
typedef bf16_t ZT; typedef bf16_t AT; typedef bf16_t RT;
#endif

#if defined(__HIP_DEVICE_COMPILE__)
#define EXPF_(x) __expf(x)
#define LOGF_(x) __logf(x)
#else
#define EXPF_(x) expf(x)
#define LOGF_(x) logf(x)
#endif
HD float sigmoidf_(float x) { return 1.0f / (1.0f + EXPF_(-x)); }
HD float siluf_(float x) { return x / (1.0f + EXPF_(-x)); }
HD float softplusf_(float x) { return (x > 0.f ? x : 0.f) + LOGF_(1.0f + EXPF_(-fabsf(x))); }

struct Ptrs {
    const float *x, *c, *ctx, *c_ctx, *ada_w, *ada_b, *norm1_g, *norm2_g, *w_in, *na_q_norm, *na_k_norm, *na_rpb, *gla_gate_w2, *gla_gate_b, *gla_norm_g,
        *rw_mu, *rw_w0, *rw_w2, *rw_a0, *rw_a2, *rw_g2, *rw_k_k, *rw_k_a, *rw_r_k, *rw_gn_g, *rw_gn_b, *w_branch, *w_out, *router_w, *router_bias,
        *moe_w_gate, *moe_w_up, *moe_w_down;
    float* out;
    float* MOD;
    float* X;
    float* RSTD;
    AT* H;
    ZT* Z;
    AT* Y3;
    RT *GQ, *GK, *GY; float* GA;
    bf16_t *QH, *KP, *KPT, *VTG; float* DL;
    bf16_t *QN, *KN, *VTN;
    float* DEC;
    RT *G, *LOW, *KK, *RS, *VS, *KS, *KD, *BB, *RY;
    bf16_t* WT_RW;
    float* ROPE;
    float* MF;
    int* SELI;
    float* SELW;
    float* ACT;
    bf16_t *WT_IN, *WT_BR, *WT_OUT;
    bf16_t* MB;
    unsigned* BAR;
    bf16_t *WGU, *WD;
    bf16_t *HS, *ACTB;
    bf16_t* YK;
    int *POS, *ROWTOK, *TILE_E;
    float* ROWW;
};

HD int row_bt(int r) { return r < R_LAT ? r / SEQ : BATCH; }
HD int rows_out(int l) { return l < DEPTH - 1 ? R_ALL : R_LAT; }
HD bool row_first(int r) { return r < R_LAT ? (r % SEQ == 0) : ((r - R_LAT) % CTX_LEN == 0); }
HD bool row_last(int r) { return r < R_LAT ? (r % SEQ == SEQ - 1) : ((r - R_LAT) % CTX_LEN == CTX_LEN - 1); }
HD const float* modp(const Ptrs& p, int l, int bt, int k) { return p.MOD + (((size_t)l * NMOD + bt) * 6 + k) * D_MODEL; }
HD int scan_row(int b, int d, int st) {
    if (st < CTX_LEN) return R_LAT + b * CTX_LEN + (d ? CTX_LEN - 1 - st : st);
    const int t = st - CTX_LEN; return b * SEQ + (d ? SEQ - 1 - t : t);
}

struct FMod { Ptrs p;
    HD void operator()(long i) const {
        const int j = (int)(i % D6); const int bt = (int)((i / D6) % NMOD); const int l = (int)(i / ((long)D6 * NMOD));
        const float* cv = bt < BATCH ? p.c + (size_t)bt * D_MODEL : p.c_ctx;
        const float* w = p.ada_w + (size_t)l * D_MODEL * D6 + j;
        float acc = p.ada_b[(size_t)l * D6 + j];
        for (int k = 0; k < D_MODEL; ++k) acc += siluf_(cv[k]) * w[(size_t)k * D6];
        p.MOD[((size_t)l * NMOD + bt) * D6 + j] = acc;
    } };
struct FCopyX { Ptrs p;
    HD void operator()(long i) const { const size_t n = (size_t)R_LAT * D_MODEL; p.X[i] = (size_t)i < n ? p.x[i] : p.ctx[i - n]; } };
struct FRstd { Ptrs p;
    HD void operator()(long r) const { const float* xr = p.X + (size_t)r * D_MODEL; float s = 0.f; for (int d = 0; d < D_MODEL; ++d) s += xr[d] * xr[d]; p.RSTD[r] = 1.0f / sqrtf(s / D_MODEL + EPS); } };
struct FNormMod { Ptrs p; int l, which;
    HD void operator()(long i) const {
        const int r = (int)(i / D_MODEL), d = (int)(i % D_MODEL); const int bt = row_bt(r);
        const float g = (which ? p.norm2_g : p.norm1_g)[(size_t)l * D_MODEL + d];
        const float sh = modp(p, l, bt, which ? 3 : 0)[d], sc = modp(p, l, bt, which ? 4 : 1)[d];
        stf(p.H, (size_t)i, p.X[i] * p.RSTD[r] * g * (1.0f + sc) + sh);
    } };

struct FNaAttn { Ptrs p; int l; int pad_;
    HD void operator()(long i) const {
        const int r = (int)(i / NA_HEADS), h = (int)(i % NA_HEADS);
        const ZT* zr = p.Z + (size_t)r * ZLD;
        float q[NA_HD], acc[NA_HD];
        float ssq = 0.f;
#pragma unroll
        for (int d = 0; d < NA_HD; ++d) { q[d] = ldf(zr, ZO_NAQ + h * NA_HD + d); ssq += q[d] * q[d]; }
        const float rq = 1.0f / sqrtf(ssq / NA_HD + EPS) * (1.0f / sqrtf((float)NA_HD));
#pragma unroll
        for (int d = 0; d < NA_HD; ++d) { q[d] = q[d] * rq * p.na_q_norm[l * NA_HD + d] * p.na_k_norm[l * NA_HD + d]; acc[d] = 0.f; }
        float m = -INFINITY, ls = 0.f;
        auto key = [&](int kr, float bias) {
            const ZT* zk = p.Z + (size_t)kr * ZLD;
            float dot = 0.f, ks = 0.f;
#pragma unroll
            for (int d = 0; d < NA_HD; ++d) { const float kv = ldf(zk, ZO_NAK + h * NA_HD + d); dot += q[d] * kv; ks += kv * kv; }
            const float s = dot / sqrtf(ks / NA_HD + EPS) + bias;
            const float mn = s > m ? s : m; const float corr = expf(m - mn), pe = expf(s - mn);
            ls = ls * corr + pe;
#pragma unroll
            for (int d = 0; d < NA_HD; ++d) acc[d] = acc[d] * corr + pe * ldf(zk, ZO_NAV + h * NA_HD + d);
            m = mn;
        };
        int b;
        if (r < R_LAT) {
            b = r / SEQ; const int t = r % SEQ, gr = t / GRID_W, gc = t % GRID_W;
            constexpr int n_rows = SEQ / GRID_W; constexpr int win_r = NA_WIN_R_MAX < n_rows ? NA_WIN_R_MAX : n_rows;
            int rs = gr - win_r / 2; rs = rs < 0 ? 0 : (rs > n_rows - win_r ? n_rows - win_r : rs);
            int cs = gc - NA_WIN_C / 2; cs = cs < 0 ? 0 : (cs > GRID_W - NA_WIN_C ? GRID_W - NA_WIN_C : cs);
            const float* rp = p.na_rpb + ((size_t)l * NA_HEADS + h) * (2 * NA_WIN_R_MAX - 1) * (2 * NA_WIN_C - 1);
            for (int n = 0; n < win_r; ++n)
                for (int j = 0; j < NA_WIN_C; ++j)
                    key(b * SEQ + (rs + n) * GRID_W + cs + j, rp[(rs + n - gr + NA_WIN_R_MAX - 1) * (2 * NA_WIN_C - 1) + (cs + j - gc + NA_WIN_C - 1)]);
        } else b = (r - R_LAT) / CTX_LEN;
        for (int c = 0; c < CTX_LEN; ++c) key(R_LAT + b * CTX_LEN + c, 0.f);
        const float inv = 1.0f / ls;
#pragma unroll
        for (int d = 0; d < NA_HD; ++d) stf(p.Y3, (size_t)r * BW + h * NA_HD + d, acc[d] * inv);
    } };

struct FGlaPrep { Ptrs p; int l; int pad_;
    HD void operator()(long i) const {
        const int r = (int)(i / GLA_QK), j = (int)(i % GLA_QK), ii = j % GLA_DK, hb = j - ii;
        const ZT* zr = p.Z + (size_t)r * ZLD;
        const float qs = 1.0f / sqrtf((float)GLA_DK);
        float qv = ldf(zr, ZO_GQ + j) * qs, kv = ldf(zr, ZO_GK + j);
        if (r < R_LAT) {
            constexpr int half = GLA_DK / 2, hh2 = half / 2;
            const int t = r % SEQ; const int sect = ii / half, i2 = ii % half, f = i2 % hh2;
            const float pos = (float)(sect == 0 ? t / GRID_W : t % GRID_W);
            const float ang = pos * powf(10000.0f, -(float)(2 * f) / (float)half);
            const float cs = cosf(ang), sn = sinf(ang);
            const int pj = hb + sect * half + (i2 < hh2 ? i2 + hh2 : i2 - hh2);
            const float qp = ldf(zr, ZO_GQ + pj) * qs, kp = ldf(zr, ZO_GK + pj);
            if (i2 < hh2) { qv = qv * cs - qp * sn; kv = kv * cs - kp * sn; } else { qv = qp * sn + qv * cs; kv = kp * sn + kv * cs; }
        }
        stf(p.GQ, (size_t)i, qv); stf(p.GK, (size_t)i, kv);
        for (int d = 0; d < 2; ++d) {
            float pre = p.gla_gate_b[((size_t)l * 2 + d) * GLA_QK + j];
            for (int k = 0; k < GLA_RANK; ++k) pre += ldf(zr, ZO_GGD + d * GLA_RANK + k) * p.gla_gate_w2[(((size_t)l * 2 + d) * GLA_RANK + k) * GLA_QK + j];
            p.GA[(size_t)d * R_ALL * GLA_QK + i] = expf(-softplusf_(-pre) / GLA_TAU);
        }
    } };
struct FGlaScan { Ptrs p; int l; int pad_;
    HD void operator()(long i) const {
        const int vc = (int)(i % GLA_DV); const int ch = (int)(i / GLA_DV); const int d = ch % 2, hh = (ch / 2) % GLA_HEADS, b = ch / (2 * GLA_HEADS);
        float s[GLA_DK];
#pragma unroll
        for (int k = 0; k < GLA_DK; ++k) s[k] = 0.f;
        const float* ga = p.GA + (size_t)d * R_ALL * GLA_QK;
        RT* gy = p.GY + (size_t)d * R_ALL * GLA_V;
        for (int st = 0; st < CTX_LEN + SEQ; ++st) {
            const int r = scan_row(b, d, st);
            const size_t o = (size_t)r * GLA_QK + hh * GLA_DK;
            const float v = ldf(p.Z, (size_t)r * ZLD + ZO_GV + hh * GLA_DV + vc);
            float y = 0.f;
#pragma unroll
            for (int k = 0; k < GLA_DK; ++k) { s[k] = ga[o + k] * s[k] + ldf(p.GK, o + k) * v; y += ldf(p.GQ, o + k) * s[k]; }
            stf(gy, (size_t)r * GLA_V + hh * GLA_DV + vc, y);
        }
    } };
struct FGlaFinish { Ptrs p; int l; int pad_;
    HD void operator()(long i) const {
        const int r = (int)(i / GLA_HEADS), hh = (int)(i % GLA_HEADS);
        const size_t o = (size_t)r * GLA_V + hh * GLA_DV; const RT* y0 = p.GY + o; const RT* y1 = p.GY + (size_t)R_ALL * GLA_V + o;
        float ss = 0.f; for (int v = 0; v < GLA_DV; ++v) { const float y = ldf(y0, v) + ldf(y1, v); ss += y * y; }
        const float rn = 1.0f / sqrtf(ss / GLA_DV + EPS);
        for (int v = 0; v < GLA_DV; ++v) {
            const float y = (ldf(y0, v) + ldf(y1, v)) * rn * p.gla_norm_g[(size_t)l * GLA_DV + v];
            stf(p.Y3, (size_t)R_ALL * BW + o + v, y * siluf_(ldf(p.Z, (size_t)r * ZLD + ZO_GR + hh * GLA_DV + v)));
        }
    } };

HD float rwz(const Ptrs& p, int l, int r, int col) {
    const size_t o = (size_t)r * ZLD + ZO_RW + col;
    const float z0 = ldf(p.Z, o), zp = row_first(r) ? 0.f : ldf(p.Z, o - ZLD), zn = row_last(r) ? 0.f : ldf(p.Z, o + ZLD);
    return z0 + p.rw_mu[(size_t)l * RW_IN + col] * (0.5f * (zp + zn) - z0);
}
struct FRwLow { Ptrs p; int l; int pad_;
    HD void operator()(long i) const {
        const int r = (int)(i / RW_LOW), q = (int)(i % RW_LOW);
        const float z = rwz(p, l, r, RO_WD + q);
        stf(p.LOW, (size_t)i, q < 2 * RW_DR ? tanhf(z) : (q < 2 * RW_DR + 2 * RW_AR ? z : sigmoidf_(z)));
    } };
struct FRwHead { Ptrs p; int l; int pad_;
    HD void operator()(long i) const {
        const int r = (int)(i / RW_HEADS), h = (int)(i % RW_HEADS);
        float ss = 0.f;
        for (int j = 0; j < RW_HEAD; ++j) { const float k = rwz(p, l, r, RO_K + h * RW_HEAD + j) * p.rw_k_k[(size_t)l * RW_W + h * RW_HEAD + j]; ss += k * k; }
        const float rn = 1.0f / sqrtf(ss + EPS);
        for (int j = 0; j < RW_HEAD; ++j) { const int c = h * RW_HEAD + j;
            stf(p.KK, (size_t)r * RW_W + c, rwz(p, l, r, RO_K + c) * p.rw_k_k[(size_t)l * RW_W + c] * rn);
            stf(p.RS, (size_t)r * RW_W + c, rwz(p, l, r, RO_R + c));
            stf(p.VS, (size_t)r * RW_W + c, rwz(p, l, r, RO_V + c)); }
    } };
struct FRwG { Ptrs p; int l; int pad_;
    HD void operator()(long i) const {
        const int r = (int)(i / RW_W), j = (int)(i % RW_W);
        const RT* lo = p.LOW + (size_t)r * RW_LOW + 2 * RW_DR + 2 * RW_AR; float acc = 0.f;
        for (int q = 0; q < RW_GR; ++q) acc += ldf(lo, q) * p.rw_g2[((size_t)l * RW_GR + q) * RW_W + j];
        stf(p.G, (size_t)i, acc);
    } };
struct FRwDir { Ptrs p; int l, d;
    HD void operator()(long i) const {
        const int r = (int)(i / RW_W), j = (int)(i % RW_W);
        const RT* lo = p.LOW + (size_t)r * RW_LOW;
        float wpre = p.rw_w0[((size_t)l * 2 + d) * RW_W + j];
        for (int q = 0; q < RW_DR; ++q) wpre += ldf(lo, d * RW_DR + q) * p.rw_w2[(((size_t)l * 2 + d) * RW_DR + q) * RW_W + j];
        const float w_log = -softplusf_(-wpre) - 0.5f;
        float apre = p.rw_a0[((size_t)l * 2 + d) * RW_W + j];
        for (int q = 0; q < RW_AR; ++q) apre += ldf(lo, 2 * RW_DR + d * RW_AR + q) * p.rw_a2[(((size_t)l * 2 + d) * RW_AR + q) * RW_W + j];
        const float a = sigmoidf_(apre);
        const float kraw = rwz(p, l, r, RO_K + j);
        const size_t o = (size_t)d * R_ALL * RW_W + i;
        p.DEC[o] = EXPF_(-EXPF_(w_log));
        stf(p.KD, o, kraw * (1.0f + (a - 1.0f) * p.rw_k_a[(size_t)l * RW_W + j]));
        stf(p.BB, o, ldf(p.KK, (size_t)i) * a);
    } };
struct FRwScan { Ptrs p; int l, d;
    HD void operator()(long i) const {
        const int vi = (int)(i % RW_HEAD); const int bh = (int)(i / RW_HEAD); const int h = bh % RW_HEADS, b = bh / RW_HEADS;
        float s[RW_HEAD];
#pragma unroll
        for (int j = 0; j < RW_HEAD; ++j) s[j] = 0.f;
        const size_t od = (size_t)d * R_ALL * RW_W;
        for (int st = 0; st < CTX_LEN + SEQ; ++st) {
            const int r = scan_row(b, d, st);
            const size_t o = (size_t)r * RW_W + h * RW_HEAD;
            const float v = ldf(p.VS, o + vi);
            float sa = 0.f;
#pragma unroll
            for (int j = 0; j < RW_HEAD; ++j) sa += s[j] * ldf(p.KK, o + j);
            float y = 0.f;
#pragma unroll
            for (int j = 0; j < RW_HEAD; ++j) { s[j] = s[j] * p.DEC[od + o + j] - sa * ldf(p.BB, od + o + j) + v * ldf(p.KD, od + o + j); y += s[j] * ldf(p.RS, o + j); }
            stf(p.RY, od + o + vi, y);
        }
    } };
struct FRwFinish { Ptrs p; int l; int pad_;
    HD void operator()(long i) const {
        const int r = (int)(i / RW_HEADS), h = (int)(i % RW_HEADS);
        const size_t o = (size_t)r * RW_W + h * RW_HEAD; const RT* y0 = p.RY + o; const RT* y1 = p.RY + (size_t)R_ALL * RW_W + o;
        float mean = 0.f; for (int j = 0; j < RW_HEAD; ++j) mean += ldf(y0, j) + ldf(y1, j);
        mean /= RW_HEAD;
        float var = 0.f, bonus = 0.f;
        for (int j = 0; j < RW_HEAD; ++j) { const float dv = ldf(y0, j) + ldf(y1, j) - mean; var += dv * dv;
            bonus += ldf(p.RS, o + j) * rwz(p, l, r, RO_K + h * RW_HEAD + j) * p.rw_r_k[((size_t)l * RW_HEADS + h) * RW_HEAD + j]; }
        const float rn = 1.0f / sqrtf(var / RW_HEAD + RW_GN_EPS);
        for (int j = 0; j < RW_HEAD; ++j) { const int c = h * RW_HEAD + j;
            float y = (ldf(y0, j) + ldf(y1, j) - mean) * rn * p.rw_gn_g[(size_t)l * RW_W + c] + p.rw_gn_b[(size_t)l * RW_W + c];
            y += bonus * ldf(p.VS, (size_t)r * RW_W + c);
            stf(p.Y3, (size_t)2 * R_ALL * BW + (size_t)r * BW + c, y * ldf(p.G, (size_t)r * RW_W + c)); }
    } };

HD void route_select(const float (&lg)[N_EXPERTS], const float* router_bias, int& i1, int& i2, float& s1, float& s2) {
        float s[N_EXPERTS], bz[N_EXPERTS];
#pragma unroll
        for (int e = 0; e < N_EXPERTS; ++e) { s[e] = sigmoidf_(lg[e]); bz[e] = s[e] + router_bias[e]; }
        int gsel = 0; float gbest = -INFINITY;
#pragma unroll
        for (int gi = 0; gi < N_GROUPS; ++gi) {
            float m1 = -INFINITY, m2 = -INFINITY;
#pragma unroll
            for (int k = 0; k < EPG; ++k) { const float v = bz[gi * EPG + k]; if (v > m1) { m2 = m1; m1 = v; } else if (v > m2) m2 = v; }
            const float sc2 = m1 + m2; if (sc2 > gbest) { gbest = sc2; gsel = gi; }
        }
        int a1 = 0, a2 = 0; float t1 = 0.f, t2 = 0.f, v1 = -INFINITY, v2 = -INFINITY;
#pragma unroll
        for (int e = 0; e < N_EXPERTS; ++e) { const float v = (e / EPG == gsel) ? bz[e] : -INFINITY; const bool g1 = v > v1, g2 = v > v2;
            v2 = g1 ? v1 : (g2 ? v : v2); a2 = g1 ? a1 : (g2 ? e : a2); t2 = g1 ? t1 : (g2 ? s[e] : t2);
            v1 = g1 ? v : v1; a1 = g1 ? e : a1; t1 = g1 ? s[e] : t1; }
        i1 = a1; i2 = a2; s1 = t1; s2 = t2;
}
struct FRouter { Ptrs p; int l; int pad_;
    HD void operator()(long r) const {
        const int bt = row_bt((int)r); const float* xr = p.X + (size_t)r * D_MODEL; const float rstd = p.RSTD[r];
        const float* sh = modp(p, l, bt, 3); const float* sc = modp(p, l, bt, 4); const float* g = p.norm2_g + (size_t)l * D_MODEL;
        float lg[N_EXPERTS];
#pragma unroll
        for (int e = 0; e < N_EXPERTS; ++e) lg[e] = 0.f;
        for (int d = 0; d < D_MODEL; ++d) { const float h = xr[d] * rstd * g[d] * (1.0f + sc[d]) + sh[d]; const float* w = p.router_w + (size_t)d * N_EXPERTS;
#pragma unroll
            for (int e = 0; e < N_EXPERTS; ++e) lg[e] += h * w[e]; }
        int i1, i2; float s1, s2; route_select(lg, p.router_bias, i1, i2, s1, s2);
        const float inv = 1.0f / (s1 + s2);
        p.SELI[2 * r] = i1; p.SELI[2 * r + 1] = i2; p.SELW[2 * r] = s1 * inv; p.SELW[2 * r + 1] = s2 * inv;
    } };
struct FMoeUp { Ptrs p; int l; int pad_;
    HD void operator()(long i) const {
        const int j = (int)(i % D_EXPERT), k = (int)((i / D_EXPERT) % 2), r = (int)(i / (2 * D_EXPERT));
        const int e = p.SELI[2 * r + k];
        const size_t wo = ((size_t)l * N_EXPERTS + e) * D_MODEL * D_EXPERT + j;
        const float* wg = p.moe_w_gate + wo; const float* wu = p.moe_w_up + wo; const AT* h = p.H + (size_t)r * D_MODEL;
        float g = 0.f, u = 0.f;
        for (int d = 0; d < D_MODEL; ++d) { const float hv = ldf(h, d); g += hv * wg[(size_t)d * D_EXPERT]; u += hv * wu[(size_t)d * D_EXPERT]; }
        p.ACT[i] = siluf_(g) * u * p.SELW[2 * r + k];
    } };
struct FMoeDown { Ptrs p; int l; int pad_;
    HD void operator()(long i) const {
        const int r = (int)(i / D_MODEL), d = (int)(i % D_MODEL);
        float acc = 0.f;
        for (int k = 0; k < 2; ++k) { const int e = p.SELI[2 * r + k];
            const float* wd = p.moe_w_down + ((size_t)l * N_EXPERTS + e) * D_EXPERT * D_MODEL + d; const float* a = p.ACT + ((size_t)r * 2 + k) * D_EXPERT;
            for (int j = 0; j < D_EXPERT; ++j) acc += a[j] * wd[(size_t)j * D_MODEL]; }
        p.X[i] += modp(p, l, row_bt(r), 5)[d] * acc;
    } };
struct FOut { Ptrs p; HD void operator()(long i) const { p.out[i] = p.X[i]; } };

struct GIn { Ptrs p; int l; int M, N, K;
    HD float a(int m, int k) const { return ldf(p.H, (size_t)m * D_MODEL + k); }
    HD float b(int k, int n) const { return p.w_in[((size_t)l * D_MODEL + k) * D_IN + n]; }
    HD void epi(int m, int n, float acc) const { stf(p.Z, (size_t)m * ZLD + n, acc); } };
struct GBranch { Ptrs p; int l, br; int M, N, K; int pad_;
    HD float a(int m, int k) const { return ldf(p.Y3, ((size_t)br * R_ALL + m) * BW + k); }
    HD float b(int k, int n) const { return p.w_branch[(((size_t)l * 3 + br) * BW + k) * D_MODEL + n]; }
    HD void epi(int m, int n, float acc) const { const float g = sigmoidf_(ldf(p.Z, (size_t)m * ZLD + ZO_GATE + br * D_MODEL + n)); float* o = p.MF + (size_t)m * D_MODEL + n; *o = (br ? *o : 0.f) + g * acc; } };
struct GOut { Ptrs p; int l; int M, N, K;
    HD float a(int m, int k) const { return p.MF[(size_t)m * D_MODEL + k]; }
    HD float b(int k, int n) const { return p.w_out[((size_t)l * D_MODEL + k) * D_MODEL + n]; }
    HD void epi(int m, int n, float acc) const { p.X[(size_t)m * D_MODEL + n] += modp(p, l, row_bt(m), 2)[n] * acc; } };

static_assert(sizeof(FNaAttn) % 8 == 0 && sizeof(GBranch) % 8 == 0 && sizeof(FRwDir) % 8 == 0 && sizeof(GIn) % 8 == 0 && sizeof(FMod) % 8 == 0, "no tail padding in by-value kernel arguments");
struct WsMap { size_t total; };
inline size_t ws_carve(Ptrs& p, char* base) {
    size_t off = 0;
    auto take = [&](size_t bytes) { char* q = base ? base + off : nullptr; off += (bytes + 255) & ~(size_t)255; return q; };
    p.BAR = (unsigned*)take(16384);
    p.WT_IN = (bf16_t*)take((size_t)ZLD * D_MODEL * 2); p.WT_BR = (bf16_t*)take((size_t)3 * D_MODEL * BW * 2); p.WT_OUT = (bf16_t*)take((size_t)D_MODEL * D_MODEL * 2);
    p.WT_RW = (bf16_t*)take((size_t)5 * RW_W * RW_LOW * 2); p.ROPE = (float*)take((size_t)GRID_W * (GLA_DK / 4) * 2 * 4);
    p.MOD = (float*)take((size_t)DEPTH * NMOD * D6 * 4);
    p.X = (float*)take((size_t)R_ALL * D_MODEL * 4);
    p.RSTD = (float*)take((size_t)R_ALL * 4);
    p.H = (AT*)take((size_t)R_ALL * D_MODEL * sizeof(AT)); p.MB = (bf16_t*)p.H;
    p.Z = (ZT*)take((size_t)R_ALL * ZLD * sizeof(ZT));
    p.Y3 = (AT*)take((size_t)3 * R_ALL * BW * sizeof(AT));
    const size_t u0 = off;
    p.GQ = (RT*)take((size_t)R_ALL * GLA_QK * sizeof(RT)); p.GK = (RT*)take((size_t)R_ALL * GLA_QK * sizeof(RT)); p.GA = (float*)take((size_t)2 * R_ALL * GLA_QK * 4);
#ifdef CPU_TEST
    p.GY = (RT*)take((size_t)2 * R_ALL * GLA_V * sizeof(RT));
#else
    static_assert(2 * GLA_V * sizeof(RT) <= 2 * GLA_QK * 4, "GY fits over GA"); p.GY = (RT*)p.GA;
#endif
    p.QH = (bf16_t*)take((size_t)2 * R_ALL * GLA_QK * 2); p.KP = (bf16_t*)take((size_t)2 * R_ALL * GLA_QK * 2); p.KPT = (bf16_t*)take((size_t)2 * R_ALL * GLA_QK * 2);
    p.VTG = (bf16_t*)take((size_t)BATCH * GLA_V * (SEQ + CTX_LEN) * 2); p.DL = (float*)take((size_t)2 * (R_ALL / 64) * GLA_QK * 4);
    p.QN = (bf16_t*)take((size_t)R_ALL * NA_W * 2); p.KN = (bf16_t*)take((size_t)R_ALL * NA_W * 2); p.VTN = (bf16_t*)take((size_t)BATCH * NA_HEADS * NA_HD * (SEQ + CTX_LEN) * 2);
    p.LOW = (RT*)take((size_t)R_ALL * RW_LOW * sizeof(RT));
    p.KK = (RT*)take((size_t)R_ALL * RW_W * sizeof(RT)); p.RS = (RT*)take((size_t)R_ALL * RW_W * sizeof(RT)); p.VS = (RT*)take((size_t)R_ALL * RW_W * sizeof(RT));
    p.G = (RT*)take((size_t)R_ALL * RW_W * sizeof(RT)); p.KS = (RT*)take((size_t)R_ALL * RW_W * sizeof(RT));
    p.DEC = (float*)take((size_t)2 * R_ALL * RW_W * 4); p.KD = (RT*)take((size_t)2 * R_ALL * RW_W * sizeof(RT)); p.BB = (RT*)take((size_t)2 * R_ALL * RW_W * sizeof(RT));
    p.RY = (RT*)take((size_t)2 * R_ALL * RW_W * sizeof(RT));
    const size_t u1 = off; off = u0;
    p.MF = (float*)take((size_t)R_ALL * D_MODEL * 4);
    p.SELI = (int*)take((size_t)R_ALL * 2 * 4); p.SELW = (float*)take((size_t)R_ALL * 2 * 4);
    p.ACT = (float*)take((size_t)R_ALL * 2 * D_EXPERT * 4);
    p.WGU = (bf16_t*)take((size_t)N_EXPERTS * 2 * D_EXPERT * D_MODEL * 2); p.WD = (bf16_t*)take((size_t)N_EXPERTS * D_MODEL * D_EXPERT * 2);
    p.HS = (bf16_t*)take((size_t)MOE_ROWS * D_MODEL * 2); p.ACTB = (bf16_t*)take((size_t)MOE_ROWS * D_EXPERT * 2);
    p.YK = (bf16_t*)take((size_t)2 * R_ALL * D_MODEL * 2);
    p.POS = (int*)take((size_t)R_ALL * 2 * 4); p.ROWTOK = (int*)take((size_t)MOE_ROWS * 4); p.TILE_E = (int*)take((size_t)(MOE_TILES + 1) * 4); p.ROWW = (float*)take((size_t)MOE_ROWS * 4);
    if (off < u1) off = u1;
    return off;
}

template <class Exec> void run_forward(Exec& ex, const Ptrs& p) {
    ex.items(FMod{p}, (long)DEPTH * NMOD * D6);
    ex.items(FCopyX{p}, (long)R_ALL * D_MODEL);
    for (int l = 0; l < DEPTH; ++l) {
        const int ro = rows_out(l);
        ex.items(FRstd{p}, R_ALL);
        ex.items(FNormMod{p, l, 0}, (long)R_ALL * D_MODEL);
        ex.gemm(GIn{p, l, R_ALL, D_IN, D_MODEL});
        ex.items(FNaAttn{p, l}, (long)ro * NA_HEADS);
        ex.items(FGlaPrep{p, l}, (long)R_ALL * GLA_QK);
        ex.items(FGlaScan{p, l}, (long)BATCH * GLA_HEADS * 2 * GLA_DV);
        ex.items(FGlaFinish{p, l}, (long)ro * GLA_HEADS);
        ex.items(FRwLow{p, l}, (long)R_ALL * RW_LOW);
        ex.items(FRwHead{p, l}, (long)R_ALL * RW_HEADS);
        ex.items(FRwG{p, l}, (long)R_ALL * RW_W);
        for (int d = 0; d < 2; ++d) ex.items(FRwDir{p, l, d}, (long)R_ALL * RW_W);
        for (int d = 0; d < 2; ++d) ex.items(FRwScan{p, l, d}, (long)BATCH * RW_HEADS * RW_HEAD);
        ex.items(FRwFinish{p, l}, (long)ro * RW_HEADS);
        ex.mark(l, 0);
        for (int br = 0; br < 3; ++br) ex.gemm(GBranch{p, l, br, ro, D_MODEL, BW});
        ex.gemm(GOut{p, l, ro, D_MODEL, D_MODEL});
        ex.mark(l, 1);
        ex.items(FRstd{p}, ro);
        ex.items(FRouter{p, l}, ro);
        ex.items(FNormMod{p, l, 1}, (long)ro * D_MODEL);
        ex.items(FMoeUp{p, l}, (long)ro * 2 * D_EXPERT);
        ex.items(FMoeDown{p, l}, (long)ro * D_MODEL);
        ex.mark(l, 2);
    }
    ex.items(FOut{p}, (long)R_LAT * D_MODEL);
}

inline void fill_inputs(Ptrs& p, void* const* d_in) {
    const float** f = (const float**)d_in;
    p.x = f[0]; p.c = f[1]; p.ctx = f[2]; p.c_ctx = f[3]; p.ada_w = f[4]; p.ada_b = f[5]; p.norm1_g = f[6]; p.norm2_g = f[7]; p.w_in = f[8];
    p.na_q_norm = f[9]; p.na_k_norm = f[10]; p.na_rpb = f[11]; p.gla_gate_w2 = f[12]; p.gla_gate_b = f[13]; p.gla_norm_g = f[14];
    p.rw_mu = f[15]; p.rw_w0 = f[16]; p.rw_w2 = f[17]; p.rw_a0 = f[18]; p.rw_a2 = f[19]; p.rw_g2 = f[20]; p.rw_k_k = f[21]; p.rw_k_a = f[22]; p.rw_r_k = f[23];
    p.rw_gn_g = f[24]; p.rw_gn_b = f[25]; p.w_branch = f[26]; p.w_out = f[27]; p.router_w = f[28]; p.router_bias = f[29];
    p.moe_w_gate = f[30]; p.moe_w_up = f[31]; p.moe_w_down = f[32];
}

#ifndef CPU_TEST
namespace pg8 {
#define PG8_LAS __attribute__((address_space(3)))
typedef unsigned short bf16_t;
typedef short bf16x8 __attribute__((ext_vector_type(8)));
typedef float f32x4 __attribute__((ext_vector_type(4)));
typedef unsigned u32x4 __attribute__((ext_vector_type(4)));
constexpr int BM = 256, BK = 64, HALF = 128, HTB = HALF * BK * 2  , STAGE_BYTES = 8 * HTB, NXCD = 8, WGM = 8;

__host__ __device__ __forceinline__ int lds_byte(int r, int c) { const int st = (r >> 4) * 2 + (c >> 5), rr = r & 15, cc = c & 31, ob = rr * 64 + cc * 2; return st * 1024 + (ob ^ (((ob >> 9) & 1) << 5)); }
__host__ __device__ __forceinline__ void stage_rc(int b, int& R, int& C) { const int st = b / 1024, sb = b % 1024, swz = sb ^ (((sb >> 9) & 1) << 5); R = (st >> 1) * 16 + swz / 64; C = (st & 1) * 32 + (swz % 64) / 2; }
__host__ __device__ __forceinline__ int perm32(int rho) { const int n = rho >> 4, i = rho & 15; return 8 * (i >> 2) + 4 * n + (i & 3); }

struct Unit { int pm, pn; };
struct Gemm { const bf16_t* A; const bf16_t* Bt; int M, N, K; };

struct StaticOrder {
    int nM, nN, nwg, G, c;
    __host__ __device__ void init(int M, int N, int G_, int c_) { nM = M / BM; nN = N / BM; nwg = nM * nN; G = G_; c = c_; }
    __host__ __device__ bool next(int i, Unit& u) const {
        const long L = (long)i * G + c; if (L >= nwg) return false;
        int wgid = (int)L; { const int q = nwg / NXCD, r = nwg % NXCD, xcd = wgid % NXCD, off = wgid / NXCD; wgid = (xcd < r ? xcd * (q + 1) : r * (q + 1) + (xcd - r) * q) + off; }
        const int nig = WGM * nN, gid = wgid / nig, fm = gid * WGM, gsz = (nM - fm) < WGM ? (nM - fm) : WGM;
        u.pm = fm + ((wgid % nig) % gsz); u.pn = (wgid % nig) / gsz; return true;
    }
    __device__ __forceinline__ void a_ready(const Unit&) const {}
    __device__ __forceinline__ void done(const Unit&) const {}
};

__device__ __forceinline__ unsigned cvt_pk_bf16(float lo, float hi) { unsigned r; asm volatile("v_cvt_pk_bf16_f32 %0, %1, %2" : "=v"(r) : "v"(lo), "v"(hi)); return r; }
template <class Epi, class Sched, bool ALIGN_EPI = false, bool SP2 = false>
__device__ __forceinline__ void gemm_phase(PG8_LAS unsigned char* lds, const Gemm g, const Sched& S, const Epi& E, const int wv  ) {
    int tid_; asm volatile("v_mbcnt_lo_u32_b32 %0, -1, 0\n\tv_mbcnt_hi_u32_b32 %0, -1, %0" : "=v"(tid_)); tid_ += wv * 64;
    const int tid = tid_, wid = __builtin_amdgcn_readfirstlane(tid >> 6), lane = tid & 63, wr = wid >> 2, wc = wid & 3, fr = lane & 15, fq = lane >> 4;
    const int K = g.K, nt = K / BK;
    unsigned voffA[2], voffB[2];
#pragma unroll
    for (int i = 0; i < 2; ++i) { int R, C; stage_rc(tid * 16 + i * 8192, R, C); const int Rb = Epi::PERM ? ((R & ~31) + perm32(R & 31)) : R;
        voffA[i] = (unsigned)(R * K + C) * 2u; voffB[i] = (unsigned)(Rb * K + C) * 2u; }
    const size_t kstep = (size_t)(BK * 2);
    const size_t hstep = (size_t)HALF * K * 2;
    const size_t tstep = 2 * hstep;
    const unsigned ldsw = (unsigned)wid * 1024u;
    const int aoff = lds_byte(wr * 64 + fr, fq * 8), boff = lds_byte(wc * 32 + fr, fq * 8);
#define PG8_SA(b, h) (((b) * 2 + (h)) * HTB)
#define PG8_SB(b, h) ((4 + (b) * 2 + (h)) * HTB)
#define PG8_STAGE(bufoff, gbase, voff) do { _Pragma("unroll") for (int _i = 0; _i < 2; ++_i) \
        __builtin_amdgcn_global_load_lds((const unsigned*)((const char*)(gbase) + (voff)[_i]), (PG8_LAS unsigned*)(lds + (bufoff) + ldsw + _i * 8192), 16, 0, 0); } while (0)
#define PG8_LDA(dst, b, h) do { _Pragma("unroll") for (int m = 0; m < 4; ++m) _Pragma("unroll") for (int k = 0; k < 2; ++k) dst[m][k] = *(const PG8_LAS bf16x8*)(lds + PG8_SA(b, h) + aoff + m * 2048 + k * 1024); } while (0)
#define PG8_LDB(dst, b, h) do { _Pragma("unroll") for (int n = 0; n < 2; ++n) _Pragma("unroll") for (int k = 0; k < 2; ++k) dst[n][k] = *(const PG8_LAS bf16x8*)(lds + PG8_SB(b, h) + boff + n * 2048 + k * 1024); } while (0)
#define PG8_MMA(ai, bj, At, Bt) do { __builtin_amdgcn_s_setprio(1); _Pragma("unroll") for (int m = 0; m < 4; ++m) _Pragma("unroll") for (int n = 0; n < 2; ++n) _Pragma("unroll") for (int k = 0; k < 2; ++k) \
        acc[ai][bj][m][n] = __builtin_amdgcn_mfma_f32_16x16x32_bf16(Bt[n][k], At[m][k], acc[ai][bj][m][n], 0, 0, 0); __builtin_amdgcn_s_setprio(0); } while (0)
#define PG8_WAIT_V(n) asm volatile("s_waitcnt vmcnt(" #n ")" ::: "memory")
#define PG8_WAIT_L(n) asm volatile("s_waitcnt lgkmcnt(" #n ")" ::: "memory")
#define PG8_BAR __builtin_amdgcn_s_barrier()
#define PG8_SCHED __builtin_amdgcn_sched_barrier(0)
    Unit cur, nxt; int ui = 0;
    if (!S.next(0, cur)) return;
    f32x4 acc[2][2][4][2];
#pragma unroll
    for (int a = 0; a < 2; ++a)
#pragma unroll
        for (int b = 0; b < 2; ++b)
#pragma unroll
            for (int m = 0; m < 4; ++m)
#pragma unroll
                for (int n = 0; n < 2; ++n) acc[a][b][m][n] = (f32x4){0.f, 0.f, 0.f, 0.f};
    bf16x8 At[4][2], B0[2][2], B1[2][2];
    const char* cA = (const char*)g.A + (size_t)cur.pm * tstep; const char* cB = (const char*)g.Bt + (size_t)cur.pn * tstep;
    S.a_ready(cur);
    if constexpr (SP2) {
        PG8_STAGE(PG8_SB(0, 0), cB, voffB); PG8_STAGE(PG8_SB(0, 1), cB + hstep, voffB); PG8_STAGE(PG8_SA(0, 0), cA, voffA); PG8_STAGE(PG8_SA(0, 1), cA + hstep, voffA);
        if (wr == 1) PG8_BAR;
        PG8_WAIT_V(2); PG8_BAR;
        PG8_STAGE(PG8_SB(1, 0), cB + kstep, voffB); PG8_STAGE(PG8_SA(1, 0), cA + kstep, voffA); PG8_STAGE(PG8_SB(1, 1), cB + hstep + kstep, voffB);
        PG8_WAIT_V(6); PG8_BAR;
    } else {
        PG8_STAGE(PG8_SB(0, 0), cB, voffB); PG8_STAGE(PG8_SA(0, 0), cA, voffA); PG8_STAGE(PG8_SB(0, 1), cB + hstep, voffB); PG8_STAGE(PG8_SA(0, 1), cA + hstep, voffA);
        if (wr == 1) PG8_BAR;
        PG8_WAIT_V(4); PG8_BAR;
        PG8_STAGE(PG8_SB(1, 0), cB + kstep, voffB); PG8_STAGE(PG8_SA(1, 0), cA + kstep, voffA); PG8_STAGE(PG8_SB(1, 1), cB + hstep + kstep, voffB);
        PG8_WAIT_V(6); PG8_BAR;
    }
    for (;;) {
        const bool has_next = S.next(ui + 1, nxt);
        const char* nA = has_next ? (const char*)g.A + (size_t)nxt.pm * tstep : cA; const char* nB = has_next ? (const char*)g.Bt + (size_t)nxt.pn * tstep : cB;
        for (int t = 0; t < nt; t += 2) {
            const bool last = (t == nt - 2);
            const char* a1 = cA + (size_t)(t + 1) * kstep;
            const char* a2 = last ? nA : cA + (size_t)(t + 2) * kstep; const char* b2 = last ? nB : cB + (size_t)(t + 2) * kstep;
            const char* a3 = a2 + kstep; const char* b3 = b2 + kstep;
            if (last && has_next) S.a_ready(nxt);
            if constexpr (SP2) {
            PG8_LDB(B0, 0, 0); PG8_LDB(B1, 0, 1); PG8_SCHED; PG8_LDA(At, 0, 0); PG8_STAGE(PG8_SA(1, 1), a1 + hstep, voffA);
            PG8_WAIT_V(8); PG8_WAIT_L(0); PG8_BAR; PG8_MMA(0, 0, At, B0); PG8_MMA(0, 1, At, B1); PG8_BAR; PG8_SCHED;
            PG8_LDA(At, 0, 1); PG8_STAGE(PG8_SB(0, 0), b2, voffB); PG8_STAGE(PG8_SB(0, 1), b2 + hstep, voffB); PG8_STAGE(PG8_SA(0, 0), a2, voffA);
            PG8_WAIT_V(8); PG8_WAIT_L(0); PG8_BAR; PG8_MMA(1, 0, At, B0); PG8_MMA(1, 1, At, B1); PG8_BAR; PG8_SCHED;
            PG8_LDB(B0, 1, 0); PG8_LDB(B1, 1, 1); PG8_SCHED; PG8_LDA(At, 1, 0); PG8_STAGE(PG8_SA(0, 1), a2 + hstep, voffA);
            PG8_WAIT_V(8); PG8_WAIT_L(0); PG8_BAR; PG8_MMA(0, 0, At, B0); PG8_MMA(0, 1, At, B1); PG8_BAR; PG8_SCHED;
            PG8_LDA(At, 1, 1); PG8_STAGE(PG8_SB(1, 0), b3, voffB); PG8_STAGE(PG8_SB(1, 1), b3 + hstep, voffB); PG8_STAGE(PG8_SA(1, 0), a3, voffA);
            PG8_WAIT_V(8); PG8_WAIT_L(0); PG8_BAR; PG8_MMA(1, 0, At, B0); PG8_MMA(1, 1, At, B1); PG8_BAR; PG8_SCHED;
            } else {
            PG8_LDB(B0, 0, 0); PG8_SCHED; PG8_LDA(At, 0, 0); PG8_STAGE(PG8_SA(1, 1), a1 + hstep, voffA);
            PG8_WAIT_L(8); PG8_BAR; PG8_WAIT_L(0); PG8_MMA(0, 0, At, B0); PG8_BAR; PG8_SCHED;
            PG8_LDB(B1, 0, 1); PG8_STAGE(PG8_SB(0, 0), b2, voffB);
            PG8_BAR; PG8_WAIT_L(0); PG8_MMA(0, 1, At, B1); PG8_BAR;
            PG8_LDA(At, 0, 1); PG8_STAGE(PG8_SA(0, 0), a2, voffA);
            PG8_BAR; PG8_WAIT_L(0); PG8_MMA(1, 0, At, B0); PG8_BAR; PG8_SCHED;
            PG8_STAGE(PG8_SB(0, 1), b2 + hstep, voffB);
            PG8_WAIT_V(6); PG8_BAR; PG8_MMA(1, 1, At, B1); PG8_BAR;
            PG8_LDB(B0, 1, 0); PG8_SCHED; PG8_LDA(At, 1, 0); PG8_STAGE(PG8_SA(0, 1), a2 + hstep, voffA);
            PG8_WAIT_L(8); PG8_BAR; PG8_WAIT_L(0); PG8_MMA(0, 0, At, B0); PG8_BAR; PG8_SCHED;
            PG8_LDB(B1, 1, 1); PG8_STAGE(PG8_SB(1, 0), b3, voffB);
            PG8_BAR; PG8_WAIT_L(0); PG8_MMA(0, 1, At, B1); PG8_BAR;
            PG8_LDA(At, 1, 1); PG8_STAGE(PG8_SA(1, 0), a3, voffA);
            PG8_BAR; PG8_WAIT_L(0); PG8_MMA(1, 0, At, B0); PG8_BAR; PG8_SCHED;
            PG8_STAGE(PG8_SB(1, 1), b3 + hstep, voffB);
            PG8_WAIT_V(6); PG8_BAR; PG8_MMA(1, 1, At, B1); PG8_BAR;
            }
        }
        if constexpr (ALIGN_EPI) { if (wr == 0) PG8_BAR; }
        if constexpr (!Epi::AFTER_DRAIN) { E(acc, cur, wr, wc, fr, fq); S.done(cur); }
        if (!has_next) break;
#pragma unroll
        for (int a = 0; a < 2; ++a)
#pragma unroll
            for (int b = 0; b < 2; ++b)
#pragma unroll
                for (int m = 0; m < 4; ++m)
#pragma unroll
                    for (int n = 0; n < 2; ++n) acc[a][b][m][n] = (f32x4){0.f, 0.f, 0.f, 0.f};
        cur = nxt; cA = nA; cB = nB; ++ui;
        if constexpr (ALIGN_EPI) { if (wr == 1) PG8_BAR; }
    }
    PG8_WAIT_V(0);
    if constexpr (!ALIGN_EPI) { if (wr == 0) PG8_BAR; }
    PG8_BAR;
    if constexpr (Epi::AFTER_DRAIN) { E.fused(acc, cur, wr, wc, fr, fq, lds, wid, lane); S.done(cur); }
#undef PG8_SA
#undef PG8_SB
#undef PG8_STAGE
#undef PG8_LDA
#undef PG8_LDB
#undef PG8_MMA
#undef PG8_WAIT_V
#undef PG8_WAIT_L
#undef PG8_BAR
#undef PG8_SCHED
}
}
#define XB_TMO      128
#define XB_XCNT(j)  (256  + 64 * (j))
#define XB_XSUB(j)  (1280 + 64 * (j))
#define XB_XGEN(j)  (2304 + 64 * (j))
#define XB_TOP      3328
#define XB_TOPGEN   3392
#define XCD_BAR_WORDS 3456
#define XB_SPIN_CAP (1u << 18)
#define LAS __attribute__((address_space(3)))

__device__ __forceinline__ unsigned xb_ld(unsigned* p)              { return __hip_atomic_load(p, __ATOMIC_RELAXED, __HIP_MEMORY_SCOPE_AGENT); }
__device__ __forceinline__ unsigned xb_add(unsigned* p, unsigned v) { return __hip_atomic_fetch_add(p, v, __ATOMIC_RELAXED, __HIP_MEMORY_SCOPE_AGENT); }
__device__ __forceinline__ unsigned xb_xcc_id() { return (unsigned)__builtin_amdgcn_s_getreg((3 << 11) | 20) & 0xFu; }
#define XB_SPIN(cond, bar) do { unsigned _sp = 0; while (cond) { __builtin_amdgcn_s_sleep(1); \
    if ((++_sp & 255u) == 0u) { if (xb_ld(&(bar)[XB_TMO])) break; if (_sp > XB_SPIN_CAP) { atomicAdd(&(bar)[XB_TMO], 1u); break; } } } } while (0)

struct XcdBarrier {
    unsigned* bar; unsigned x; int wv;
    volatile LAS unsigned* st;
};

__device__ __forceinline__ XcdBarrier xcd_barrier_post(unsigned* bar, volatile LAS unsigned* st) {
    XcdBarrier b; b.bar = bar; b.x = xb_xcc_id(); b.st = st; b.wv = __builtin_amdgcn_readfirstlane(threadIdx.x >> 6);
    if (threadIdx.x == 0) (void)xb_add(&bar[XB_XCNT(b.x)], 1u);
    return b;
}
__device__ __forceinline__ void xcd_barrier_complete(unsigned* bar, unsigned x, unsigned& nloc, unsigned& nx) {
    const unsigned G = gridDim.x * gridDim.y * gridDim.z;
    unsigned sum, cnt, mine, sp = 0u;
    for (;;) {
        sum = 0u; cnt = 0u; mine = 0u;
#pragma unroll
        for (unsigned j = 0; j < 16; ++j) { const unsigned c = xb_ld(&bar[XB_XCNT(j)]); sum += c; cnt += (c > 0u) ? 1u : 0u; mine = (j == x) ? c : mine; }
        if (sum == G) break;
        __builtin_amdgcn_s_sleep(1);
        if ((++sp & 255u) == 0u) { if (xb_ld(&bar[XB_TMO])) break; if (sp > XB_SPIN_CAP) { atomicAdd(&bar[XB_TMO], 1u); break; } }
    }
    nloc = mine > 0u ? mine : 1u; nx = cnt > 0u ? cnt : 1u;
}

__device__ __forceinline__ void xcd_barrier(const XcdBarrier& b) {
    asm volatile("s_waitcnt vmcnt(0)" ::: "memory");
    __syncthreads();
    int xb_lane; asm volatile("v_mbcnt_lo_u32_b32 %0, -1, 0\n\tv_mbcnt_hi_u32_b32 %0, -1, %0" : "=v"(xb_lane));
    if (b.wv == 0 && xb_lane == 0) {
        unsigned* bar = b.bar;
        __builtin_amdgcn_s_waitcnt(0);
        unsigned nloc = b.st[0], nx = b.st[1];
        if (nloc == 0u) { xcd_barrier_complete(bar, b.x, nloc, nx); b.st[0] = nloc; b.st[1] = nx; }
        const unsigned old = xb_add(&bar[XB_XSUB(b.x)], 1u);
        const unsigned gen = old / nloc;
        if (old + 1u == (gen + 1u) * nloc) {
            __builtin_amdgcn_fence(__ATOMIC_RELEASE, "agent");
            asm volatile("s_waitcnt vmcnt(0)" ::: "memory");
            const unsigned og = xb_add(&bar[XB_TOP], 1u);
            const unsigned tg = og / nx;
            if (og + 1u == (tg + 1u) * nx) xb_add(&bar[XB_TOPGEN], 1u);
            else XB_SPIN(xb_ld(&bar[XB_TOPGEN]) == tg, bar);
            __builtin_amdgcn_fence(__ATOMIC_ACQUIRE, "agent");
            xb_add(&bar[XB_XGEN(b.x)], 1u);
            asm volatile("s_waitcnt vmcnt(0)" ::: "memory");
        } else {
            XB_SPIN(xb_ld(&bar[XB_XGEN(b.x)]) == gen, bar);
            __builtin_amdgcn_fence(__ATOMIC_ACQUIRE, "agent");
            asm volatile("s_waitcnt vmcnt(0)" ::: "memory");
        }
    }
    __syncthreads();
}

constexpr int MEGA_THREADS = 512;
constexpr int LDS_BYTES = pg8::STAGE_BYTES + 16;
typedef float f32x4 __attribute__((ext_vector_type(4)));
typedef unsigned u32x4 __attribute__((ext_vector_type(4)));
typedef unsigned u32x2 __attribute__((ext_vector_type(2)));

__device__ __forceinline__ int opaque_lane() { int l; asm volatile("v_mbcnt_lo_u32_b32 %0, -1, 0\n\tv_mbcnt_hi_u32_b32 %0, -1, %0" : "=v"(l)); return l; }
__device__ __forceinline__ int opaque_tid(int wv) { return wv * 64 + opaque_lane(); }
__device__ __forceinline__ int opaque_grid() { int g = gridDim.x; asm volatile("" : "+s"(g)); return g; }
__device__ __forceinline__ int opaque_block() { int b = blockIdx.x; asm volatile("" : "+s"(b)); return b; }
template <class F> __device__ __forceinline__ void run_items(int wv, const F& f, long n) {
    const int tid = opaque_tid(wv); const int lane = tid & 63, w = tid >> 6; const int G = opaque_grid(), B = opaque_block();
    const long nw = (long)G * (MEGA_THREADS / 64);
    for (long gw = (long)w * G + B; gw * 64 < n; gw += nw) { const long i = gw * 64 + lane; if (i < n) f(i); }
}

template <int CTRL> __device__ __forceinline__ float dpp_mov(float x) { return __int_as_float(__builtin_amdgcn_mov_dpp(__float_as_int(x), CTRL, 0xf, 0xf, true)); }
__device__ __forceinline__ float row16_sum(float x) {
    x += dpp_mov<0xB1>(x);
    x += dpp_mov<0x4E>(x);
    x += dpp_mov<0x141>(x);
    x += dpp_mov<0x140>(x);
    return x;
}
__device__ __forceinline__ float wave_sum(float v) {
    v = row16_sum(v);
    const int b = __float_as_int(v);
    return __int_as_float(__builtin_amdgcn_readlane(b, 0)) + __int_as_float(__builtin_amdgcn_readlane(b, 16)) + (__int_as_float(__builtin_amdgcn_readlane(b, 32)) + __int_as_float(__builtin_amdgcn_readlane(b, 48)));
}

typedef short bf16x8 __attribute__((ext_vector_type(8)));
typedef float f32x16 __attribute__((ext_vector_type(16)));
typedef float f32x4 __attribute__((ext_vector_type(4)));
typedef unsigned u32x4 __attribute__((ext_vector_type(4)));
typedef unsigned u32x2 __attribute__((ext_vector_type(2)));
typedef __bf16 bf16x2_t __attribute__((ext_vector_type(2)));
typedef float f32x2_t __attribute__((ext_vector_type(2)));
#define MFMA32(a, b, c) __builtin_amdgcn_mfma_f32_32x32x16_bf16((a), (b), (c), 0, 0, 0)
__device__ __forceinline__ unsigned pk2(float lo, float hi) { const f32x2_t v = {lo, hi}; return __builtin_bit_cast(unsigned, __builtin_convertvector(v, bf16x2_t)); }
__device__ __forceinline__ bf16x8 pack8(float a0, float a1, float a2, float a3, float a4, float a5, float a6, float a7) {
    u32x4 r; r[0] = pk2(a0, a1); r[1] = pk2(a2, a3); r[2] = pk2(a4, a5); r[3] = pk2(a6, a7); return __builtin_bit_cast(bf16x8, r); }
__device__ __forceinline__ bf16x8 ld8(const bf16_t* p) { return *(const bf16x8*)p; }
__device__ __forceinline__ bf16x8 ld4x2(const bf16_t* lo, const bf16_t* hi) { u32x4 r; const u32x2 a = *(const u32x2*)lo, b = *(const u32x2*)hi; r[0] = a[0]; r[1] = a[1]; r[2] = b[0]; r[3] = b[1]; return __builtin_bit_cast(bf16x8, r); }
__device__ __forceinline__ float half_swap_max(float x) { const auto t = __builtin_amdgcn_permlane32_swap(__float_as_uint(x), __float_as_uint(x), false, false); return fmaxf(__uint_as_float(t[0]), __uint_as_float(t[1])); }
__device__ __forceinline__ float half_swap_sum(float x) { const auto t = __builtin_amdgcn_permlane32_swap(__float_as_uint(x), __float_as_uint(x), false, false); return __uint_as_float(t[0]) + __uint_as_float(t[1]); }
constexpr int T_ALL = SEQ + CTX_LEN;
constexpr float LOG2E = 1.4426950408889634f;

struct FNaPrep { Ptrs p; int l; int pad_;
    __device__ __forceinline__ void operator()(long i) const {
        const int isk = (int)(i & 1), h = (int)((i >> 1) % NA_HEADS), r = (int)(i / (2 * NA_HEADS));
        const bf16_t* z = p.Z + (size_t)r * ZLD + (isk ? ZO_NAK : ZO_NAQ) + h * NA_HD;
        float v[NA_HD]; float ss = 0.f;
#pragma unroll
        for (int q = 0; q < NA_HD / 8; ++q) { const u32x4 w = *(const u32x4*)(z + 8 * q);
#pragma unroll
            for (int k = 0; k < 4; ++k) { v[8 * q + 2 * k] = __uint_as_float(w[k] << 16); v[8 * q + 2 * k + 1] = __uint_as_float(w[k] & 0xffff0000u); } }
#pragma unroll
        for (int d = 0; d < NA_HD; ++d) ss += v[d] * v[d];
        const float rn = 1.0f / sqrtf(ss / NA_HD + EPS) * (isk ? 1.0f : LOG2E / sqrtf((float)NA_HD));
        const float* g = (isk ? p.na_k_norm : p.na_q_norm) + l * NA_HD;
        bf16_t* o = (isk ? p.KN : p.QN) + (size_t)r * NA_W + h * NA_HD;
#pragma unroll
        for (int q = 0; q < NA_HD / 8; ++q) { u32x4 w;
#pragma unroll
            for (int k = 0; k < 4; ++k) w[k] = pk2(v[8 * q + 2 * k] * rn * g[8 * q + 2 * k], v[8 * q + 2 * k + 1] * rn * g[8 * q + 2 * k + 1]);
            *(u32x4*)(o + 8 * q) = w; }
    } };
struct FVt { Ptrs p; bf16_t* dst; int zoff, nheads, hd; int pad_;
    __device__ __forceinline__ void operator()(long i) const {
        const int dim = (int)(i % hd), tb = (int)((i / hd) % (T_ALL / 8)), bh = (int)(i / ((long)hd * (T_ALL / 8))), b = bh / nheads, h = bh % nheads;
        const int tok = tb * 8, row0 = tok < SEQ ? b * SEQ + tok : R_LAT + b * CTX_LEN + (tok - SEQ);
        const bf16_t* z = p.Z + (size_t)row0 * ZLD + zoff + h * hd + dim;
        u32x4 w;
#pragma unroll
        for (int k = 0; k < 4; ++k) w[k] = (unsigned)z[(size_t)(2 * k) * ZLD] | ((unsigned)z[(size_t)(2 * k + 1) * ZLD] << 16);
        *(u32x4*)(dst + ((size_t)bh * hd + dim) * T_ALL + tok) = w;
    } };

constexpr int GLA_NCH = (SEQ + CTX_LEN) / 64, GLA_CCH = CTX_LEN / 64;
static_assert(GLA_DK == 128 && GLA_DV == 256 && GLA_HEADS == 4 && SEQ % 64 == 0 && CTX_LEN % 64 == 0, "GLA kernel geometry");
__device__ __forceinline__ int gla_row0(int b, int cidx) { return cidx < GLA_CCH ? R_LAT + b * CTX_LEN + 64 * cidx : b * SEQ + 64 * (cidx - GLA_CCH); }
__device__ __forceinline__ int gla_tok0(int cidx) { return cidx < GLA_CCH ? SEQ + 64 * cidx : 64 * (cidx - GLA_CCH); }
struct FGlaChunk { Ptrs p;
    __device__ __forceinline__ void operator()(long i) const {
        const int j = (int)(i % GLA_QK), cidx = (int)((i / GLA_QK) % GLA_NCH), b = (int)((i / ((long)GLA_QK * GLA_NCH)) % BATCH), d = (int)(i / ((long)GLA_QK * GLA_NCH * BATCH));
        const int row0 = gla_row0(b, cidx);
        const size_t od = (size_t)d * R_ALL * GLA_QK;
        bf16_t* kpt = p.KPT + ((((size_t)(d * BATCH + b) * GLA_NCH + cidx) * GLA_QK + j) * 64);
        float A = 1.0f;
#pragma unroll 1
        for (int tb = 0; tb < 8; ++tb) {
            float kv[8];
#pragma unroll
            for (int u = 0; u < 8; ++u) { const int t = d ? 63 - (tb * 8 + u) : tb * 8 + u; const size_t o = (size_t)(row0 + t) * GLA_QK + j;
                A *= p.GA[od + o];
                const float q = bf2f(p.GQ[o]) * A, k = bf2f(p.GK[o]) * __builtin_amdgcn_rcpf(A);
                p.QH[od + o] = f2bf(q); p.KP[od + o] = f2bf(k); kv[d ? 7 - u : u] = k; }
            u32x4 w; w[0] = pk2(kv[0], kv[1]); w[1] = pk2(kv[2], kv[3]); w[2] = pk2(kv[4], kv[5]); w[3] = pk2(kv[6], kv[7]);
            *(u32x4*)(kpt + (d ? 56 - tb * 8 : tb * 8)) = w;
        }
        p.DL[((size_t)(d * BATCH + b) * GLA_NCH + cidx) * GLA_QK + j] = A;
    } };
__device__ __forceinline__ void gla_task(const Ptrs& p, int chain, int w, int lane) {
    const int c = lane & 31, hf = lane >> 5;
    const int d = chain & 1, hh = (chain >> 1) % GLA_HEADS, b = chain / (2 * GLA_HEADS);
    f32x16 S[4];
#pragma unroll
    for (int kb = 0; kb < 4; ++kb)
#pragma unroll
        for (int r = 0; r < 16; ++r) S[kb][r] = 0.f;
    const size_t od = (size_t)d * R_ALL * GLA_QK;
    const bf16_t* vt = p.VTG + ((size_t)(b * GLA_HEADS + hh) * GLA_DV + 32 * w + c) * T_ALL;
    for (int step = 0; step < GLA_NCH; ++step) {
        const int cidx = d ? (step < GLA_CCH ? GLA_CCH - 1 - step : GLA_NCH - 1 - (step - GLA_CCH)) : step;
        const int row0 = gla_row0(b, cidx), tok0 = gla_tok0(cidx);
        const bf16_t* qh = p.QH + od + (size_t)row0 * GLA_QK + hh * GLA_DK;
        const bf16_t* kp = p.KP + od + (size_t)row0 * GLA_QK + hh * GLA_DK;
        f32x16 y[2];
#pragma unroll
        for (int ib = 0; ib < 2; ++ib)
#pragma unroll
            for (int r = 0; r < 16; ++r) y[ib][r] = 0.f;
#pragma unroll
        for (int t3 = 0; t3 < 3; ++t3) {
            const int jb = (t3 == 2) ? 1 : 0, ib = (t3 == 0) ? 0 : 1;
            const int JB = d ? ib : jb, IB = d ? jb : ib;
            f32x16 at;
#pragma unroll
            for (int r = 0; r < 16; ++r) at[r] = 0.f;
#pragma unroll
            for (int ks = 0; ks < 8; ++ks) at = MFMA32(ld8(kp + (size_t)(32 * JB + c) * GLA_QK + ks * 16 + 8 * hf), ld8(qh + (size_t)(32 * IB + c) * GLA_QK + ks * 16 + 8 * hf), at);
            if (JB == IB) {
#pragma unroll
                for (int r = 0; r < 16; ++r) { const int jj = (r & 3) + 8 * (r >> 2) + 4 * hf; at[r] = (d ? jj >= c : jj <= c) ? at[r] : 0.f; }
            }
#pragma unroll
            for (int s = 0; s < 2; ++s) {
                const bf16x8 af = pack8(at[8 * s], at[8 * s + 1], at[8 * s + 2], at[8 * s + 3], at[8 * s + 4], at[8 * s + 5], at[8 * s + 6], at[8 * s + 7]);
                const bf16_t* vp = vt + tok0 + 32 * JB + 16 * s + 4 * hf;
                if (IB == 0) y[0] = MFMA32(af, ld4x2(vp, vp + 8), y[0]); else y[1] = MFMA32(af, ld4x2(vp, vp + 8), y[1]);
            }
        }
#pragma unroll
        for (int kb = 0; kb < 4; ++kb)
#pragma unroll
            for (int s = 0; s < 2; ++s) {
                const bf16x8 sf = pack8(S[kb][8 * s], S[kb][8 * s + 1], S[kb][8 * s + 2], S[kb][8 * s + 3], S[kb][8 * s + 4], S[kb][8 * s + 5], S[kb][8 * s + 6], S[kb][8 * s + 7]);
#pragma unroll
                for (int ib = 0; ib < 2; ++ib) { const bf16_t* qp = qh + (size_t)(32 * ib + c) * GLA_QK + 32 * kb + 16 * s + 4 * hf; y[ib] = MFMA32(ld4x2(qp, qp + 8), sf, y[ib]); }
            }
        bf16_t* gy = p.GY + ((size_t)d * R_ALL + row0) * GLA_V + hh * GLA_DV + 32 * w + c;
#pragma unroll
        for (int ib = 0; ib < 2; ++ib)
#pragma unroll
            for (int r = 0; r < 16; ++r) gy[(size_t)(32 * ib + (r & 3) + 8 * (r >> 2) + 4 * hf) * GLA_V] = f2bf(y[ib][r]);
        const bf16_t* kt = p.KPT + (((size_t)(d * BATCH + b) * GLA_NCH + cidx) * GLA_QK + hh * GLA_DK) * 64;
        const float* dl = p.DL + ((size_t)(d * BATCH + b) * GLA_NCH + cidx) * GLA_QK + hh * GLA_DK;
#pragma unroll
        for (int kb = 0; kb < 4; ++kb) {
#pragma unroll
            for (int ks = 0; ks < 4; ++ks) S[kb] = MFMA32(ld8(kt + (size_t)(32 * kb + c) * 64 + 16 * ks + 8 * hf), ld8(vt + tok0 + 16 * ks + 8 * hf), S[kb]);
#pragma unroll
            for (int g = 0; g < 4; ++g) { const f32x4 dv = *(const f32x4*)(dl + 32 * kb + 8 * g + 4 * hf);
#pragma unroll
                for (int k = 0; k < 4; ++k) S[kb][4 * g + k] *= dv[k]; }
        }
    }
}
__device__ __forceinline__ void gla_phase(int wv, const Ptrs& p, int wg0) {
    const int tid = opaque_tid(wv), lane = tid & 63; const int B = opaque_block();
    if (B >= wg0 && B < wg0 + BATCH * GLA_HEADS * 2) gla_task(p, B - wg0, wv, lane);
}

constexpr int NA_LAT_UNITS = BATCH * NA_HEADS * (SEQ / GRID_W) * (GRID_W / 32);
constexpr int NA_CTX_UNITS = BATCH * NA_HEADS * (CTX_LEN / 32);
constexpr int NA_RPB_N = NA_HEADS * (2 * NA_WIN_R_MAX - 1) * (2 * NA_WIN_C - 1);
static_assert(GRID_W == 64 && NA_HD == 64 && SEQ / GRID_W == 32 && NA_HEADS == 16 && CTX_LEN % 32 == 0, "NA kernel geometry");
__device__ __forceinline__ void na_softmax_pv(const float (&s)[16], float& m, float& ls, f32x16& o0, f32x16& o1, const bf16_t* vtb, int c, int hh) {
    float bm = s[0];
#pragma unroll
    for (int r = 1; r < 16; ++r) bm = fmaxf(bm, s[r]);
    bm = half_swap_max(bm);
    const float mn = fmaxf(m, bm), ms = (mn == -INFINITY) ? 0.f : mn;
    const float alpha = __builtin_amdgcn_exp2f(m - ms);
    m = mn;
    float pv[16], psum = 0.f;
#pragma unroll
    for (int r = 0; r < 16; ++r) { pv[r] = __builtin_amdgcn_exp2f(s[r] - ms); psum += pv[r]; }
    ls = ls * alpha + psum;
#pragma unroll
    for (int r = 0; r < 16; ++r) { o0[r] *= alpha; o1[r] *= alpha; }
#pragma unroll
    for (int ks = 0; ks < 2; ++ks) {
        const bf16x8 pb = pack8(pv[8 * ks], pv[8 * ks + 1], pv[8 * ks + 2], pv[8 * ks + 3], pv[8 * ks + 4], pv[8 * ks + 5], pv[8 * ks + 6], pv[8 * ks + 7]);
        const bf16_t* v0 = vtb + (size_t)c * T_ALL + 16 * ks + 4 * hh;
        const bf16_t* v1 = vtb + (size_t)(32 + c) * T_ALL + 16 * ks + 4 * hh;
        o0 = MFMA32(ld4x2(v0, v0 + 8), pb, o0);
        o1 = MFMA32(ld4x2(v1, v1 + 8), pb, o1);
    }
}
__device__ __forceinline__ void na_unit(const Ptrs& p, int u, int lane, const LAS float* rpb) {
    const int c = lane & 31, hh = lane >> 5;
    int b, h, qrow, gr = 0, qc = 0, nloc;
    if (u < NA_LAT_UNITS) { const int qh = u & 1; gr = (u >> 1) & 31; h = (u >> 6) & 15; b = u >> 10; qc = 32 * qh + c; qrow = b * SEQ + gr * GRID_W + qc; nloc = NA_WIN_R_MAX; }
    else { const int v = u - NA_LAT_UNITS; h = (v >> 3) & 15; b = v >> 7; qrow = R_LAT + b * CTX_LEN + 32 * (v & 7) + c; nloc = 0; }
    bf16x8 qf[4];
#pragma unroll
    for (int ks = 0; ks < 4; ++ks) qf[ks] = ld8(p.QN + (size_t)qrow * NA_W + h * NA_HD + ks * 16 + 8 * hh);
    int rs = gr - NA_WIN_R_MAX / 2; rs = rs < 0 ? 0 : (rs > SEQ / GRID_W - NA_WIN_R_MAX ? SEQ / GRID_W - NA_WIN_R_MAX : rs);
    int cs = qc - NA_WIN_C / 2; cs = cs < 0 ? 0 : (cs > GRID_W - NA_WIN_C ? GRID_W - NA_WIN_C : cs);
    f32x16 o0, o1;
#pragma unroll
    for (int r = 0; r < 16; ++r) { o0[r] = 0.f; o1[r] = 0.f; }
    float m = -INFINITY, ls = 0.f;
    const bf16_t* vt = p.VTN + (size_t)(b * NA_HEADS + h) * NA_HD * T_ALL;
    for (int blk = 0; blk < 2 * nloc; ++blk) {
        const int n = blk >> 1, kb = blk & 1, tok0 = (rs + n) * GRID_W + 32 * kb;
        const bf16_t* kp = p.KN + (size_t)(b * SEQ + tok0 + c) * NA_W + h * NA_HD + 8 * hh;
        f32x16 S;
#pragma unroll
        for (int r = 0; r < 16; ++r) S[r] = 0.f;
#pragma unroll
        for (int ks = 0; ks < 4; ++ks) S = MFMA32(ld8(kp + ks * 16), qf[ks], S);
        const LAS float* rp = rpb + (h * (2 * NA_WIN_R_MAX - 1) + (rs + n - gr + NA_WIN_R_MAX - 1)) * (2 * NA_WIN_C - 1);
        float s[16];
#pragma unroll
        for (int r = 0; r < 16; ++r) { const int kc = 32 * kb + (r & 3) + 8 * (r >> 2) + 4 * hh; int idx = kc - qc + NA_WIN_C - 1; idx = idx < 0 ? 0 : (idx > 2 * NA_WIN_C - 2 ? 2 * NA_WIN_C - 2 : idx);
            s[r] = ((unsigned)(kc - cs) < (unsigned)NA_WIN_C) ? S[r] + rp[idx] : -INFINITY; }
        na_softmax_pv(s, m, ls, o0, o1, vt + tok0, c, hh);
    }
    for (int cb = 0; cb < CTX_LEN / 32; ++cb) {
        const bf16_t* kp = p.KN + (size_t)(R_LAT + b * CTX_LEN + 32 * cb + c) * NA_W + h * NA_HD + 8 * hh;
        f32x16 S;
#pragma unroll
        for (int r = 0; r < 16; ++r) S[r] = 0.f;
#pragma unroll
        for (int ks = 0; ks < 4; ++ks) S = MFMA32(ld8(kp + ks * 16), qf[ks], S);
        float s[16];
#pragma unroll
        for (int r = 0; r < 16; ++r) s[r] = S[r];
        na_softmax_pv(s, m, ls, o0, o1, vt + SEQ + 32 * cb, c, hh);
    }
    const float inv = 1.0f / half_swap_sum(ls);
    bf16_t* yo = p.Y3 + (size_t)qrow * BW + h * NA_HD + 4 * hh;
#pragma unroll
    for (int g = 0; g < 4; ++g) {
        u32x2 w0, w1; w0[0] = pk2(o0[4 * g] * inv, o0[4 * g + 1] * inv); w0[1] = pk2(o0[4 * g + 2] * inv, o0[4 * g + 3] * inv);
        w1[0] = pk2(o1[4 * g] * inv, o1[4 * g + 1] * inv); w1[1] = pk2(o1[4 * g + 2] * inv, o1[4 * g + 3] * inv);
        *(u32x2*)(yo + 8 * g) = w0; *(u32x2*)(yo + 32 + 8 * g) = w1;
    }
}
__device__ __forceinline__ void na_phase(int wv, const Ptrs& p, int l, LAS unsigned char* lds, int wg0, int nwg) {
    const int tid = opaque_tid(wv), lane = tid & 63; const int B = opaque_block();
    LAS float* rpb = (LAS float*)lds;
    __syncthreads();
    for (int i = tid; i < NA_RPB_N; i += MEGA_THREADS) rpb[i] = p.na_rpb[(size_t)l * NA_RPB_N + i] * LOG2E;
    __syncthreads();
    const int nunits = NA_LAT_UNITS + (l < DEPTH - 1 ? NA_CTX_UNITS : 0);
    if (B >= wg0 && B < wg0 + nwg)
        for (int u = wv * nwg + (B - wg0); u < nunits; u += nwg * (MEGA_THREADS / 64)) na_unit(p, u, lane, rpb);
}

__device__ __forceinline__ void ld8f(const bf16_t* p, float (&v)[8]) { const u32x4 w = *(const u32x4*)p;
#pragma unroll
    for (int k = 0; k < 4; ++k) { v[2 * k] = __uint_as_float(w[k] << 16); v[2 * k + 1] = __uint_as_float(w[k] & 0xffff0000u); } }
__device__ __forceinline__ void st8f(bf16_t* p, const float (&v)[8]) { u32x4 w;
#pragma unroll
    for (int k = 0; k < 4; ++k) w[k] = pk2(v[2 * k], v[2 * k + 1]);
    *(u32x4*)p = w; }
__device__ __forceinline__ float sum8(float x) { x += dpp_mov<0xB1>(x); x += dpp_mov<0x4E>(x); x += dpp_mov<0x141>(x); return x; }
__device__ __forceinline__ float sum32(float x) { x = row16_sum(x); const auto t = __builtin_amdgcn_permlane16_swap(__float_as_uint(x), __float_as_uint(x), false, false); return __uint_as_float(t[0]) + __uint_as_float(t[1]); }
__device__ __forceinline__ float fast_tanh(float x) { return 1.0f - 2.0f / (__expf(2.0f * x) + 1.0f); }
struct FRope { Ptrs p;
    __device__ __forceinline__ void operator()(long i) const { const int pos = (int)(i / (GLA_DK / 4)), f = (int)(i % (GLA_DK / 4)); const float ang = (float)pos * powf(10000.0f, -(float)(2 * f) / (float)(GLA_DK / 2));
        p.ROPE[2 * i] = cosf(ang); p.ROPE[2 * i + 1] = sinf(ang); } };
struct FRwWt { Ptrs p; int l; int pad_;
    __device__ __forceinline__ void operator()(long i) const {
        const int n = (int)(i % (5 * RW_W)), k0 = (int)(i / (5 * RW_W)) * 8, cb = n / RW_W, j = n % RW_W;
        const int koff = cb < 2 ? cb * RW_DR : (cb < 4 ? 2 * RW_DR + (cb - 2) * RW_AR : 2 * RW_DR + 2 * RW_AR), klen = cb < 2 ? RW_DR : (cb < 4 ? RW_AR : RW_GR);
        const float* W = cb < 2 ? p.rw_w2 + ((size_t)l * 2 + cb) * RW_DR * RW_W : (cb < 4 ? p.rw_a2 + ((size_t)l * 2 + cb - 2) * RW_AR * RW_W : p.rw_g2 + (size_t)l * RW_GR * RW_W);
        float v[8];
#pragma unroll
        for (int e = 0; e < 8; ++e) { const int k = k0 + e - koff; v[e] = (k >= 0 && k < klen) ? W[(size_t)k * RW_W + j] : 0.f; }
        st8f(p.WT_RW + (size_t)n * RW_LOW + k0, v);
    } };
static_assert(RW_DR % 8 == 0 && RW_AR % 8 == 0 && RW_LOW % 128 == 0 && RW_LOW / 64 % 2 == 0, "RWKV low-rank GEMM geometry");

constexpr int PR_W2 = 0, PR_GB = PR_W2 + 2 * GLA_RANK * GLA_QK, PR_ROPE = PR_GB + 2 * GLA_QK, PR_MU = PR_ROPE + GRID_W * (GLA_DK / 4) * 2, PR_KK = PR_MU + RW_IN, PR_END = PR_KK + RW_W;
static_assert(PR_END * 4 <= pg8::STAGE_BYTES && RW_IN % 8 == 0 && (RW_IN / 8) <= 8 * 64 && ZO_RW % 8 == 0 && GLA_QK == 512 && NA_W == 1024 && RW_W == 1024, "prep_rows geometry");
__device__ __forceinline__ void prep_rows(int wv, const Ptrs& p, int l, LAS unsigned char* lds) {
    const int tid = opaque_tid(wv), lane = tid & 63; const int G = opaque_grid(), B = opaque_block();
    LAS float* T = (LAS float*)lds;
    __syncthreads();
    for (int i = tid; i < 2 * GLA_RANK * GLA_QK; i += MEGA_THREADS) T[PR_W2 + i] = p.gla_gate_w2[(size_t)l * 2 * GLA_RANK * GLA_QK + i];
    for (int i = tid; i < 2 * GLA_QK; i += MEGA_THREADS) T[PR_GB + i] = p.gla_gate_b[(size_t)l * 2 * GLA_QK + i];
    for (int i = tid; i < GRID_W * (GLA_DK / 4) * 2; i += MEGA_THREADS) T[PR_ROPE + i] = p.ROPE[i];
    for (int i = tid; i < RW_IN; i += MEGA_THREADS) T[PR_MU + i] = p.rw_mu[(size_t)l * RW_IN + i];
    for (int i = tid; i < RW_W; i += MEGA_THREADS) T[PR_KK + i] = p.rw_k_k[(size_t)l * RW_W + i];
    __syncthreads();
    for (int r = wv * G + B; r < R_ALL; r += G * (MEGA_THREADS / 64)) {
        asm volatile("" ::: "memory");
        const bf16_t* zr = p.Z + (size_t)r * ZLD;
        const bool lat = r < R_LAT; const int tk = r % SEQ, gr = tk / GRID_W, gc = tk % GRID_W;
#pragma unroll
        for (int it = 0; it < 4; ++it) {
            const int isk = it >> 1, col = (it & 1) * 512 + lane * 8;
            float v[8]; ld8f(zr + (isk ? ZO_NAK : ZO_NAQ) + col, v);
            float ss = 0.f;
#pragma unroll
            for (int e = 0; e < 8; ++e) ss += v[e] * v[e];
            ss = sum8(ss);
            const float rn = 1.0f / sqrtf(ss / NA_HD + EPS) * (isk ? 1.0f : LOG2E / sqrtf((float)NA_HD));
            const float* g = (isk ? p.na_k_norm : p.na_q_norm) + l * NA_HD + (col % NA_HD);
#pragma unroll
            for (int e = 0; e < 8; ++e) v[e] *= rn * g[e];
            st8f((isk ? p.KN : p.QN) + (size_t)r * NA_W + col, v);
        }
        {
            const int j0 = lane * 8, i2 = j0 % (GLA_DK / 2), sect = (j0 % GLA_DK) / (GLA_DK / 2); const bool first = i2 < GLA_DK / 4; const int f0 = i2 % (GLA_DK / 4), pj = first ? j0 + GLA_DK / 4 : j0 - GLA_DK / 4;
            float q[8], k[8], qp[8], kp[8];
            ld8f(zr + ZO_GQ + j0, q); ld8f(zr + ZO_GK + j0, k);
            const float qs = 1.0f / sqrtf((float)GLA_DK);
            if (lat) {
                ld8f(zr + ZO_GQ + pj, qp); ld8f(zr + ZO_GK + pj, kp);
                const LAS float* cs = T + PR_ROPE + ((sect ? gc : gr) * (GLA_DK / 4) + f0) * 2;
#pragma unroll
                for (int e = 0; e < 8; ++e) { const float c = cs[2 * e], s = cs[2 * e + 1];
                    q[e] = first ? q[e] * c - qp[e] * s : qp[e] * s + q[e] * c; k[e] = first ? k[e] * c - kp[e] * s : kp[e] * s + k[e] * c; }
            }
#pragma unroll
            for (int e = 0; e < 8; ++e) q[e] *= qs;
            st8f(p.GQ + (size_t)r * GLA_QK + j0, q); st8f(p.GK + (size_t)r * GLA_QK + j0, k);
            float gd[2 * GLA_RANK];
#pragma unroll
            for (int c = 0; c < 2 * GLA_RANK / 8; ++c) { float t8[8]; ld8f(zr + ZO_GGD + 8 * c, t8);
#pragma unroll
                for (int e = 0; e < 8; ++e) gd[8 * c + e] = t8[e]; }
#pragma unroll
            for (int d = 0; d < 2; ++d) {
                float pre[8];
#pragma unroll
                for (int e = 0; e < 8; ++e) pre[e] = T[PR_GB + d * GLA_QK + j0 + e];
#pragma unroll
                for (int kk = 0; kk < GLA_RANK; ++kk) { const LAS f32x4* w = (const LAS f32x4*)(T + PR_W2 + (d * GLA_RANK + kk) * GLA_QK + j0); const f32x4 w0 = w[0], w1 = w[1]; const float gv = gd[d * GLA_RANK + kk];
                    pre[0] += gv * w0[0]; pre[1] += gv * w0[1]; pre[2] += gv * w0[2]; pre[3] += gv * w0[3]; pre[4] += gv * w1[0]; pre[5] += gv * w1[1]; pre[6] += gv * w1[2]; pre[7] += gv * w1[3]; }
                f32x4 a0, a1;
#pragma unroll
                for (int e = 0; e < 4; ++e) { a0[e] = __expf(-softplusf_(-pre[e]) * (1.0f / GLA_TAU)); a1[e] = __expf(-softplusf_(-pre[4 + e]) * (1.0f / GLA_TAU)); }
                f32x4* ga = (f32x4*)(p.GA + ((size_t)d * R_ALL + r) * GLA_QK + j0); ga[0] = a0; ga[1] = a1;
            }
        }
        const bool rf = row_first(r), rl = row_last(r);
#pragma unroll
        for (int it = 0; it < 8; ++it) {
            const int ci = it * 64 + lane;
            if (it < 7 || ci < RW_IN / 8) {
                const int col = ci * 8;
                float z0[8], zp[8], zn[8], zs[8];
                ld8f(zr + ZO_RW + col, z0);
                if (rf) {
#pragma unroll
                    for (int e = 0; e < 8; ++e) zp[e] = 0.f; } else ld8f(zr - ZLD + ZO_RW + col, zp);
                if (rl) {
#pragma unroll
                    for (int e = 0; e < 8; ++e) zn[e] = 0.f; } else ld8f(zr + ZLD + ZO_RW + col, zn);
#pragma unroll
                for (int e = 0; e < 8; ++e) zs[e] = z0[e] + T[PR_MU + col + e] * (0.5f * (zp[e] + zn[e]) - z0[e]);
                if (it < 2) st8f(p.RS + (size_t)r * RW_W + col, zs);
                else if (it < 4) { const int c2 = col - RW_W;
                    st8f(p.KS + (size_t)r * RW_W + c2, zs);
                    float kk[8], ss = 0.f;
#pragma unroll
                    for (int e = 0; e < 8; ++e) { kk[e] = zs[e] * T[PR_KK + c2 + e]; ss += kk[e] * kk[e]; }
                    ss = sum8(ss);
                    const float rn = 1.0f / sqrtf(ss + EPS);
#pragma unroll
                    for (int e = 0; e < 8; ++e) kk[e] *= rn;
                    st8f(p.KK + (size_t)r * RW_W + c2, kk); }
                else if (it < 6) st8f(p.VS + (size_t)r * RW_W + col - 2 * RW_W, zs);
                else { const int q = col - 3 * RW_W;
#pragma unroll
                    for (int e = 0; e < 8; ++e) zs[e] = q < 2 * RW_DR ? fast_tanh(zs[e]) : (q < 2 * RW_DR + 2 * RW_AR ? zs[e] : 1.0f / (1.0f + __expf(-zs[e])));
                    st8f(p.LOW + (size_t)r * RW_LOW + q, zs); }
            }
        }
    }
}
__device__ __forceinline__ void finish_rows(int wv, const Ptrs& p, int l, int ro) {
    const int tid = opaque_tid(wv), lane = tid & 63; const int G = opaque_grid(), B = opaque_block();
    for (int r = wv * G + B; r < ro; r += G * (MEGA_THREADS / 64)) {
        asm volatile("" ::: "memory");
#pragma unroll
        for (int it = 0; it < 2; ++it) {
            const int col = it * 512 + lane * 8;
            float y0[8], y1[8], rg[8];
            ld8f(p.GY + (size_t)r * GLA_V + col, y0); ld8f(p.GY + ((size_t)R_ALL + r) * GLA_V + col, y1); ld8f(p.Z + (size_t)r * ZLD + ZO_GR + col, rg);
            float ss = 0.f;
#pragma unroll
            for (int e = 0; e < 8; ++e) { y0[e] += y1[e]; ss += y0[e] * y0[e]; }
            ss = sum32(ss);
            const float rn = 1.0f / sqrtf(ss / GLA_DV + EPS);
            const float* g = p.gla_norm_g + (size_t)l * GLA_DV + (col % GLA_DV);
#pragma unroll
            for (int e = 0; e < 8; ++e) y0[e] = y0[e] * rn * g[e] * (rg[e] / (1.0f + __expf(-rg[e])));
            st8f(p.Y3 + (size_t)R_ALL * BW + (size_t)r * BW + col, y0);
        }
#pragma unroll
        for (int it = 0; it < 2; ++it) {
            const int col = it * 512 + lane * 8; const size_t o = (size_t)r * RW_W + col;
            float y0[8], y1[8], rs[8], ks[8], vs[8], gg[8];
            ld8f(p.RY + o, y0); ld8f(p.RY + (size_t)R_ALL * RW_W + o, y1); ld8f(p.RS + o, rs); ld8f(p.KS + o, ks); ld8f(p.VS + o, vs); ld8f(p.G + o, gg);
            const float* rk = p.rw_r_k + (size_t)l * RW_W + col; const float* gng = p.rw_gn_g + (size_t)l * RW_W + col; const float* gnb = p.rw_gn_b + (size_t)l * RW_W + col;
            float sm = 0.f, bonus = 0.f;
#pragma unroll
            for (int e = 0; e < 8; ++e) { y0[e] += y1[e]; sm += y0[e]; bonus += rs[e] * ks[e] * rk[e]; }
            const float mean = sum8(sm) * (1.0f / RW_HEAD); bonus = sum8(bonus);
            float var = 0.f;
#pragma unroll
            for (int e = 0; e < 8; ++e) { y0[e] -= mean; var += y0[e] * y0[e]; }
            const float rn = 1.0f / sqrtf(sum8(var) * (1.0f / RW_HEAD) + RW_GN_EPS);
#pragma unroll
            for (int e = 0; e < 8; ++e) y0[e] = (y0[e] * rn * gng[e] + gnb[e] + bonus * vs[e]) * gg[e];
            st8f(p.Y3 + (size_t)2 * R_ALL * BW + (size_t)r * BW + col, y0);
        }
    }
}
struct EpiRw {
    static constexpr bool PERM = true, AFTER_DRAIN = false;
    float* DEC; bf16_t *KD, *BB, *Gt; const bf16_t *KS, *KK; const float *w0, *a0, *ka;
    __device__ __forceinline__ void operator()(const pg8::f32x4 (&acc)[2][2][4][2], const pg8::Unit& u, int wr, int wc, int fr, int fq) const {
        const int cb = u.pn >> 2, row0 = u.pm * 256 + wr * 64 + fr, col0 = (u.pn & 3) * 256 + wc * 32 + 8 * fq;
#pragma unroll
        for (int ai = 0; ai < 2; ++ai)
#pragma unroll
            for (int m = 0; m < 4; ++m) { const size_t row = (size_t)(row0 + ai * 128 + m * 16);
#pragma unroll
                for (int bj = 0; bj < 2; ++bj) { const int j = col0 + bj * 128;
                    float v[8];
#pragma unroll
                    for (int e = 0; e < 4; ++e) { v[e] = acc[ai][bj][m][0][e]; v[4 + e] = acc[ai][bj][m][1][e]; }
                    if (cb < 2) { f32x4 d0, d1;
#pragma unroll
                        for (int e = 0; e < 4; ++e) { d0[e] = __expf(-__expf(-softplusf_(-(v[e] + w0[cb * RW_W + j + e])) - 0.5f)); d1[e] = __expf(-__expf(-softplusf_(-(v[4 + e] + w0[cb * RW_W + j + 4 + e])) - 0.5f)); }
                        f32x4* dp = (f32x4*)(DEC + ((size_t)cb * R_ALL + row) * RW_W + j); dp[0] = d0; dp[1] = d1; }
                    else if (cb < 4) { const int d = cb - 2; float ks[8], kk[8];
                        ld8f(KS + row * RW_W + j, ks); ld8f(KK + row * RW_W + j, kk);
#pragma unroll
                        for (int e = 0; e < 8; ++e) { const float a = 1.0f / (1.0f + __expf(-(v[e] + a0[d * RW_W + j + e]))); ks[e] *= 1.0f + (a - 1.0f) * ka[j + e]; kk[e] *= a; }
                        st8f(KD + ((size_t)d * R_ALL + row) * RW_W + j, ks); st8f(BB + ((size_t)d * R_ALL + row) * RW_W + j, kk); }
                    else st8f(Gt + row * RW_W + j, v);
                } }
    }
};
__device__ __forceinline__ void norm_rows(int wv, const Ptrs& p, int l, int which, int nrows, bool addmoe) {
    static_assert(D_MODEL == 2048, "norm_rows lane mapping");
    const int tid = opaque_tid(wv); const int lane = tid & 63, w = tid >> 6;
    const float* gain = (which ? p.norm2_g : p.norm1_g) + (size_t)l * D_MODEL;
    const int G = opaque_grid(), B = opaque_block();
    for (int r = w * G + B; r < nrows; r += G * (MEGA_THREADS / 64)) {
        const f32x4* xr = (const f32x4*)(p.X + (size_t)r * D_MODEL);
        f32x4 v[8]; float ss = 0.f;
        const int bt = row_bt(r);
#pragma unroll
        for (int i = 0; i < 8; ++i) v[i] = xr[lane + 64 * i];
        if (addmoe) {
            const f32x4* g2p = (const f32x4*)modp(p, l - 1, bt, 5);
#pragma unroll
            for (int i = 0; i < 8; ++i) { const int c = lane + 64 * i;
                const u32x2 a = *(const u32x2*)(p.YK + (size_t)r * D_MODEL + 4 * c), b = *(const u32x2*)(p.YK + ((size_t)R_ALL + r) * D_MODEL + 4 * c); const f32x4 g = g2p[c];
                v[i][0] += g[0] * (__uint_as_float(a[0] << 16) + __uint_as_float(b[0] << 16)); v[i][1] += g[1] * (__uint_as_float(a[0] & 0xffff0000u) + __uint_as_float(b[0] & 0xffff0000u));
                v[i][2] += g[2] * (__uint_as_float(a[1] << 16) + __uint_as_float(b[1] << 16)); v[i][3] += g[3] * (__uint_as_float(a[1] & 0xffff0000u) + __uint_as_float(b[1] & 0xffff0000u));
                ((f32x4*)(p.X + (size_t)r * D_MODEL))[c] = v[i]; }
        }
#pragma unroll
        for (int i = 0; i < 8; ++i) ss += v[i][0] * v[i][0] + v[i][1] * v[i][1] + v[i][2] * v[i][2] + v[i][3] * v[i][3];
        ss = wave_sum(ss);
        const float rstd = 1.0f / sqrtf(ss / D_MODEL + EPS);
        const f32x4* sh = (const f32x4*)modp(p, l, bt, which ? 3 : 0); const f32x4* sc = (const f32x4*)modp(p, l, bt, which ? 4 : 1); const f32x4* g4 = (const f32x4*)gain;
        float lg[N_EXPERTS];
#pragma unroll
        for (int e = 0; e < N_EXPERTS; ++e) lg[e] = 0.f;
#pragma unroll
        for (int i = 0; i < 8; ++i) {
            const int c = lane + 64 * i; const f32x4 g = g4[c], s = sc[c], b = sh[c]; f32x4 h;
#pragma unroll
            for (int k = 0; k < 4; ++k) h[k] = v[i][k] * rstd * g[k] * (1.0f + s[k]) + b[k];
            u32x2 pk; pk[0] = pg8::cvt_pk_bf16(h[0], h[1]); pk[1] = pg8::cvt_pk_bf16(h[2], h[3]);
            *(u32x2*)(p.H + (size_t)r * D_MODEL + 4 * c) = pk;
            if (which) {
#pragma unroll
                for (int k = 0; k < 4; ++k) { const f32x4* rw = (const f32x4*)(p.router_w + (size_t)(4 * c + k) * N_EXPERTS);
#pragma unroll
                    for (int q = 0; q < 4; ++q) { const f32x4 wv = rw[q]; lg[4 * q] += h[k] * wv[0]; lg[4 * q + 1] += h[k] * wv[1]; lg[4 * q + 2] += h[k] * wv[2]; lg[4 * q + 3] += h[k] * wv[3]; } }
            }
        }
        if (which) {
#pragma unroll
            for (int e = 0; e < N_EXPERTS; ++e) lg[e] = wave_sum(lg[e]);
            if (lane == 0) { int i1, i2; float s1, s2; route_select(lg, p.router_bias, i1, i2, s1, s2); const float inv = 1.0f / (s1 + s2);
                p.SELI[2 * r] = i1; p.SELI[2 * r + 1] = i2; p.SELW[2 * r] = s1 * inv; p.SELW[2 * r + 1] = s2 * inv;
                unsigned* cnt = p.BAR + CNT_WORD0 + l * N_EXPERTS * 16;
                p.POS[2 * r] = (int)__hip_atomic_fetch_add(cnt + i1 * 16, 1u, __ATOMIC_RELAXED, __HIP_MEMORY_SCOPE_AGENT);
                p.POS[2 * r + 1] = (int)__hip_atomic_fetch_add(cnt + i2 * 16, 1u, __ATOMIC_RELAXED, __HIP_MEMORY_SCOPE_AGENT); }
        }
    }
}

__device__ __forceinline__ void conv_tile(const float* __restrict__ W, int ldw, int nvalid, bf16_t* __restrict__ Wt, int K, int kb, int nb, float* tile, int tid) {
    { const int n = tid & 63, k0 = tid >> 6;
#pragma unroll
      for (int i = 0; i < 8; ++i) { const int k = k0 + 8 * i; tile[k * 65 + n] = (nb + n < nvalid) ? W[(size_t)(kb + k) * ldw + nb + n] : 0.f; } }
    __syncthreads();
    { const int kp = (tid & 31) * 2, n0 = tid >> 5;
#pragma unroll
      for (int i = 0; i < 4; ++i) { const int n = n0 + 16 * i; *(unsigned*)(Wt + (size_t)(nb + n) * K + kb + kp) = pg8::cvt_pk_bf16(tile[kp * 65 + n], tile[(kp + 1) * 65 + n]); } }
    __syncthreads();
}
__device__ __forceinline__ void conv_wT(int wv, const float* __restrict__ W, bf16_t* __restrict__ Wt, int K, int N, int Npad, float* tile) {
    const int tn = Npad / 64, tk = K / 64, tid = opaque_tid(wv);
    const int G = opaque_grid(), B = opaque_block();
    for (int t = B; t < tn * tk; t += G) conv_tile(W, N, N, Wt, K, (t / tn) * 64, (t % tn) * 64, tile, tid);
}
__device__ __forceinline__ void conv_moe(int wv, const Ptrs& p, int l, float* tile) {
    const int tid = opaque_tid(wv); const int G = opaque_grid(), B = opaque_block();
    constexpr int TK = D_MODEL / 64, PER_E = 2 * D_EXPERT / 64 * TK;
    for (int t = B; t < N_EXPERTS * PER_E; t += G) {
        const int e = t / PER_E, q = t % PER_E, rt = q % (2 * D_EXPERT / 64), kt = q / (2 * D_EXPERT / 64);
        const int row = rt * 64, pn = row / 256, up = (row % 256) / 128, c0 = pn * 128 + (row % 128);
        const float* W = (up ? p.moe_w_up : p.moe_w_gate) + ((size_t)l * N_EXPERTS + e) * D_MODEL * D_EXPERT + c0;
        conv_tile(W, D_EXPERT, 64, p.WGU + ((size_t)e * 2 * D_EXPERT + row) * D_MODEL, D_MODEL, kt * 64, 0, tile, tid);
    }
    constexpr int TKD = D_EXPERT / 64, PER_ED = D_MODEL / 64 * TKD;
    for (int t = B; t < N_EXPERTS * PER_ED; t += G) {
        const int e = t / PER_ED, q = t % PER_ED, nt = q % (D_MODEL / 64), kt = q / (D_MODEL / 64);
        conv_tile(p.moe_w_down + ((size_t)l * N_EXPERTS + e) * D_EXPERT * D_MODEL, D_MODEL, D_MODEL, p.WD + (size_t)e * D_MODEL * D_EXPERT, D_EXPERT, kt * 64, nt * 64, tile, tid);
    }
}

struct EpiZ {
    static constexpr bool PERM = true, AFTER_DRAIN = false;
    bf16_t* O;
    __device__ __forceinline__ void operator()(const f32x4 (&acc)[2][2][4][2], const pg8::Unit& u, int wr, int wc, int fr, int fq) const {
        const int row0 = u.pm * 256 + wr * 64 + fr, col0 = u.pn * 256 + wc * 32 + 8 * fq;
#pragma unroll
        for (int ai = 0; ai < 2; ++ai)
#pragma unroll
            for (int m = 0; m < 4; ++m) { bf16_t* rowp = O + (size_t)(row0 + ai * 128 + m * 16) * ZLD + col0;
#pragma unroll
                for (int bj = 0; bj < 2; ++bj) { const f32x4 v0 = acc[ai][bj][m][0], v1 = acc[ai][bj][m][1];
                    u32x4 pk; pk[0] = pg8::cvt_pk_bf16(v0[0], v0[1]); pk[1] = pg8::cvt_pk_bf16(v0[2], v0[3]); pk[2] = pg8::cvt_pk_bf16(v1[0], v1[1]); pk[3] = pg8::cvt_pk_bf16(v1[2], v1[3]);
                    *(u32x4*)(rowp + bj * 128) = pk; } }
    }
};
template <int BR> struct EpiBranch {
    static constexpr bool PERM = false, AFTER_DRAIN = false;
    const bf16_t* Z; float* MF; bf16_t* MB;
    __device__ __forceinline__ void operator()(const f32x4 (&acc)[2][2][4][2], const pg8::Unit& u, int wr, int wc, int fr, int fq) const {
        const int row0 = u.pm * 256 + wr * 64 + fr, col0 = u.pn * 256 + wc * 32 + 4 * fq;
#pragma unroll
        for (int ai = 0; ai < 2; ++ai)
#pragma unroll
            for (int m = 0; m < 4; ++m) { const size_t row = (size_t)(row0 + ai * 128 + m * 16);
#pragma unroll
                for (int bj = 0; bj < 2; ++bj)
#pragma unroll
                    for (int n = 0; n < 2; ++n) { const int col = col0 + bj * 128 + n * 16;
                        const u32x2 gz = *(const u32x2*)(Z + row * ZLD + ZO_GATE + BR * D_MODEL + col);
                        f32x4 g; g[0] = __uint_as_float(gz[0] << 16); g[1] = __uint_as_float(gz[0] & 0xffff0000u); g[2] = __uint_as_float(gz[1] << 16); g[3] = __uint_as_float(gz[1] & 0xffff0000u);
                        f32x4 val;
#pragma unroll
                        for (int k = 0; k < 4; ++k) val[k] = acc[ai][bj][m][n][k] / (1.0f + __expf(-g[k]));
                        float* mp = MF + row * D_MODEL + col;
                        if (BR > 0) val += *(const f32x4*)mp;
                        if (BR < 2) *(f32x4*)mp = val;
                        else { u32x2 pk; pk[0] = pg8::cvt_pk_bf16(val[0], val[1]); pk[1] = pg8::cvt_pk_bf16(val[2], val[3]); *(u32x2*)(MB + row * D_MODEL + col) = pk; } }
            }
    }
};
struct EpiOut {
    static constexpr bool PERM = false, AFTER_DRAIN = false;
    float* X; const float* MODL;
    __device__ __forceinline__ void operator()(const f32x4 (&acc)[2][2][4][2], const pg8::Unit& u, int wr, int wc, int fr, int fq) const {
        const int row0 = u.pm * 256 + wr * 64 + fr, col0 = u.pn * 256 + wc * 32 + 4 * fq;
#pragma unroll
        for (int ai = 0; ai < 2; ++ai)
#pragma unroll
            for (int m = 0; m < 4; ++m) { const int row = row0 + ai * 128 + m * 16; const float* g1 = MODL + ((size_t)row_bt(row) * 6 + 2) * D_MODEL;
#pragma unroll
                for (int bj = 0; bj < 2; ++bj)
#pragma unroll
                    for (int n = 0; n < 2; ++n) { const int col = col0 + bj * 128 + n * 16; float* xp = X + (size_t)row * D_MODEL + col;
                        *(f32x4*)xp = *(const f32x4*)xp + *(const f32x4*)(g1 + col) * acc[ai][bj][m][n]; }
            }
    }
};


constexpr int RWS_T = 64;
constexpr int RWS_REC = 896;
constexpr int RWS_BUF = RWS_T * RWS_REC;
static_assert(2 * RWS_BUF <= pg8::STAGE_BYTES && (RWS_T * (RWS_REC / 16)) % MEGA_THREADS == 0 && (CTX_LEN + SEQ) % RWS_T == 0 && RW_HEAD == 64, "RWKV scan staging");
__device__ __forceinline__ void rw_scan_issue(const Ptrs& p, int b, int h, int d, int batch, LAS unsigned char* buf, int tid) {
    const size_t od = (size_t)d * R_ALL * RW_W;
#pragma unroll
    for (int q = 0; q < RWS_T * (RWS_REC / 16) / MEGA_THREADS; ++q) {
        const int id = q * MEGA_THREADS + tid, st = id / (RWS_REC / 16), c = id % (RWS_REC / 16);
        const int r = scan_row(b, d, batch * RWS_T + st);
        const size_t o = (size_t)r * RW_W + h * RW_HEAD;
        const char* src;
        if (c < 16) src = (const char*)(p.DEC + od + o) + c * 16;
        else { const int a = (c - 16) >> 3, cc = (c - 16) & 7;
            const bf16_t* base = a == 0 ? p.KK + o : a == 1 ? p.BB + od + o : a == 2 ? p.KD + od + o : a == 3 ? p.RS + o : p.VS + o;
            src = (const char*)base + cc * 16; }
        __builtin_amdgcn_global_load_lds((const unsigned*)src, (LAS unsigned*)(buf + (size_t)(q * MEGA_THREADS + (tid & ~63)) * 16), 16, 0, 0);
    }
}
__device__ __forceinline__ void rw_scan_chain(int wv, const Ptrs& p, int chain, LAS unsigned char* lds) {
    const int tid = opaque_tid(wv), cg = tid & 15, rp = tid >> 4;
    const int d = chain & 1, h = (chain >> 1) % RW_HEADS, b = chain / (2 * RW_HEADS);
    float s0[4], s1[4];
#pragma unroll
    for (int j = 0; j < 4; ++j) { s0[j] = 0.f; s1[j] = 0.f; }
    constexpr int NB = (CTX_LEN + SEQ) / RWS_T;
    __syncthreads();
    rw_scan_issue(p, b, h, d, 0, lds, tid);
    bf16_t* ry = p.RY + (size_t)d * R_ALL * RW_W + h * RW_HEAD + 2 * rp;
    for (int batch = 0; batch < NB; ++batch) {
        asm volatile("s_waitcnt vmcnt(0)" ::: "memory");
        __syncthreads();
        if (batch + 1 < NB) rw_scan_issue(p, b, h, d, batch + 1, lds + ((batch + 1) & 1) * RWS_BUF, tid);
        const LAS unsigned char* rec = lds + (batch & 1) * RWS_BUF;
        for (int s16 = 0; s16 < RWS_T; s16 += 16) {
            float yk0 = 0.f, yk1 = 0.f;
#pragma unroll
            for (int u = 0; u < 16; ++u) {
                const LAS unsigned char* rr = rec + (s16 + u) * RWS_REC;
                const f32x4 w = *(const LAS f32x4*)(rr + cg * 16);
                const u32x2 kkp = *(const LAS u32x2*)(rr + 256 + cg * 8), bbp = *(const LAS u32x2*)(rr + 384 + cg * 8), kdp = *(const LAS u32x2*)(rr + 512 + cg * 8), rsp = *(const LAS u32x2*)(rr + 640 + cg * 8);
                const unsigned vp = *(const LAS unsigned*)(rr + 768 + rp * 4);
                float kk[4], bb[4], kd[4], rs[4];
                kk[0] = __uint_as_float(kkp[0] << 16); kk[1] = __uint_as_float(kkp[0] & 0xffff0000u); kk[2] = __uint_as_float(kkp[1] << 16); kk[3] = __uint_as_float(kkp[1] & 0xffff0000u);
                bb[0] = __uint_as_float(bbp[0] << 16); bb[1] = __uint_as_float(bbp[0] & 0xffff0000u); bb[2] = __uint_as_float(bbp[1] << 16); bb[3] = __uint_as_float(bbp[1] & 0xffff0000u);
                kd[0] = __uint_as_float(kdp[0] << 16); kd[1] = __uint_as_float(kdp[0] & 0xffff0000u); kd[2] = __uint_as_float(kdp[1] << 16); kd[3] = __uint_as_float(kdp[1] & 0xffff0000u);
                rs[0] = __uint_as_float(rsp[0] << 16); rs[1] = __uint_as_float(rsp[0] & 0xffff0000u); rs[2] = __uint_as_float(rsp[1] << 16); rs[3] = __uint_as_float(rsp[1] & 0xffff0000u);
                const float v0 = __uint_as_float(vp << 16), v1 = __uint_as_float(vp & 0xffff0000u);
                float sa0 = s0[0] * kk[0] + s0[1] * kk[1] + (s0[2] * kk[2] + s0[3] * kk[3]);
                float sa1 = s1[0] * kk[0] + s1[1] * kk[1] + (s1[2] * kk[2] + s1[3] * kk[3]);
                sa0 = row16_sum(sa0); sa1 = row16_sum(sa1);
                float y0 = 0.f, y1 = 0.f;
#pragma unroll
                for (int j = 0; j < 4; ++j) {
                    s0[j] = s0[j] * w[j] + (v0 * kd[j] - sa0 * bb[j]); y0 += s0[j] * rs[j];
                    s1[j] = s1[j] * w[j] + (v1 * kd[j] - sa1 * bb[j]); y1 += s1[j] * rs[j];
                }
                y0 = row16_sum(y0); y1 = row16_sum(y1);
                yk0 = (cg == u) ? y0 : yk0; yk1 = (cg == u) ? y1 : yk1;
            }
            const int r = scan_row(b, d, batch * RWS_T + s16 + cg);
            *(unsigned*)(ry + (size_t)r * RW_W) = pg8::cvt_pk_bf16(yk0, yk1);
        }
    }
}

__device__ __forceinline__ void moe_gather(int wv, const Ptrs& p, int l, int ro, int* so  ) {
    const int tid = opaque_tid(wv), lane = tid & 63, w = tid >> 6;
    const unsigned* cnt = p.BAR + CNT_WORD0 + l * N_EXPERTS * 16;
    __syncthreads();
    if (tid == 0) { int o = 0; for (int e = 0; e < N_EXPERTS; ++e) { so[e] = o; const int c = (int)__hip_atomic_load(cnt + e * 16, __ATOMIC_RELAXED, __HIP_MEMORY_SCOPE_AGENT); so[32 + e] = c; o += (c + 255) & ~255; } so[N_EXPERTS] = o; }
    __syncthreads();
    const int ntiles = so[N_EXPERTS] / 256;
    if (opaque_block() == 0) {
        for (int t = tid; t < ntiles; t += MEGA_THREADS) { int e = 0; for (int q = 1; q < N_EXPERTS; ++q) if (so[q] <= t * 256) e = q; p.TILE_E[t] = e; }
        if (tid == 0) p.TILE_E[MOE_TILES] = ntiles;
    }
    if (opaque_block() < N_EXPERTS) { const int e = opaque_block(); for (int rr = so[e] + so[32 + e] + tid; rr < so[e + 1]; rr += MEGA_THREADS) { p.ROWTOK[rr] = -1; p.ROWW[rr] = 0.f; } }
    const int G = opaque_grid(), B = opaque_block();
    for (int it = w * G + B; it < ro * 2; it += G * (MEGA_THREADS / 64)) {
        const int e = p.SELI[it], dst = so[e] + p.POS[it];
        const u32x4* src = (const u32x4*)(p.H + (size_t)(it >> 1) * D_MODEL); u32x4* d = (u32x4*)(p.HS + (size_t)dst * D_MODEL);
#pragma unroll
        for (int i = 0; i < 4; ++i) d[lane + 64 * i] = src[lane + 64 * i];
        if (lane == 0) { p.ROWTOK[dst] = it; p.ROWW[dst] = p.SELW[it]; }
    }
}
struct MoeOrder {
    int ntiles, nN, G, c; const int* tile_e;
    __device__ __forceinline__ bool next(int i, pg8::Unit& u) const { const long L = (long)i * G + c; if (L >= (long)ntiles * nN) return false; const int t = (int)(L / nN); u.pm = t; u.pn = tile_e[t] * nN + (int)(L % nN); return true; }
    __device__ __forceinline__ void a_ready(const pg8::Unit&) const {}
    __device__ __forceinline__ void done(const pg8::Unit&) const {}
};
struct EpiMoeUp {
    static constexpr bool PERM = true, AFTER_DRAIN = false;
    bf16_t* ACTB; const float* ROWW;
    __device__ __forceinline__ void operator()(const f32x4 (&acc)[2][2][4][2], const pg8::Unit& u, int wr, int wc, int fr, int fq) const {
        const int row0 = u.pm * 256 + wr * 64 + fr, col0 = (u.pn & 3) * 128 + wc * 32 + 8 * fq;
        static_assert(2 * D_EXPERT / 256 == 4, "EpiMoeUp column tiles");
#pragma unroll
        for (int ai = 0; ai < 2; ++ai)
#pragma unroll
            for (int m = 0; m < 4; ++m) { const int row = row0 + ai * 128 + m * 16; const float w = ROWW[row];
                float a[8];
#pragma unroll
                for (int n = 0; n < 2; ++n)
#pragma unroll
                    for (int k = 0; k < 4; ++k) { const float g = acc[ai][0][m][n][k], uu = acc[ai][1][m][n][k]; a[4 * n + k] = g / (1.0f + __expf(-g)) * uu * w; }
                u32x4 pk; pk[0] = pg8::cvt_pk_bf16(a[0], a[1]); pk[1] = pg8::cvt_pk_bf16(a[2], a[3]); pk[2] = pg8::cvt_pk_bf16(a[4], a[5]); pk[3] = pg8::cvt_pk_bf16(a[6], a[7]);
                *(u32x4*)(ACTB + (size_t)row * D_EXPERT + col0) = pk; }
    }
};
struct EpiMoeDown {
    static constexpr bool PERM = true, AFTER_DRAIN = false;
    bf16_t* YK; const int* ROWTOK;
    __device__ __forceinline__ void operator()(const f32x4 (&acc)[2][2][4][2], const pg8::Unit& u, int wr, int wc, int fr, int fq) const {
        static_assert(D_MODEL / 256 == 8, "EpiMoeDown column tiles");
        const int row0 = u.pm * 256 + wr * 64 + fr, col0 = (u.pn & 7) * 256 + wc * 32 + 8 * fq;
#pragma unroll
        for (int ai = 0; ai < 2; ++ai)
#pragma unroll
            for (int m = 0; m < 4; ++m) { const int tok = ROWTOK[row0 + ai * 128 + m * 16];
                if (tok >= 0) { bf16_t* rowp = YK + ((size_t)(tok & 1) * R_ALL + (tok >> 1)) * D_MODEL + col0;
#pragma unroll
                    for (int bj = 0; bj < 2; ++bj) { const f32x4 v0 = acc[ai][bj][m][0], v1 = acc[ai][bj][m][1];
                        u32x4 pk; pk[0] = pg8::cvt_pk_bf16(v0[0], v0[1]); pk[1] = pg8::cvt_pk_bf16(v0[2], v0[3]); pk[2] = pg8::cvt_pk_bf16(v1[0], v1[1]); pk[3] = pg8::cvt_pk_bf16(v1[2], v1[3]);
                        *(u32x4*)(rowp + bj * 128) = pk; } } }
    }
};
template <class Epi> __device__ __forceinline__ void moe_gemm_call(int wv, LAS unsigned char* lds, const Ptrs& p, const bf16_t* A, const bf16_t* Bt, int nN, int K, const Epi& E) {
    pg8::Gemm g{A, Bt, 0, 0, K}; MoeOrder S{p.TILE_E[MOE_TILES], nN, opaque_grid(), opaque_block(), p.TILE_E};
    pg8::gemm_phase<Epi, MoeOrder, true, true>(lds, g, S, E, wv);
}
__device__ __forceinline__ void final_out(int wv, const Ptrs& p) {
    const int tid = opaque_tid(wv);
    const size_t n4 = (size_t)R_LAT * D_MODEL / 4;
    const int G = opaque_grid(), B = opaque_block();
    for (size_t i = (size_t)B * MEGA_THREADS + tid; i < n4; i += (size_t)G * MEGA_THREADS) {
        const int r = (int)(i / (D_MODEL / 4)), c = (int)(i % (D_MODEL / 4));
        const f32x4 g = ((const f32x4*)modp(p, DEPTH - 1, row_bt(r), 5))[c]; f32x4 v = ((const f32x4*)p.X)[i];
        const u32x2 a = *(const u32x2*)(p.YK + i * 4), b = *(const u32x2*)(p.YK + (size_t)R_ALL * D_MODEL + i * 4);
        v[0] += g[0] * (__uint_as_float(a[0] << 16) + __uint_as_float(b[0] << 16)); v[1] += g[1] * (__uint_as_float(a[0] & 0xffff0000u) + __uint_as_float(b[0] & 0xffff0000u));
        v[2] += g[2] * (__uint_as_float(a[1] << 16) + __uint_as_float(b[1] << 16)); v[3] += g[3] * (__uint_as_float(a[1] & 0xffff0000u) + __uint_as_float(b[1] & 0xffff0000u));
        ((f32x4*)p.out)[i] = v;
    }
}

template <class Epi> __device__ __forceinline__ void gemm_call(int wv, LAS unsigned char* lds, const bf16_t* A, const bf16_t* Bt, int M, int N, int K, const Epi& E) {
    pg8::Gemm g{A, Bt, M, N, K}; pg8::StaticOrder S; S.init(M, N, opaque_grid(), opaque_block());
    pg8::gemm_phase<Epi, pg8::StaticOrder, true, true>(lds, g, S, E, wv);
}

__global__ void __launch_bounds__(MEGA_THREADS, 2) mega_fwd(Ptrs p) {
    extern __shared__ __attribute__((aligned(16))) unsigned char smem[];
    LAS unsigned char* lds = (LAS unsigned char*)smem;
    volatile LAS unsigned* stw = (volatile LAS unsigned*)(lds + pg8::STAGE_BYTES);
    const int wv = __builtin_amdgcn_readfirstlane(threadIdx.x >> 6);
    if (threadIdx.x < 4) stw[threadIdx.x] = 0u;
    __syncthreads();
    const XcdBarrier bar = xcd_barrier_post(p.BAR, stw);
#define GRID_SYNC() xcd_barrier(bar)

    { run_items(wv, FMod{p}, (long)DEPTH * NMOD * D6); }
    { run_items(wv, FCopyX{p}, (long)R_ALL * D_MODEL); }
    { run_items(wv, FRope{p}, (long)GRID_W * (GLA_DK / 4)); }
#pragma unroll
    for (int l = 0; l < DEPTH; ++l) {
        const int ro = rows_out(l);
        { conv_wT(wv, p.w_in + (size_t)l * D_MODEL * D_IN, p.WT_IN, D_MODEL, D_IN, ZLD, (float*)smem); }
        { for (int br = 0; br < 3; ++br) conv_wT(wv, p.w_branch + ((size_t)l * 3 + br) * BW * D_MODEL, p.WT_BR + (size_t)br * D_MODEL * BW, BW, D_MODEL, D_MODEL, (float*)smem); }
        { conv_wT(wv, p.w_out + (size_t)l * D_MODEL * D_MODEL, p.WT_OUT, D_MODEL, D_MODEL, D_MODEL, (float*)smem); }
        { run_items(wv, FRwWt{p, l}, (long)5 * RW_W * (RW_LOW / 8)); }
        GRID_SYNC();
        { norm_rows(wv, p, l, 0, R_ALL, l > 0); }
        GRID_SYNC();
        { gemm_call(wv, lds, p.H, p.WT_IN, R_ALL, ZLD, D_MODEL, EpiZ{p.Z}); }
        GRID_SYNC();
        { prep_rows(wv, p, l, lds); }
        { run_items(wv, FVt{p, p.VTN, ZO_NAV, NA_HEADS, NA_HD}, (long)BATCH * NA_HEADS * NA_HD * (T_ALL / 8)); }
        { run_items(wv, FVt{p, p.VTG, ZO_GV, GLA_HEADS, GLA_DV}, (long)BATCH * GLA_V * (T_ALL / 8)); }
        GRID_SYNC();
        { run_items(wv, FGlaChunk{p}, (long)2 * BATCH * GLA_NCH * GLA_QK); }
        { gemm_call(wv, lds, p.LOW, p.WT_RW, R_ALL, 5 * RW_W, RW_LOW, EpiRw{p.DEC, p.KD, p.BB, p.G, p.KS, p.KK, p.rw_w0 + (size_t)l * 2 * RW_W, p.rw_a0 + (size_t)l * 2 * RW_W, p.rw_k_a + (size_t)l * RW_W}); }
        GRID_SYNC();
        { for (int ch = opaque_block(); ch < BATCH * RW_HEADS * 2; ch += opaque_grid()) rw_scan_chain(wv, p, ch, lds); }
        { gla_phase(wv, p, 128); }
        { na_phase(wv, p, l, lds, 160, opaque_grid() - 160); }
        GRID_SYNC();
        { finish_rows(wv, p, l, ro); }
        GRID_SYNC();
        { gemm_call(wv, lds, p.Y3, p.WT_BR, ro, D_MODEL, BW, EpiBranch<0>{p.Z, p.MF, p.MB}); }
        GRID_SYNC();
        { gemm_call(wv, lds, p.Y3 + (size_t)R_ALL * BW, p.WT_BR + (size_t)D_MODEL * BW, ro, D_MODEL, BW, EpiBranch<1>{p.Z, p.MF, p.MB}); }
        GRID_SYNC();
        { gemm_call(wv, lds, p.Y3 + (size_t)2 * R_ALL * BW, p.WT_BR + (size_t)2 * D_MODEL * BW, ro, D_MODEL, BW, EpiBranch<2>{p.Z, p.MF, p.MB}); }
        GRID_SYNC();
        { gemm_call(wv, lds, p.MB, p.WT_OUT, ro, D_MODEL, D_MODEL, EpiOut{p.X, p.MOD + (size_t)l * NMOD * D6}); }
        GRID_SYNC();
        { norm_rows(wv, p, l, 1, ro, false); }
        { conv_moe(wv, p, l, (float*)smem); }
        GRID_SYNC();
        { moe_gather(wv, p, l, ro, (int*)smem); }
        GRID_SYNC();
        { moe_gemm_call(wv, lds, p, p.HS, p.WGU, 4, D_MODEL, EpiMoeUp{p.ACTB, p.ROWW}); }
        GRID_SYNC();
        { moe_gemm_call(wv, lds, p, p.ACTB, p.WD, 8, D_EXPERT, EpiMoeDown{p.YK, p.ROWTOK}); }
        GRID_SYNC();
    }
    { final_out(wv, p); }
#undef GRID_SYNC
}

extern "C" void kernel_launch(void* const* d_in, const int* in_sizes, int n_in, void* d_out, int out_size, void* d_ws, size_t ws_size, hipStream_t stream) {
    static int grid = 0;
    Ptrs p{};
    fill_inputs(p, d_in);
    p.out = (float*)d_out;
    const size_t need = ws_carve(p, (char*)d_ws);
    if (grid == 0) {
        if (need > ws_size || n_in != 33) { fprintf(stderr, "kernel_launch: workspace %zu < %zu or n_in %d != 33; nothing launched\n", ws_size, need, n_in); grid = -1; return; }
        int dev = 0, cus = 0, per_cu = 0;
        if (hipGetDevice(&dev) != hipSuccess || hipDeviceGetAttribute(&cus, hipDeviceAttributeMultiprocessorCount, dev) != hipSuccess) { grid = -1; return; }
        if (hipFuncSetAttribute((const void*)mega_fwd, hipFuncAttributeMaxDynamicSharedMemorySize, LDS_BYTES) != hipSuccess) { fprintf(stderr, "kernel_launch: hipFuncSetAttribute failed\n"); grid = -1; return; }
        if (hipOccupancyMaxActiveBlocksPerMultiprocessor(&per_cu, (const void*)mega_fwd, MEGA_THREADS, LDS_BYTES) != hipSuccess || per_cu < 1) { fprintf(stderr, "kernel_launch: occupancy query says %d blocks per CU; nothing launched\n", per_cu); (void)hipGetLastError(); grid = -1; return; }
        grid = cus;
    }
    if (grid < 0) return;
    (void)hipMemsetAsync(p.BAR, 0, 16384, stream);
    hipLaunchKernelGGL(mega_fwd, dim3(grid), dim3(MEGA_THREADS), LDS_BYTES, stream, p);
}
#endif
```

```cpp
#ifndef CPU_TEST
#include <hip/hip_runtime.h>
#define HD __host__ __device__ __forceinline__
#else
#define HD inline
#endif
#include <cmath>
#include <cstdint>
#include <cstddef>
#include <cstdio>

#ifndef PROBE_SET
#define PROBE_SET 0
#endif
#ifdef CFG_SMALL
constexpr int D_MODEL = 48, BATCH = 2, GRID_W = 32, SEQ = 384, DEPTH = 2, CTX_LEN = 64;
constexpr int NA_HEADS = 2, NA_HD = 16;
constexpr int GLA_HEADS = 2, GLA_DK = 8, GLA_DV = 16, GLA_RANK = 4;
constexpr int RW_HEADS = 2, RW_HEAD = 16, RW_DR = 6, RW_AR = 6, RW_GR = 8;
constexpr int D_EXPERT = 12;
#else
constexpr int D_MODEL = 2048, BATCH = 4, GRID_W = 64, SEQ = 2048, DEPTH = 2, CTX_LEN = 256;
constexpr int NA_HEADS = 16, NA_HD = 64;
constexpr int GLA_HEADS = 4, GLA_DK = 128, GLA_DV = 256, GLA_RANK = 16;
constexpr int RW_HEADS = 16, RW_HEAD = 64, RW_DR = 96, RW_AR = 96, RW_GR = 256;
constexpr int D_EXPERT = 512;
#endif
constexpr int NA_WIN_R_MAX = 8, NA_WIN_C = 16;
constexpr int NA_W = NA_HEADS * NA_HD;
constexpr int GLA_QK = GLA_HEADS * GLA_DK, GLA_V = GLA_HEADS * GLA_DV;
constexpr float GLA_TAU = 16.0f;
constexpr int RW_W = RW_HEADS * RW_HEAD;
constexpr int RW_IN = 3 * RW_W + 2 * RW_DR + 2 * RW_AR + RW_GR;
constexpr int RW_LOW = 2 * RW_DR + 2 * RW_AR + RW_GR;
constexpr float RW_GN_EPS = 64e-5f;
constexpr int BW = NA_W;
static_assert(GLA_V == BW && RW_W == BW, "branch widths");
constexpr int N_EXPERTS = 16, N_GROUPS = 4, EPG = 4;
constexpr float EPS = 1e-6f;
constexpr int D6 = 6 * D_MODEL;
constexpr int ZO_NAQ = 0, ZO_NAK = NA_W, ZO_NAV = 2 * NA_W;
constexpr int ZO_GQ = 3 * NA_W, ZO_GK = ZO_GQ + GLA_QK, ZO_GV = ZO_GK + GLA_QK, ZO_GR = ZO_GV + GLA_V, ZO_GGD = ZO_GR + GLA_V;
constexpr int ZO_RW = ZO_GGD + 2 * GLA_RANK, ZO_GATE = ZO_RW + RW_IN, D_IN = ZO_GATE + 3 * D_MODEL;
constexpr int RO_R = 0, RO_K = RW_W, RO_V = 2 * RW_W, RO_WD = 3 * RW_W, RO_AD = RO_WD + 2 * RW_DR, RO_GD = RO_AD + 2 * RW_AR;
#ifdef CFG_SMALL
constexpr int ZLD = D_IN;
#else
constexpr int ZLD = 16128;
static_assert(D_IN == 16032, "D_IN");
#endif
constexpr int R_LAT = BATCH * SEQ, R_CTX = BATCH * CTX_LEN, R_ALL = R_LAT + R_CTX;
constexpr int NMOD = BATCH + 1;
constexpr int MOE_TILES = (R_ALL * 2 + N_EXPERTS * 255) / 256 + 1, MOE_ROWS = MOE_TILES * 256;
constexpr int CNT_WORD0 = 3456;
constexpr int BAR_BYTES = 65536;
constexpr int CH_WORD0 = 4096;
constexpr int NA_CTR_WORD0 = 3968;

typedef unsigned short bf16_t;
HD float bf2f(bf16_t b) { union { unsigned u; float f; } v; v.u = ((unsigned)b) << 16; return v.f; }
HD bf16_t f2bf(float f) { union { unsigned u; float f; } v; v.f = f; unsigned u = v.u; if ((u & 0x7fffffffu) > 0x7f800000u) return (bf16_t)0x7fc0; u += 0x7FFFu + ((u >> 16) & 1u); return (bf16_t)(u >> 16); }
HD float ldf(const float* p, size_t i) { return p[i]; }
HD float ldf(const bf16_t* p, size_t i) { return bf2f(p[i]); }
HD void stf(float* p, size_t i, float v) { p[i] = v; }
HD void stf(bf16_t* p, size_t i, float v) { p[i] = f2bf(v); }

#ifdef CPU_TEST
typedef float ZT; typedef float AT; typedef float RT;
#else
typedef bf16_t ZT; typedef bf16_t AT; typedef bf16_t RT;
#endif

#if defined(__HIP_DEVICE_COMPILE__)
#define EXPF_(x) __expf(x)
#define LOGF_(x) __logf(x)
#else
#define EXPF_(x) expf(x)
#define LOGF_(x) logf(x)
#endif
HD float sigmoidf_(float x) { return 1.0f / (1.0f + EXPF_(-x)); }
HD float siluf_(float x) { return x / (1.0f + EXPF_(-x)); }
HD float softplusf_(float x) { return (x > 0.f ? x : 0.f) + LOGF_(1.0f + EXPF_(-fabsf(x))); }

struct Ptrs {
    const float *x, *c, *ctx, *c_ctx, *ada_w, *ada_b, *norm1_g, *norm2_g, *w_in, *na_q_norm, *na_k_norm, *na_rpb, *gla_gate_w2, *gla_gate_b, *gla_norm_g,
        *rw_mu, *rw_w0, *rw_w2, *rw_a0, *rw_a2, *rw_g2, *rw_k_k, *rw_k_a, *rw_r_k, *rw_gn_g, *rw_gn_b, *w_branch, *w_out, *router_w, *router_bias,
        *moe_w_gate, *moe_w_up, *moe_w_down;
    float* out;
    float* MOD;
    float* X;
    float* RSTD;
    AT* H;
    ZT* Z;
    AT* Y3;
    RT *GQ, *GK, *GY; float* GA;
    bf16_t *QH, *KP, *KPT, *VTG; float* DL;
    bf16_t *QN, *KN, *VTN;
    float* DEC;
    RT *G, *LOW, *KK, *RS, *VS, *KS, *KD, *BB, *RY;
    bf16_t* WT_RW;
    float* ROPE;
    float* MF;
    int* SELI;
    float* SELW;
    float* ACT;
    bf16_t *WT_IN, *WT_BR, *WT_OUT;
    bf16_t* MB;
    unsigned* BAR;
    bf16_t *WGU, *WD;
    bf16_t *HS, *ACTB;
    bf16_t* YK;
    int *POS, *ROWTOK, *TILE_E;
    float* ROWW;
};

HD int row_bt(int r) { return r < R_LAT ? r / SEQ : BATCH; }
HD int rows_out(int l) { return l < DEPTH - 1 ? R_ALL : R_LAT; }
HD bool row_first(int r) { return r < R_LAT ? (r % SEQ == 0) : ((r - R_LAT) % CTX_LEN == 0); }
HD bool row_last(int r) { return r < R_LAT ? (r % SEQ == SEQ - 1) : ((r - R_LAT) % CTX_LEN == CTX_LEN - 1); }
HD const float* modp(const Ptrs& p, int l, int bt, int k) { return p.MOD + (((size_t)l * NMOD + bt) * 6 + k) * D_MODEL; }
HD int scan_row(int b, int d, int st) {
    if (st < CTX_LEN) return R_LAT + b * CTX_LEN + (d ? CTX_LEN - 1 - st : st);
    const int t = st - CTX_LEN; return b * SEQ + (d ? SEQ - 1 - t : t);
}

struct FMod { Ptrs p;
    HD void operator()(long i) const {
        const int j = (int)(i % D6); const int bt = (int)((i / D6) % NMOD); const int l = (int)(i / ((long)D6 * NMOD));
        const float* cv = bt < BATCH ? p.c + (size_t)bt * D_MODEL : p.c_ctx;
        const float* w = p.ada_w + (size_t)l * D_MODEL * D6 + j;
        float acc = p.ada_b[(size_t)l * D6 + j];
        for (int k = 0; k < D_MODEL; ++k) acc += siluf_(cv[k]) * w[(size_t)k * D6];
        p.MOD[((size_t)l * NMOD + bt) * D6 + j] = acc;
    } };
struct FCopyX { Ptrs p;
    HD void operator()(long i) const { const size_t n = (size_t)R_LAT * D_MODEL; p.X[i] = (size_t)i < n ? p.x[i] : p.ctx[i - n]; } };
struct FRstd { Ptrs p;
    HD void operator()(long r) const { const float* xr = p.X + (size_t)r * D_MODEL; float s = 0.f; for (int d = 0; d < D_MODEL; ++d) s += xr[d] * xr[d]; p.RSTD[r] = 1.0f / sqrtf(s / D_MODEL + EPS); } };
struct FNormMod { Ptrs p; int l, which;
    HD void operator()(long i) const {
        const int r = (int)(i / D_MODEL), d = (int)(i % D_MODEL); const int bt = row_bt(r);
        const float g = (which ? p.norm2_g : p.norm1_g)[(size_t)l * D_MODEL + d];
        const float sh = modp(p, l, bt, which ? 3 : 0)[d], sc = modp(p, l, bt, which ? 4 : 1)[d];
        stf(p.H, (size_t)i, p.X[i] * p.RSTD[r] * g * (1.0f + sc) + sh);
    } };

struct FNaAttn { Ptrs p; int l; int pad_;
    HD void operator()(long i) const {
        const int r = (int)(i / NA_HEADS), h = (int)(i % NA_HEADS);
        const ZT* zr = p.Z + (size_t)r * ZLD;
        float q[NA_HD], acc[NA_HD];
        float ssq = 0.f;
#pragma unroll
        for (int d = 0; d < NA_HD; ++d) { q[d] = ldf(zr, ZO_NAQ + h * NA_HD + d); ssq += q[d] * q[d]; }
        const float rq = 1.0f / sqrtf(ssq / NA_HD + EPS) * (1.0f / sqrtf((float)NA_HD));
#pragma unroll
        for (int d = 0; d < NA_HD; ++d) { q[d] = q[d] * rq * p.na_q_norm[l * NA_HD + d] * p.na_k_norm[l * NA_HD + d]; acc[d] = 0.f; }
        float m = -INFINITY, ls = 0.f;
        auto key = [&](int kr, float bias) {
            const ZT* zk = p.Z + (size_t)kr * ZLD;
            float dot = 0.f, ks = 0.f;
#pragma unroll
            for (int d = 0; d < NA_HD; ++d) { const float kv = ldf(zk, ZO_NAK + h * NA_HD + d); dot += q[d] * kv; ks += kv * kv; }
            const float s = dot / sqrtf(ks / NA_HD + EPS) + bias;
            const float mn = s > m ? s : m; const float corr = expf(m - mn), pe = expf(s - mn);
            ls = ls * corr + pe;
#pragma unroll
            for (int d = 0; d < NA_HD; ++d) acc[d] = acc[d] * corr + pe * ldf(zk, ZO_NAV + h * NA_HD + d);
            m = mn;
        };
        int b;
        if (r < R_LAT) {
            b = r / SEQ; const int t = r % SEQ, gr = t / GRID_W, gc = t % GRID_W;
            constexpr int n_rows = SEQ / GRID_W; constexpr int win_r = NA_WIN_R_MAX < n_rows ? NA_WIN_R_MAX : n_rows;
            int rs = gr - win_r / 2; rs = rs < 0 ? 0 : (rs > n_rows - win_r ? n_rows - win_r : rs);
            int cs = gc - NA_WIN_C / 2; cs = cs < 0 ? 0 : (cs > GRID_W - NA_WIN_C ? GRID_W - NA_WIN_C : cs);
            const float* rp = p.na_rpb + ((size_t)l * NA_HEADS + h) * (2 * NA_WIN_R_MAX - 1) * (2 * NA_WIN_C - 1);
            for (int n = 0; n < win_r; ++n)
                for (int j = 0; j < NA_WIN_C; ++j)
                    key(b * SEQ + (rs + n) * GRID_W + cs + j, rp[(rs + n - gr + NA_WIN_R_MAX - 1) * (2 * NA_WIN_C - 1) + (cs + j - gc + NA_WIN_C - 1)]);
        } else b = (r - R_LAT) / CTX_LEN;
        for (int c = 0; c < CTX_LEN; ++c) key(R_LAT + b * CTX_LEN + c, 0.f);
        const float inv = 1.0f / ls;
#pragma unroll
        for (int d = 0; d < NA_HD; ++d) stf(p.Y3, (size_t)r * BW + h * NA_HD + d, acc[d] * inv);
    } };

struct FGlaPrep { Ptrs p; int l; int pad_;
    HD void operator()(long i) const {
        const int r = (int)(i / GLA_QK), j = (int)(i % GLA_QK), ii = j % GLA_DK, hb = j - ii;
        const ZT* zr = p.Z + (size_t)r * ZLD;
        const float qs = 1.0f / sqrtf((float)GLA_DK);
        float qv = ldf(zr, ZO_GQ + j) * qs, kv = ldf(zr, ZO_GK + j);
        if (r < R_LAT) {
            constexpr int half = GLA_DK / 2, hh2 = half / 2;
            const int t = r % SEQ; const int sect = ii / half, i2 = ii % half, f = i2 % hh2;
            const float pos = (float)(sect == 0 ? t / GRID_W : t % GRID_W);
            const float ang = pos * powf(10000.0f, -(float)(2 * f) / (float)half);
            const float cs = cosf(ang), sn = sinf(ang);
            const int pj = hb + sect * half + (i2 < hh2 ? i2 + hh2 : i2 - hh2);
            const float qp = ldf(zr, ZO_GQ + pj) * qs, kp = ldf(zr, ZO_GK + pj);
            if (i2 < hh2) { qv = qv * cs - qp * sn; kv = kv * cs - kp * sn; } else { qv = qp * sn + qv * cs; kv = kp * sn + kv * cs; }
        }
        stf(p.GQ, (size_t)i, qv); stf(p.GK, (size_t)i, kv);
        for (int d = 0; d < 2; ++d) {
            float pre = p.gla_gate_b[((size_t)l * 2 + d) * GLA_QK + j];
            for (int k = 0; k < GLA_RANK; ++k) pre += ldf(zr, ZO_GGD + d * GLA_RANK + k) * p.gla_gate_w2[(((size_t)l * 2 + d) * GLA_RANK + k) * GLA_QK + j];
            p.GA[(size_t)d * R_ALL * GLA_QK + i] = expf(-softplusf_(-pre) / GLA_TAU);
        }
    } };
struct FGlaScan { Ptrs p; int l; int pad_;
    HD void operator()(long i) const {
        const int vc = (int)(i % GLA_DV); const int ch = (int)(i / GLA_DV); const int d = ch % 2, hh = (ch / 2) % GLA_HEADS, b = ch / (2 * GLA_HEADS);
        float s[GLA_DK];
#pragma unroll
        for (int k = 0; k < GLA_DK; ++k) s[k] = 0.f;
        const float* ga = p.GA + (size_t)d * R_ALL * GLA_QK;
        RT* gy = p.GY + (size_t)d * R_ALL * GLA_V;
        for (int st = 0; st < CTX_LEN + SEQ; ++st) {
            const int r = scan_row(b, d, st);
            const size_t o = (size_t)r * GLA_QK + hh * GLA_DK;
            const float v = ldf(p.Z, (size_t)r * ZLD + ZO_GV + hh * GLA_DV + vc);
            float y = 0.f;
#pragma unroll
            for (int k = 0; k < GLA_DK; ++k) { s[k] = ga[o + k] * s[k] + ldf(p.GK, o + k) * v; y += ldf(p.GQ, o + k) * s[k]; }
            stf(gy, (size_t)r * GLA_V + hh * GLA_DV + vc, y);
        }
    } };
struct FGlaFinish { Ptrs p; int l; int pad_;
    HD void operator()(long i) const {
        const int r = (int)(i / GLA_HEADS), hh = (int)(i % GLA_HEADS);
        const size_t o = (size_t)r * GLA_V + hh * GLA_DV; const RT* y0 = p.GY + o; const RT* y1 = p.GY + (size_t)R_ALL * GLA_V + o;
        float ss = 0.f; for (int v = 0; v < GLA_DV; ++v) { const float y = ldf(y0, v) + ldf(y1, v); ss += y * y; }
        const float rn = 1.0f / sqrtf(ss / GLA_DV + EPS);
        for (int v = 0; v < GLA_DV; ++v) {
            const float y = (ldf(y0, v) + ldf(y1, v)) * rn * p.gla_norm_g[(size_t)l * GLA_DV + v];
            stf(p.Y3, (size_t)R_ALL * BW + o + v, y * siluf_(ldf(p.Z, (size_t)r * ZLD + ZO_GR + hh * GLA_DV + v)));
        }
    } };

HD float rwz(const Ptrs& p, int l, int r, int col) {
    const size_t o = (size_t)r * ZLD + ZO_RW + col;
    const float z0 = ldf(p.Z, o), zp = row_first(r) ? 0.f : ldf(p.Z, o - ZLD), zn = row_last(r) ? 0.f : ldf(p.Z, o + ZLD);
    return z0 + p.rw_mu[(size_t)l * RW_IN + col] * (0.5f * (zp + zn) - z0);
}
struct FRwLow { Ptrs p; int l; int pad_;
    HD void operator()(long i) const {
        const int r = (int)(i / RW_LOW), q = (int)(i % RW_LOW);
        const float z = rwz(p, l, r, RO_WD + q);
        stf(p.LOW, (size_t)i, q < 2 * RW_DR ? tanhf(z) : (q < 2 * RW_DR + 2 * RW_AR ? z : sigmoidf_(z)));
    } };
struct FRwHead { Ptrs p; int l; int pad_;
    HD void operator()(long i) const {
        const int r = (int)(i / RW_HEADS), h = (int)(i % RW_HEADS);
        float ss = 0.f;
        for (int j = 0; j < RW_HEAD; ++j) { const float k = rwz(p, l, r, RO_K + h * RW_HEAD + j) * p.rw_k_k[(size_t)l * RW_W + h * RW_HEAD + j]; ss += k * k; }
        const float rn = 1.0f / sqrtf(ss + EPS);
        for (int j = 0; j < RW_HEAD; ++j) { const int c = h * RW_HEAD + j;
            stf(p.KK, (size_t)r * RW_W + c, rwz(p, l, r, RO_K + c) * p.rw_k_k[(size_t)l * RW_W + c] * rn);
            stf(p.RS, (size_t)r * RW_W + c, rwz(p, l, r, RO_R + c));
            stf(p.VS, (size_t)r * RW_W + c, rwz(p, l, r, RO_V + c)); }
    } };
struct FRwG { Ptrs p; int l; int pad_;
    HD void operator()(long i) const {
        const int r = (int)(i / RW_W), j = (int)(i % RW_W);
        const RT* lo = p.LOW + (size_t)r * RW_LOW + 2 * RW_DR + 2 * RW_AR; float acc = 0.f;
        for (int q = 0; q < RW_GR; ++q) acc += ldf(lo, q) * p.rw_g2[((size_t)l * RW_GR + q) * RW_W + j];
        stf(p.G, (size_t)i, acc);
    } };
struct FRwDir { Ptrs p; int l, d;
    HD void operator()(long i) const {
        const int r = (int)(i / RW_W), j = (int)(i % RW_W);
        const RT* lo = p.LOW + (size_t)r * RW_LOW;
        float wpre = p.rw_w0[((size_t)l * 2 + d) * RW_W + j];
        for (int q = 0; q < RW_DR; ++q) wpre += ldf(lo, d * RW_DR + q) * p.rw_w2[(((size_t)l * 2 + d) * RW_DR + q) * RW_W + j];
        const float w_log = -softplusf_(-wpre) - 0.5f;
        float apre = p.rw_a0[((size_t)l * 2 + d) * RW_W + j];
        for (int q = 0; q < RW_AR; ++q) apre += ldf(lo, 2 * RW_DR + d * RW_AR + q) * p.rw_a2[(((size_t)l * 2 + d) * RW_AR + q) * RW_W + j];
        const float a = sigmoidf_(apre);
        const float kraw = rwz(p, l, r, RO_K + j);
        const size_t o = (size_t)d * R_ALL * RW_W + i;
        p.DEC[o] = EXPF_(-EXPF_(w_log));
        stf(p.KD, o, kraw * (1.0f + (a - 1.0f) * p.rw_k_a[(size_t)l * RW_W + j]));
        stf(p.BB, o, ldf(p.KK, (size_t)i) * a);
    } };
struct FRwScan { Ptrs p; int l, d;
    HD void operator()(long i) const {
        const int vi = (int)(i % RW_HEAD); const int bh = (int)(i / RW_HEAD); const int h = bh % RW_HEADS, b = bh / RW_HEADS;
        float s[RW_HEAD];
#pragma unroll
        for (int j = 0; j < RW_HEAD; ++j) s[j] = 0.f;
        const size_t od = (size_t)d * R_ALL * RW_W;
        for (int st = 0; st < CTX_LEN + SEQ; ++st) {
            const int r = scan_row(b, d, st);
            const size_t o = (size_t)r * RW_W + h * RW_HEAD;
            const float v = ldf(p.VS, o + vi);
            float sa = 0.f;
#pragma unroll
            for (int j = 0; j < RW_HEAD; ++j) sa += s[j] * ldf(p.KK, o + j);
            float y = 0.f;
#pragma unroll
            for (int j = 0; j < RW_HEAD; ++j) { s[j] = s[j] * p.DEC[od + o + j] - sa * ldf(p.BB, od + o + j) + v * ldf(p.KD, od + o + j); y += s[j] * ldf(p.RS, o + j); }
            stf(p.RY, od + o + vi, y);
        }
    } };
struct FRwFinish { Ptrs p; int l; int pad_;
    HD void operator()(long i) const {
        const int r = (int)(i / RW_HEADS), h = (int)(i % RW_HEADS);
        const size_t o = (size_t)r * RW_W + h * RW_HEAD; const RT* y0 = p.RY + o; const RT* y1 = p.RY + (size_t)R_ALL * RW_W + o;
        float mean = 0.f; for (int j = 0; j < RW_HEAD; ++j) mean += ldf(y0, j) + ldf(y1, j);
        mean /= RW_HEAD;
        float var = 0.f, bonus = 0.f;
        for (int j = 0; j < RW_HEAD; ++j) { const float dv = ldf(y0, j) + ldf(y1, j) - mean; var += dv * dv;
            bonus += ldf(p.RS, o + j) * rwz(p, l, r, RO_K + h * RW_HEAD + j) * p.rw_r_k[((size_t)l * RW_HEADS + h) * RW_HEAD + j]; }
        const float rn = 1.0f / sqrtf(var / RW_HEAD + RW_GN_EPS);
        for (int j = 0; j < RW_HEAD; ++j) { const int c = h * RW_HEAD + j;
            float y = (ldf(y0, j) + ldf(y1, j) - mean) * rn * p.rw_gn_g[(size_t)l * RW_W + c] + p.rw_gn_b[(size_t)l * RW_W + c];
            y += bonus * ldf(p.VS, (size_t)r * RW_W + c);
            stf(p.Y3, (size_t)2 * R_ALL * BW + (size_t)r * BW + c, y * ldf(p.G, (size_t)r * RW_W + c)); }
    } };

HD void route_select(const float (&lg)[N_EXPERTS], const float* router_bias, int& i1, int& i2, float& s1, float& s2) {
        float s[N_EXPERTS], bz[N_EXPERTS];
#pragma unroll
        for (int e = 0; e < N_EXPERTS; ++e) { s[e] = sigmoidf_(lg[e]); bz[e] = s[e] + router_bias[e]; }
        int gsel = 0; float gbest = -INFINITY;
#pragma unroll
        for (int gi = 0; gi < N_GROUPS; ++gi) {
            float m1 = -INFINITY, m2 = -INFINITY;
#pragma unroll
            for (int k = 0; k < EPG; ++k) { const float v = bz[gi * EPG + k]; if (v > m1) { m2 = m1; m1 = v; } else if (v > m2) m2 = v; }
            const float sc2 = m1 + m2; if (sc2 > gbest) { gbest = sc2; gsel = gi; }
        }
        int a1 = 0, a2 = 0; float t1 = 0.f, t2 = 0.f, v1 = -INFINITY, v2 = -INFINITY;
#pragma unroll
        for (int e = 0; e < N_EXPERTS; ++e) { const float v = (e / EPG == gsel) ? bz[e] : -INFINITY; const bool g1 = v > v1, g2 = v > v2;
            v2 = g1 ? v1 : (g2 ? v : v2); a2 = g1 ? a1 : (g2 ? e : a2); t2 = g1 ? t1 : (g2 ? s[e] : t2);
            v1 = g1 ? v : v1; a1 = g1 ? e : a1; t1 = g1 ? s[e] : t1; }
        i1 = a1; i2 = a2; s1 = t1; s2 = t2;
}
struct FRouter { Ptrs p; int l; int pad_;
    HD void operator()(long r) const {
        const int bt = row_bt((int)r); const float* xr = p.X + (size_t)r * D_MODEL; const float rstd = p.RSTD[r];
        const float* sh = modp(p, l, bt, 3); const float* sc = modp(p, l, bt, 4); const float* g = p.norm2_g + (size_t)l * D_MODEL;
        float lg[N_EXPERTS];
#pragma unroll
        for (int e = 0; e < N_EXPERTS; ++e) lg[e] = 0.f;
        for (int d = 0; d < D_MODEL; ++d) { const float h = xr[d] * rstd * g[d] * (1.0f + sc[d]) + sh[d]; const float* w = p.router_w + (size_t)d * N_EXPERTS;
#pragma unroll
            for (int e = 0; e < N_EXPERTS; ++e) lg[e] += h * w[e]; }
        int i1, i2; float s1, s2; route_select(lg, p.router_bias, i1, i2, s1, s2);
        const float inv = 1.0f / (s1 + s2);
        p.SELI[2 * r] = i1; p.SELI[2 * r + 1] = i2; p.SELW[2 * r] = s1 * inv; p.SELW[2 * r + 1] = s2 * inv;
    } };
struct FMoeUp { Ptrs p; int l; int pad_;
    HD void operator()(long i) const {
        const int j = (int)(i % D_EXPERT), k = (int)((i / D_EXPERT) % 2), r = (int)(i / (2 * D_EXPERT));
        const int e = p.SELI[2 * r + k];
        const size_t wo = ((size_t)l * N_EXPERTS + e) * D_MODEL * D_EXPERT + j;
        const float* wg = p.moe_w_gate + wo; const float* wu = p.moe_w_up + wo; const AT* h = p.H + (size_t)r * D_MODEL;
        float g = 0.f, u = 0.f;
        for (int d = 0; d < D_MODEL; ++d) { const float hv = ldf(h, d); g += hv * wg[(size_t)d * D_EXPERT]; u += hv * wu[(size_t)d * D_EXPERT]; }
        p.ACT[i] = siluf_(g) * u * p.SELW[2 * r + k];
    } };
struct FMoeDown { Ptrs p; int l; int pad_;
    HD void operator()(long i) const {
        const int r = (int)(i / D_MODEL), d = (int)(i % D_MODEL);
        float acc = 0.f;
        for (int k = 0; k < 2; ++k) { const int e = p.SELI[2 * r + k];
            const float* wd = p.moe_w_down + ((size_t)l * N_EXPERTS + e) * D_EXPERT * D_MODEL + d; const float* a = p.ACT + ((size_t)r * 2 + k) * D_EXPERT;
            for (int j = 0; j < D_EXPERT; ++j) acc += a[j] * wd[(size_t)j * D_MODEL]; }
        p.X[i] += modp(p, l, row_bt(r), 5)[d] * acc;
    } };
struct FOut { Ptrs p; HD void operator()(long i) const { p.out[i] = p.X[i]; } };

struct GIn { Ptrs p; int l; int M, N, K;
    HD float a(int m, int k) const { return ldf(p.H, (size_t)m * D_MODEL + k); }
    HD float b(int k, int n) const { return p.w_in[((size_t)l * D_MODEL + k) * D_IN + n]; }
    HD void epi(int m, int n, float acc) const { stf(p.Z, (size_t)m * ZLD + n, acc); } };
struct GBranch { Ptrs p; int l, br; int M, N, K; int pad_;
    HD float a(int m, int k) const { return ldf(p.Y3, ((size_t)br * R_ALL + m) * BW + k); }
    HD float b(int k, int n) const { return p.w_branch[(((size_t)l * 3 + br) * BW + k) * D_MODEL + n]; }
    HD void epi(int m, int n, float acc) const { const float g = sigmoidf_(ldf(p.Z, (size_t)m * ZLD + ZO_GATE + br * D_MODEL + n)); float* o = p.MF + (size_t)m * D_MODEL + n; *o = (br ? *o : 0.f) + g * acc; } };
struct GOut { Ptrs p; int l; int M, N, K;
    HD float a(int m, int k) const { return p.MF[(size_t)m * D_MODEL + k]; }
    HD float b(int k, int n) const { return p.w_out[((size_t)l * D_MODEL + k) * D_MODEL + n]; }
    HD void epi(int m, int n, float acc) const { p.X[(size_t)m * D_MODEL + n] += modp(p, l, row_bt(m), 2)[n] * acc; } };

static_assert(sizeof(FNaAttn) % 8 == 0 && sizeof(GBranch) % 8 == 0 && sizeof(FRwDir) % 8 == 0 && sizeof(GIn) % 8 == 0 && sizeof(FMod) % 8 == 0, "no tail padding in by-value kernel arguments");
struct WsMap { size_t total; };
inline size_t ws_carve(Ptrs& p, char* base) {
    size_t off = 0;
    auto take = [&](size_t bytes) { char* q = base ? base + off : nullptr; off += (bytes + 255) & ~(size_t)255; return q; };
    p.BAR = (unsigned*)take(BAR_BYTES);
    p.MOD = (float*)take((size_t)DEPTH * NMOD * D6 * 4);
    p.WT_IN = (bf16_t*)take((size_t)ZLD * D_MODEL * 2); p.WT_BR = (bf16_t*)take((size_t)3 * D_MODEL * BW * 2); p.WT_OUT = (bf16_t*)take((size_t)D_MODEL * D_MODEL * 2);
    p.WT_RW = (bf16_t*)take((size_t)5 * RW_W * RW_LOW * 2); p.ROPE = (float*)take((size_t)GRID_W * (GLA_DK / 4) * 2 * 4);
    p.X = (float*)take((size_t)R_ALL * D_MODEL * 4);
    p.RSTD = (float*)take((size_t)R_ALL * 4);
    p.H = (AT*)take((size_t)R_ALL * D_MODEL * sizeof(AT)); p.MB = (bf16_t*)p.H;
    p.Z = (ZT*)take((size_t)R_ALL * ZLD * sizeof(ZT));
    p.Y3 = (AT*)take((size_t)3 * R_ALL * BW * sizeof(AT));
    const size_t u0 = off;
    p.GQ = (RT*)take((size_t)R_ALL * GLA_QK * sizeof(RT)); p.GK = (RT*)take((size_t)R_ALL * GLA_QK * sizeof(RT)); p.GA = (float*)take((size_t)2 * R_ALL * GLA_QK * 4);
#ifdef CPU_TEST
    p.GY = (RT*)take((size_t)2 * R_ALL * GLA_V * sizeof(RT));
#else
    static_assert(2 * GLA_V * sizeof(RT) <= 2 * GLA_QK * 4, "GY fits over GA"); p.GY = (RT*)p.GA;
#endif
    p.QH = (bf16_t*)take((size_t)2 * R_ALL * GLA_QK * 2); p.KP = (bf16_t*)take((size_t)2 * R_ALL * GLA_QK * 2); p.KPT = (bf16_t*)take((size_t)2 * R_ALL * GLA_QK * 2);
    p.VTG = (bf16_t*)take((size_t)BATCH * GLA_V * (SEQ + CTX_LEN) * 2); p.DL = (float*)take((size_t)2 * (R_ALL / 64) * GLA_QK * 4);
    p.QN = (bf16_t*)take((size_t)R_ALL * NA_W * 2); p.KN = (bf16_t*)take((size_t)R_ALL * NA_W * 2); p.VTN = (bf16_t*)take((size_t)BATCH * NA_HEADS * NA_HD * (SEQ + CTX_LEN) * 2);
    p.LOW = (RT*)take((size_t)R_ALL * (RW_LOW > 768 ? RW_LOW : 768) * sizeof(RT));
    p.KK = (RT*)take((size_t)R_ALL * RW_W * sizeof(RT)); p.RS = (RT*)take((size_t)R_ALL * RW_W * sizeof(RT)); p.VS = (RT*)take((size_t)R_ALL * RW_W * sizeof(RT));
    p.G = (RT*)take((size_t)R_ALL * RW_W * sizeof(RT)); p.KS = (RT*)take((size_t)R_ALL * RW_W * sizeof(RT));
    p.DEC = (float*)take((size_t)2 * R_ALL * RW_W * 4); p.KD = (RT*)take((size_t)2 * R_ALL * RW_W * sizeof(RT)); p.BB = (RT*)take((size_t)2 * R_ALL * RW_W * sizeof(RT));
    p.RY = (RT*)take((size_t)2 * R_ALL * RW_W * sizeof(RT));
    const size_t u1 = off; off = u0;
    p.MF = (float*)take((size_t)R_ALL * D_MODEL * 4);
    p.SELI = (int*)take((size_t)R_ALL * 2 * 4); p.SELW = (float*)take((size_t)R_ALL * 2 * 4);
    p.ACT = (float*)take((size_t)R_ALL * 2 * D_EXPERT * 4);
    p.WGU = (bf16_t*)take((size_t)N_EXPERTS * 2 * D_EXPERT * D_MODEL * 2); p.WD = (bf16_t*)take((size_t)N_EXPERTS * D_MODEL * D_EXPERT * 2);
    p.HS = (bf16_t*)take((size_t)MOE_ROWS * D_MODEL * 2); p.ACTB = (bf16_t*)take((size_t)MOE_ROWS * D_EXPERT * 2);
    p.YK = (bf16_t*)take((size_t)2 * R_ALL * D_MODEL * 2);
    p.POS = (int*)take((size_t)R_ALL * 2 * 4); p.ROWTOK = (int*)take((size_t)MOE_ROWS * 4); p.TILE_E = (int*)take((size_t)(MOE_TILES + 1) * 4); p.ROWW = (float*)take((size_t)MOE_ROWS * 4);
    if (off < u1) off = u1;
    return off;
}

template <class Exec> void run_forward(Exec& ex, const Ptrs& p) {
    ex.items(FMod{p}, (long)DEPTH * NMOD * D6);
    ex.items(FCopyX{p}, (long)R_ALL * D_MODEL);
    for (int l = 0; l < DEPTH; ++l) {
        const int ro = rows_out(l);
        ex.items(FRstd{p}, R_ALL);
        ex.items(FNormMod{p, l, 0}, (long)R_ALL * D_MODEL);
        ex.gemm(GIn{p, l, R_ALL, D_IN, D_MODEL});
        ex.items(FNaAttn{p, l}, (long)ro * NA_HEADS);
        ex.items(FGlaPrep{p, l}, (long)R_ALL * GLA_QK);
        ex.items(FGlaScan{p, l}, (long)BATCH * GLA_HEADS * 2 * GLA_DV);
        ex.items(FGlaFinish{p, l}, (long)ro * GLA_HEADS);
        ex.items(FRwLow{p, l}, (long)R_ALL * RW_LOW);
        ex.items(FRwHead{p, l}, (long)R_ALL * RW_HEADS);
        ex.items(FRwG{p, l}, (long)R_ALL * RW_W);
        for (int d = 0; d < 2; ++d) ex.items(FRwDir{p, l, d}, (long)R_ALL * RW_W);
        for (int d = 0; d < 2; ++d) ex.items(FRwScan{p, l, d}, (long)BATCH * RW_HEADS * RW_HEAD);
        ex.items(FRwFinish{p, l}, (long)ro * RW_HEADS);
        ex.mark(l, 0);
        for (int br = 0; br < 3; ++br) ex.gemm(GBranch{p, l, br, ro, D_MODEL, BW});
        ex.gemm(GOut{p, l, ro, D_MODEL, D_MODEL});
        ex.mark(l, 1);
        ex.items(FRstd{p}, ro);
        ex.items(FRouter{p, l}, ro);
        ex.items(FNormMod{p, l, 1}, (long)ro * D_MODEL);
        ex.items(FMoeUp{p, l}, (long)ro * 2 * D_EXPERT);
        ex.items(FMoeDown{p, l}, (long)ro * D_MODEL);
        ex.mark(l, 2);
    }
    ex.items(FOut{p}, (long)R_LAT * D_MODEL);
}

inline void fill_inputs(Ptrs& p, void* const* d_in) {
    const float** f = (const float**)d_in;
    p.x = f[0]; p.c = f[1]; p.ctx = f[2]; p.c_ctx = f[3]; p.ada_w = f[4]; p.ada_b = f[5]; p.norm1_g = f[6]; p.norm2_g = f[7]; p.w_in = f[8];
    p.na_q_norm = f[9]; p.na_k_norm = f[10]; p.na_rpb = f[11]; p.gla_gate_w2 = f[12]; p.gla_gate_b = f[13]; p.gla_norm_g = f[14];
    p.rw_mu = f[15]; p.rw_w0 = f[16]; p.rw_w2 = f[17]; p.rw_a0 = f[18]; p.rw_a2 = f[19]; p.rw_g2 = f[20]; p.rw_k_k = f[21]; p.rw_k_a = f[22]; p.rw_r_k = f[23];
    p.rw_gn_g = f[24]; p.rw_gn_b = f[25]; p.w_branch = f[26]; p.w_out = f[27]; p.router_w = f[28]; p.router_bias = f[29];
    p.moe_w_gate = f[30]; p.moe_w_up = f[31]; p.moe_w_down = f[32];
}

#ifndef CPU_TEST
namespace pg8 {
#define PG8_LAS __attribute__((address_space(3)))
typedef unsigned short bf16_t;
typedef short bf16x8 __attribute__((ext_vector_type(8)));
typedef float f32x4 __attribute__((ext_vector_type(4)));
typedef unsigned u32x4 __attribute__((ext_vector_type(4)));
constexpr int BM = 256, BK = 64, HALF = 128, HTB = HALF * BK * 2  , STAGE_BYTES = 8 * HTB, NXCD = 8, WGM = 8;

__host__ __device__ __forceinline__ int lds_byte(int r, int c) { const int st = (r >> 4) * 2 + (c >> 5), rr = r & 15, cc = c & 31, ob = rr * 64 + cc * 2; return st * 1024 + (ob ^ (((ob >> 9) & 1) << 5)); }
__host__ __device__ __forceinline__ void stage_rc(int b, int& R, int& C) { const int st = b / 1024, sb = b % 1024, swz = sb ^ (((sb >> 9) & 1) << 5); R = (st >> 1) * 16 + swz / 64; C = (st & 1) * 32 + (swz % 64) / 2; }
__host__ __device__ __forceinline__ int perm32(int rho) { const int n = rho >> 4, i = rho & 15; return 8 * (i >> 2) + 4 * n + (i & 3); }

struct Unit { int pm, pn; };
struct Gemm { const bf16_t* A; const bf16_t* Bt; int M, N, K; };

struct StaticOrder {
    int nM, nN, nwg, G, c;
    __host__ __device__ void init(int M, int N, int G_, int c_) { nM = M / BM; nN = N / BM; nwg = nM * nN; G = G_; c = c_; }
    __host__ __device__ bool next(int i, Unit& u) const {
        const long L = (long)i * G + c; if (L >= nwg) return false;
        int wgid = (int)L; { const int q = nwg / NXCD, r = nwg % NXCD, xcd = wgid % NXCD, off = wgid / NXCD; wgid = (xcd < r ? xcd * (q + 1) : r * (q + 1) + (xcd - r) * q) + off; }
        const int nig = WGM * nN, gid = wgid / nig, fm = gid * WGM, gsz = (nM - fm) < WGM ? (nM - fm) : WGM;
        u.pm = fm + ((wgid % nig) % gsz); u.pn = (wgid % nig) / gsz; return true;
    }
    __device__ __forceinline__ void a_ready(const Unit&) const {}
    __device__ __forceinline__ void done(const Unit&) const {}
};

__device__ __forceinline__ unsigned cvt_pk_bf16(float lo, float hi) { unsigned r; asm volatile("v_cvt_pk_bf16_f32 %0, %1, %2" : "=v"(r) : "v"(lo), "v"(hi)); return r; }
template <class Epi, class Sched, bool ALIGN_EPI = false, bool SP2 = false, bool GATHER = false>
__device__ __forceinline__ void gemm_phase(PG8_LAS unsigned char* lds, const Gemm g, const Sched& S, const Epi& E, const int wv  , const int* arow = nullptr) {
    static_assert(!GATHER || SP2, "gathered A rows: SP2 loop only");
    int tid_; asm volatile("v_mbcnt_lo_u32_b32 %0, -1, 0\n\tv_mbcnt_hi_u32_b32 %0, -1, %0" : "=v"(tid_)); tid_ += wv * 64;
    const int tid = tid_, wid = __builtin_amdgcn_readfirstlane(tid >> 6), lane = tid & 63, wr = wid >> 2, wc = wid & 3, fr = lane & 15, fq = lane >> 4;
    const int K = g.K, nt = K / BK;
    unsigned voffA[2], voffB[2];
#pragma unroll
    for (int i = 0; i < 2; ++i) { int R, C; stage_rc(tid * 16 + i * 8192, R, C); const int Rb = Epi::PERM ? ((R & ~31) + perm32(R & 31)) : R;
        voffA[i] = (unsigned)(R * K + C) * 2u; voffB[i] = (unsigned)(Rb * K + C) * 2u; }
    unsigned gvA[2][2][2];
    if constexpr (GATHER) {
#pragma unroll
        for (int u = 0; u < 2; ++u) { Unit uu; const bool have = S.next(u, uu);
#pragma unroll
            for (int h = 0; h < 2; ++h)
#pragma unroll
                for (int i = 0; i < 2; ++i) { int R, C; stage_rc(tid * 16 + i * 8192, R, C);
                    int tok = have ? arow[uu.pm * 256 + h * HALF + R] : 0; tok = tok < 0 ? 0 : tok >> 1;
                    gvA[u][h][i] = (unsigned)(tok * K + C) * 2u; } }
    }
    const size_t kstep = (size_t)(BK * 2);
    const size_t hstep = (size_t)HALF * K * 2;
    const size_t tstep = 2 * hstep;
    const unsigned ldsw = (unsigned)wid * 1024u;
    const int aoff = lds_byte(wr * 64 + fr, fq * 8), boff = lds_byte(wc * 32 + fr, fq * 8);
#define PG8_SA(b, h) (((b) * 2 + (h)) * HTB)
#define PG8_SB(b, h) ((4 + (b) * 2 + (h)) * HTB)
#define PG8_STAGE(bufoff, gbase, voff) do { _Pragma("unroll") for (int _i = 0; _i < 2; ++_i) \
        __builtin_amdgcn_global_load_lds((const unsigned*)((const char*)(gbase) + (voff)[_i]), (PG8_LAS unsigned*)(lds + (bufoff) + ldsw + _i * 8192), 16, 0, 0); } while (0)
#define PG8_LDA(dst, b, h) do { _Pragma("unroll") for (int m = 0; m < 4; ++m) _Pragma("unroll") for (int k = 0; k < 2; ++k) dst[m][k] = *(const PG8_LAS bf16x8*)(lds + PG8_SA(b, h) + aoff + m * 2048 + k * 1024); } while (0)
#define PG8_LDB(dst, b, h) do { _Pragma("unroll") for (int n = 0; n < 2; ++n) _Pragma("unroll") for (int k = 0; k < 2; ++k) dst[n][k] = *(const PG8_LAS bf16x8*)(lds + PG8_SB(b, h) + boff + n * 2048 + k * 1024); } while (0)
#define PG8_MMA(ai, bj, At, Bt) do { __builtin_amdgcn_s_setprio(1); _Pragma("unroll") for (int m = 0; m < 4; ++m) _Pragma("unroll") for (int n = 0; n < 2; ++n) _Pragma("unroll") for (int k = 0; k < 2; ++k) \
        acc[ai][bj][m][n] = __builtin_amdgcn_mfma_f32_16x16x32_bf16(Bt[n][k], At[m][k], acc[ai][bj][m][n], 0, 0, 0); __builtin_amdgcn_s_setprio(0); } while (0)
#define PG8_WAIT_V(n) asm volatile("s_waitcnt vmcnt(" #n ")" ::: "memory")
#define PG8_WAIT_L(n) asm volatile("s_waitcnt lgkmcnt(" #n ")" ::: "memory")
#define PG8_BAR __builtin_amdgcn_s_barrier()
#define PG8_SCHED __builtin_amdgcn_sched_barrier(0)
    Unit cur, nxt; int ui = 0;
    if (!S.next(0, cur)) return;
    f32x4 acc[2][2][4][2];
#pragma unroll
    for (int a = 0; a < 2; ++a)
#pragma unroll
        for (int b = 0; b < 2; ++b)
#pragma unroll
            for (int m = 0; m < 4; ++m)
#pragma unroll
                for (int n = 0; n < 2; ++n) acc[a][b][m][n] = (f32x4){0.f, 0.f, 0.f, 0.f};
    bf16x8 At[4][2], B0[2][2], B1[2][2];
    const char* cA = (const char*)g.A + (GATHER ? (size_t)0 : (size_t)cur.pm * tstep); const char* cB = (const char*)g.Bt + (size_t)cur.pn * tstep;
    const size_t hstepA = GATHER ? (size_t)0 : hstep;
    unsigned gc[2][2], gn[2][2];
#pragma unroll
    for (int h = 0; h < 2; ++h)
#pragma unroll
        for (int i = 0; i < 2; ++i) { gc[h][i] = GATHER ? gvA[0][h][i] : voffA[i]; gn[h][i] = GATHER ? gvA[1][h][i] : voffA[i]; }
    S.a_ready(cur);
    if constexpr (SP2) {
        PG8_STAGE(PG8_SB(0, 0), cB, voffB); PG8_STAGE(PG8_SB(0, 1), cB + hstep, voffB); PG8_STAGE(PG8_SA(0, 0), cA, gc[0]); PG8_STAGE(PG8_SA(0, 1), cA + hstepA, gc[1]);
        if (wr == 1) PG8_BAR;
        PG8_WAIT_V(2); PG8_BAR;
        PG8_STAGE(PG8_SB(1, 0), cB + kstep, voffB); PG8_STAGE(PG8_SA(1, 0), cA + kstep, gc[0]); PG8_STAGE(PG8_SB(1, 1), cB + hstep + kstep, voffB);
        PG8_WAIT_V(6); PG8_BAR;
    } else {
        PG8_STAGE(PG8_SB(0, 0), cB, voffB); PG8_STAGE(PG8_SA(0, 0), cA, voffA); PG8_STAGE(PG8_SB(0, 1), cB + hstep, voffB); PG8_STAGE(PG8_SA(0, 1), cA + hstep, voffA);
        if (wr == 1) PG8_BAR;
        PG8_WAIT_V(4); PG8_BAR;
        PG8_STAGE(PG8_SB(1, 0), cB + kstep, voffB); PG8_STAGE(PG8_SA(1, 0), cA + kstep, voffA); PG8_STAGE(PG8_SB(1, 1), cB + hstep + kstep, voffB);
        PG8_WAIT_V(6); PG8_BAR;
    }
    for (;;) {
        const bool has_next = S.next(ui + 1, nxt);
        const char* nA = (has_next && !GATHER) ? (const char*)g.A + (size_t)nxt.pm * tstep : cA; const char* nB = has_next ? (const char*)g.Bt + (size_t)nxt.pn * tstep : cB;
        if constexpr (GATHER) { if (!has_next) {
#pragma unroll
            for (int h = 0; h < 2; ++h)
#pragma unroll
                for (int i = 0; i < 2; ++i) gn[h][i] = gc[h][i]; } }
        for (int t = 0; t < nt; t += 2) {
            const bool last = (t == nt - 2);
            const char* a1 = cA + (size_t)(t + 1) * kstep;
            const char* a2 = last ? nA : cA + (size_t)(t + 2) * kstep; const char* b2 = last ? nB : cB + (size_t)(t + 2) * kstep;
            const char* a3 = a2 + kstep; const char* b3 = b2 + kstep;
            if (last && has_next) S.a_ready(nxt);
            if constexpr (SP2) {
            unsigned g2[2][2];
#pragma unroll
            for (int h = 0; h < 2; ++h)
#pragma unroll
                for (int i = 0; i < 2; ++i) g2[h][i] = last ? gn[h][i] : gc[h][i];
            PG8_LDB(B0, 0, 0); PG8_LDB(B1, 0, 1); PG8_SCHED; PG8_LDA(At, 0, 0); PG8_STAGE(PG8_SA(1, 1), a1 + hstepA, gc[1]);
            PG8_WAIT_V(8); PG8_WAIT_L(0); PG8_BAR; PG8_MMA(0, 0, At, B0); PG8_MMA(0, 1, At, B1); PG8_BAR; PG8_SCHED;
            PG8_LDA(At, 0, 1); PG8_STAGE(PG8_SB(0, 0), b2, voffB); PG8_STAGE(PG8_SB(0, 1), b2 + hstep, voffB); PG8_STAGE(PG8_SA(0, 0), a2, g2[0]);
            PG8_WAIT_V(8); PG8_WAIT_L(0); PG8_BAR; PG8_MMA(1, 0, At, B0); PG8_MMA(1, 1, At, B1); PG8_BAR; PG8_SCHED;
            PG8_LDB(B0, 1, 0); PG8_LDB(B1, 1, 1); PG8_SCHED; PG8_LDA(At, 1, 0); PG8_STAGE(PG8_SA(0, 1), a2 + hstepA, g2[1]);
            PG8_WAIT_V(8); PG8_WAIT_L(0); PG8_BAR; PG8_MMA(0, 0, At, B0); PG8_MMA(0, 1, At, B1); PG8_BAR; PG8_SCHED;
            PG8_LDA(At, 1, 1); PG8_STAGE(PG8_SB(1, 0), b3, voffB); PG8_STAGE(PG8_SB(1, 1), b3 + hstep, voffB); PG8_STAGE(PG8_SA(1, 0), a3, g2[0]);
            PG8_WAIT_V(8); PG8_WAIT_L(0); PG8_BAR; PG8_MMA(1, 0, At, B0); PG8_MMA(1, 1, At, B1); PG8_BAR; PG8_SCHED;
            } else {
            PG8_LDB(B0, 0, 0); PG8_SCHED; PG8_LDA(At, 0, 0); PG8_STAGE(PG8_SA(1, 1), a1 + hstep, voffA);
            PG8_WAIT_L(8); PG8_BAR; PG8_WAIT_L(0); PG8_MMA(0, 0, At, B0); PG8_BAR; PG8_SCHED;
            PG8_LDB(B1, 0, 1); PG8_STAGE(PG8_SB(0, 0), b2, voffB);
            PG8_BAR; PG8_WAIT_L(0); PG8_MMA(0, 1, At, B1); PG8_BAR;
            PG8_LDA(At, 0, 1); PG8_STAGE(PG8_SA(0, 0), a2, voffA);
            PG8_BAR; PG8_WAIT_L(0); PG8_MMA(1, 0, At, B0); PG8_BAR; PG8_SCHED;
            PG8_STAGE(PG8_SB(0, 1), b2 + hstep, voffB);
            PG8_WAIT_V(6); PG8_BAR; PG8_MMA(1, 1, At, B1); PG8_BAR;
            PG8_LDB(B0, 1, 0); PG8_SCHED; PG8_LDA(At, 1, 0); PG8_STAGE(PG8_SA(0, 1), a2 + hstep, voffA);
            PG8_WAIT_L(8); PG8_BAR; PG8_WAIT_L(0); PG8_MMA(0, 0, At, B0); PG8_BAR; PG8_SCHED;
            PG8_LDB(B1, 1, 1); PG8_STAGE(PG8_SB(1, 0), b3, voffB);
            PG8_BAR; PG8_WAIT_L(0); PG8_MMA(0, 1, At, B1); PG8_BAR;
            PG8_LDA(At, 1, 1); PG8_STAGE(PG8_SA(1, 0), a3, voffA);
            PG8_BAR; PG8_WAIT_L(0); PG8_MMA(1, 0, At, B0); PG8_BAR; PG8_SCHED;
            PG8_STAGE(PG8_SB(1, 1), b3 + hstep, voffB);
            PG8_WAIT_V(6); PG8_BAR; PG8_MMA(1, 1, At, B1); PG8_BAR;
            }
        }
        if constexpr (ALIGN_EPI) { if (wr == 0) PG8_BAR; }
        if constexpr (Epi::CARRY) { E.carry(acc, cur, wr, wc, fr, fq); S.done(cur); }
        else if constexpr (!Epi::AFTER_DRAIN) { E(acc, cur, wr, wc, fr, fq); S.done(cur); }
        if (!has_next) break;
        if constexpr (!Epi::CARRY) {
#pragma unroll
        for (int a = 0; a < 2; ++a)
#pragma unroll
            for (int b = 0; b < 2; ++b)
#pragma unroll
                for (int m = 0; m < 4; ++m)
#pragma unroll
                    for (int n = 0; n < 2; ++n) acc[a][b][m][n] = (f32x4){0.f, 0.f, 0.f, 0.f};
        }
        cur = nxt; cA = nA; cB = nB; ++ui;
#pragma unroll
        for (int h = 0; h < 2; ++h)
#pragma unroll
            for (int i = 0; i < 2; ++i) gc[h][i] = gn[h][i];
        if constexpr (ALIGN_EPI) { if (wr == 1) PG8_BAR; }
    }
    PG8_WAIT_V(0);
    if constexpr (!ALIGN_EPI) { if (wr == 0) PG8_BAR; }
    PG8_BAR;
    if constexpr (Epi::AFTER_DRAIN) { E.fused(acc, cur, wr, wc, fr, fq, lds, wid, lane); S.done(cur); }
#undef PG8_SA
#undef PG8_SB
#undef PG8_STAGE
#undef PG8_LDA
#undef PG8_LDB
#undef PG8_MMA
#undef PG8_WAIT_V
#undef PG8_WAIT_L
#undef PG8_BAR
#undef PG8_SCHED
}
}
#define XB_TMO      128
#define XB_XCNT(j)  (256  + 64 * (j))
#define XB_XSUB(j)  (1280 + 64 * (j))
#define XB_XGEN(j)  (2304 + 64 * (j))
#define XB_TOP      3328
#define XB_TOPGEN   3392
#define XCD_BAR_WORDS 3456
#define XB_SPIN_CAP (1u << 18)
#define LAS __attribute__((address_space(3)))

__device__ __forceinline__ unsigned xb_ld(unsigned* p)              { return __hip_atomic_load(p, __ATOMIC_RELAXED, __HIP_MEMORY_SCOPE_AGENT); }
__device__ __forceinline__ unsigned xb_add(unsigned* p, unsigned v) { return __hip_atomic_fetch_add(p, v, __ATOMIC_RELAXED, __HIP_MEMORY_SCOPE_AGENT); }
__device__ __forceinline__ unsigned xb_xcc_id() { return (unsigned)__builtin_amdgcn_s_getreg((3 << 11) | 20) & 0xFu; }
#define XB_SPIN(cond, bar) do { unsigned _sp = 0; while (cond) { __builtin_amdgcn_s_sleep(1); \
    if ((++_sp & 255u) == 0u) { if (xb_ld(&(bar)[XB_TMO])) break; if (_sp > XB_SPIN_CAP) { atomicAdd(&(bar)[XB_TMO], 1u); break; } } } } while (0)

struct XcdBarrier {
    unsigned* bar; unsigned x; int wv;
    volatile LAS unsigned* st;
};

__device__ __forceinline__ XcdBarrier xcd_barrier_post(unsigned* bar, volatile LAS unsigned* st) {
    XcdBarrier b; b.bar = bar; b.x = xb_xcc_id(); b.st = st; b.wv = __builtin_amdgcn_readfirstlane(threadIdx.x >> 6);
    if (threadIdx.x == 0) (void)xb_add(&bar[XB_XCNT(b.x)], 1u);
    return b;
}
__device__ __forceinline__ void xcd_barrier_complete(unsigned* bar, unsigned x, unsigned& nloc, unsigned& nx) {
    const unsigned G = gridDim.x * gridDim.y * gridDim.z;
    unsigned sum, cnt, mine, sp = 0u;
    for (;;) {
        sum = 0u; cnt = 0u; mine = 0u;
#pragma unroll
        for (unsigned j = 0; j < 16; ++j) { const unsigned c = xb_ld(&bar[XB_XCNT(j)]); sum += c; cnt += (c > 0u) ? 1u : 0u; mine = (j == x) ? c : mine; }
        if (sum == G) break;
        __builtin_amdgcn_s_sleep(1);
        if ((++sp & 255u) == 0u) { if (xb_ld(&bar[XB_TMO])) break; if (sp > XB_SPIN_CAP) { atomicAdd(&bar[XB_TMO], 1u); break; } }
    }
    nloc = mine > 0u ? mine : 1u; nx = cnt > 0u ? cnt : 1u;
}

__device__ __forceinline__ void xcd_barrier(const XcdBarrier& b) {
    asm volatile("s_waitcnt vmcnt(0)" ::: "memory");
    __syncthreads();
    int xb_lane; asm volatile("v_mbcnt_lo_u32_b32 %0, -1, 0\n\tv_mbcnt_hi_u32_b32 %0, -1, %0" : "=v"(xb_lane));
    if (b.wv == 0 && xb_lane == 0) {
        unsigned* bar = b.bar;
        __builtin_amdgcn_s_waitcnt(0);
        unsigned nloc = b.st[0], nx = b.st[1];
        if (nloc == 0u) { xcd_barrier_complete(bar, b.x, nloc, nx); b.st[0] = nloc; b.st[1] = nx; }
        const unsigned old = xb_add(&bar[XB_XSUB(b.x)], 1u);
        const unsigned gen = old / nloc;
        if (old + 1u == (gen + 1u) * nloc) {
            __builtin_amdgcn_fence(__ATOMIC_RELEASE, "agent");
            asm volatile("s_waitcnt vmcnt(0)" ::: "memory");
            const unsigned og = xb_add(&bar[XB_TOP], 1u);
            const unsigned tg = og / nx;
            if (og + 1u == (tg + 1u) * nx) xb_add(&bar[XB_TOPGEN], 1u);
            else XB_SPIN(xb_ld(&bar[XB_TOPGEN]) == tg, bar);
            __builtin_amdgcn_fence(__ATOMIC_ACQUIRE, "agent");
            xb_add(&bar[XB_XGEN(b.x)], 1u);
            asm volatile("s_waitcnt vmcnt(0)" ::: "memory");
        } else {
            XB_SPIN(xb_ld(&bar[XB_XGEN(b.x)]) == gen, bar);
            __builtin_amdgcn_fence(__ATOMIC_ACQUIRE, "agent");
            asm volatile("s_waitcnt vmcnt(0)" ::: "memory");
        }
    }
    __syncthreads();
}

constexpr int MEGA_THREADS = 512;
constexpr int CONV_EARLY = 1024;
constexpr int NA_SPLIT = 2048;
constexpr int LDS_BYTES = pg8::STAGE_BYTES + 16;
typedef float f32x4 __attribute__((ext_vector_type(4)));
typedef unsigned u32x4 __attribute__((ext_vector_type(4)));
typedef unsigned u32x2 __attribute__((ext_vector_type(2)));

__device__ __forceinline__ int opaque_lane() { int l; asm volatile("v_mbcnt_lo_u32_b32 %0, -1, 0\n\tv_mbcnt_hi_u32_b32 %0, -1, %0" : "=v"(l)); return l; }
__device__ __forceinline__ int opaque_tid(int wv) { return wv * 64 + opaque_lane(); }
__device__ __forceinline__ int opaque_grid() { int g = gridDim.x; asm volatile("" : "+s"(g)); return g; }
__device__ __forceinline__ int opaque_block() { int b = blockIdx.x; asm volatile("" : "+s"(b)); return b; }
template <class F> __device__ __forceinline__ void run_items(int wv, const F& f, long n) {
    const int tid = opaque_tid(wv); const int lane = tid & 63, w = tid >> 6; const int G = opaque_grid(), B = opaque_block();
    const long nw = (long)G * (MEGA_THREADS / 64);
    for (long gw = (long)w * G + B; gw * 64 < n; gw += nw) { const long i = gw * 64 + lane; if (i < n) f(i); }
}

__device__ __forceinline__ void lds_barrier() { asm volatile("s_waitcnt lgkmcnt(0)\n\ts_barrier" ::: "memory"); }

template <int CTRL> __device__ __forceinline__ float dpp_mov(float x) { return __int_as_float(__builtin_amdgcn_mov_dpp(__float_as_int(x), CTRL, 0xf, 0xf, true)); }
__device__ __forceinline__ float row16_sum(float x) {
    x += dpp_mov<0xB1>(x);
    x += dpp_mov<0x4E>(x);
    x += dpp_mov<0x141>(x);
    x += dpp_mov<0x140>(x);
    return x;
}
__device__ __forceinline__ void row16_sum2(float& a, float& b) {
    float a1 = a + dpp_mov<0xB1>(a), b1 = b + dpp_mov<0xB1>(b);
    float a2 = a1 + dpp_mov<0x4E>(a1), b2 = b1 + dpp_mov<0x4E>(b1);
    float a3 = a2 + dpp_mov<0x141>(a2), b3 = b2 + dpp_mov<0x141>(b2);
    a = a3 + dpp_mov<0x140>(a3); b = b3 + dpp_mov<0x140>(b3);
}
__device__ __forceinline__ float wave_sum(float v) {
    v = row16_sum(v);
    const int b = __float_as_int(v);
    return __int_as_float(__builtin_amdgcn_readlane(b, 0)) + __int_as_float(__builtin_amdgcn_readlane(b, 16)) + (__int_as_float(__builtin_amdgcn_readlane(b, 32)) + __int_as_float(__builtin_amdgcn_readlane(b, 48)));
}

typedef short bf16x8 __attribute__((ext_vector_type(8)));
typedef float f32x16 __attribute__((ext_vector_type(16)));
typedef float f32x4 __attribute__((ext_vector_type(4)));
typedef unsigned u32x4 __attribute__((ext_vector_type(4)));
typedef unsigned u32x2 __attribute__((ext_vector_type(2)));
typedef __bf16 bf16x2_t __attribute__((ext_vector_type(2)));
typedef float f32x2_t __attribute__((ext_vector_type(2)));
#define MFMA32(a, b, c) __builtin_amdgcn_mfma_f32_32x32x16_bf16((a), (b), (c), 0, 0, 0)
__device__ __forceinline__ unsigned pk2(float lo, float hi) { const f32x2_t v = {lo, hi}; return __builtin_bit_cast(unsigned, __builtin_convertvector(v, bf16x2_t)); }
__device__ __forceinline__ bf16x8 pack8(float a0, float a1, float a2, float a3, float a4, float a5, float a6, float a7) {
    u32x4 r; r[0] = pk2(a0, a1); r[1] = pk2(a2, a3); r[2] = pk2(a4, a5); r[3] = pk2(a6, a7); return __builtin_bit_cast(bf16x8, r); }
__device__ __forceinline__ bf16x8 ld8(const bf16_t* p) { return *(const bf16x8*)p; }
__device__ __forceinline__ bf16x8 ld4x2(const bf16_t* lo, const bf16_t* hi) { u32x4 r; const u32x2 a = *(const u32x2*)lo, b = *(const u32x2*)hi; r[0] = a[0]; r[1] = a[1]; r[2] = b[0]; r[3] = b[1]; return __builtin_bit_cast(bf16x8, r); }
__device__ __forceinline__ float half_swap_max(float x) { const auto t = __builtin_amdgcn_permlane32_swap(__float_as_uint(x), __float_as_uint(x), false, false); return fmaxf(__uint_as_float(t[0]), __uint_as_float(t[1])); }
__device__ __forceinline__ float half_swap_sum(float x) { const auto t = __builtin_amdgcn_permlane32_swap(__float_as_uint(x), __float_as_uint(x), false, false); return __uint_as_float(t[0]) + __uint_as_float(t[1]); }
constexpr int T_ALL = SEQ + CTX_LEN;
constexpr float LOG2E = 1.4426950408889634f;

struct FNaPrep { Ptrs p; int l; int pad_;
    __device__ __forceinline__ void operator()(long i) const {
        const int isk = (int)(i & 1), h = (int)((i >> 1) % NA_HEADS), r = (int)(i / (2 * NA_HEADS));
        const bf16_t* z = p.Z + (size_t)r * ZLD + (isk ? ZO_NAK : ZO_NAQ) + h * NA_HD;
        float v[NA_HD]; float ss = 0.f;
#pragma unroll
        for (int q = 0; q < NA_HD / 8; ++q) { const u32x4 w = *(const u32x4*)(z + 8 * q);
#pragma unroll
            for (int k = 0; k < 4; ++k) { v[8 * q + 2 * k] = __uint_as_float(w[k] << 16); v[8 * q + 2 * k + 1] = __uint_as_float(w[k] & 0xffff0000u); } }
#pragma unroll
        for (int d = 0; d < NA_HD; ++d) ss += v[d] * v[d];
        const float rn = 1.0f / sqrtf(ss / NA_HD + EPS) * (isk ? 1.0f : LOG2E / sqrtf((float)NA_HD));
        const float* g = (isk ? p.na_k_norm : p.na_q_norm) + l * NA_HD;
        bf16_t* o = (isk ? p.KN : p.QN) + (size_t)r * NA_W + h * NA_HD;
#pragma unroll
        for (int q = 0; q < NA_HD / 8; ++q) { u32x4 w;
#pragma unroll
            for (int k = 0; k < 4; ++k) w[k] = pk2(v[8 * q + 2 * k] * rn * g[8 * q + 2 * k], v[8 * q + 2 * k + 1] * rn * g[8 * q + 2 * k + 1]);
            *(u32x4*)(o + 8 * q) = w; }
    } };
struct FVt { Ptrs p; bf16_t* dst; int zoff, nheads, hd; int pad_;
    __device__ __forceinline__ void operator()(long i) const {
        const int dim = (int)(i % hd), tb = (int)((i / hd) % (T_ALL / 8)), bh = (int)(i / ((long)hd * (T_ALL / 8))), b = bh / nheads, h = bh % nheads;
        const int tok = tb * 8, row0 = tok < SEQ ? b * SEQ + tok : R_LAT + b * CTX_LEN + (tok - SEQ);
        const bf16_t* z = p.Z + (size_t)row0 * ZLD + zoff + h * hd + dim;
        u32x4 w;
#pragma unroll
        for (int k = 0; k < 4; ++k) w[k] = (unsigned)z[(size_t)(2 * k) * ZLD] | ((unsigned)z[(size_t)(2 * k + 1) * ZLD] << 16);
        *(u32x4*)(dst + ((size_t)bh * hd + dim) * T_ALL + tok) = w;
    } };

__device__ __forceinline__ f32x4 bf4_to_f32x(u32x2 w) { f32x4 o; o[0] = __uint_as_float(w[0] << 16); o[1] = __uint_as_float(w[0] & 0xffff0000u); o[2] = __uint_as_float(w[1] << 16); o[3] = __uint_as_float(w[1] & 0xffff0000u); return o; }
constexpr int GLA_NCH = (SEQ + CTX_LEN) / 64, GLA_CCH = CTX_LEN / 64;
static_assert(GLA_DK == 128 && GLA_DV == 256 && GLA_HEADS == 4 && SEQ % 64 == 0 && CTX_LEN % 64 == 0, "GLA kernel geometry");
__device__ __forceinline__ int gla_row0(int b, int cidx) { return cidx < GLA_CCH ? R_LAT + b * CTX_LEN + 64 * cidx : b * SEQ + 64 * (cidx - GLA_CCH); }
__device__ __forceinline__ int gla_tok0(int cidx) { return cidx < GLA_CCH ? SEQ + 64 * cidx : 64 * (cidx - GLA_CCH); }
template <int CTRL> __device__ __forceinline__ float dpp_shr_or(float x, float fill) { return __int_as_float(__builtin_amdgcn_update_dpp(__float_as_int(fill), __float_as_int(x), CTRL, 0xf, 0xf, false)); }
struct FGlaChunk { Ptrs p;
    __device__ __forceinline__ void operator()(long i8) const {
        const int tb = (int)(i8 & 7); const long i = i8 >> 3;
        const int j = (int)(i % (GLA_QK / 4)) * 4, cidx = (int)((i / (GLA_QK / 4)) % GLA_NCH), b = (int)((i / ((long)(GLA_QK / 4) * GLA_NCH)) % BATCH), d = (int)(i / ((long)(GLA_QK / 4) * GLA_NCH * BATCH));
        const int row0 = gla_row0(b, cidx);
        const size_t od = (size_t)d * R_ALL * GLA_QK;
        bf16_t* kpt = p.KPT + ((((size_t)(d * BATCH + b) * GLA_NCH + cidx) * GLA_QK + j) * 64);
        f32x4 a[8]; u32x2 qv[8], kv[8];
#pragma unroll
        for (int u = 0; u < 8; ++u) { const int t = d ? 63 - (tb * 8 + u) : tb * 8 + u; const size_t o = (size_t)(row0 + t) * GLA_QK + j;
            a[u] = *(const f32x4*)(p.GA + od + o); qv[u] = *(const u32x2*)(p.GQ + o); kv[u] = *(const u32x2*)(p.GK + o); }
        f32x4 P[8];
        P[0] = a[0];
#pragma unroll
        for (int u = 1; u < 8; ++u) P[u] = P[u - 1] * a[u];
        f32x4 I = P[7], E;
#pragma unroll
        for (int e = 0; e < 4; ++e) {
            float v = I[e];
            { const float s = dpp_shr_or<0x111>(v, 1.0f); v *= (tb >= 1) ? s : 1.0f; }
            { const float s = dpp_shr_or<0x112>(v, 1.0f); v *= (tb >= 2) ? s : 1.0f; }
            { const float s = dpp_shr_or<0x114>(v, 1.0f); v *= (tb >= 4) ? s : 1.0f; }
            I[e] = v;
            const float s1 = dpp_shr_or<0x111>(v, 1.0f); E[e] = (tb >= 1) ? s1 : 1.0f;
        }
        float kt[4][8];
#pragma unroll
        for (int u = 0; u < 8; ++u) { const int t = d ? 63 - (tb * 8 + u) : tb * 8 + u; const size_t o = (size_t)(row0 + t) * GLA_QK + j;
            const f32x4 A = E * P[u];
            const f32x4 q = bf4_to_f32x(qv[u]), k = bf4_to_f32x(kv[u]); f32x4 qo, ko;
#pragma unroll
            for (int e = 0; e < 4; ++e) { qo[e] = q[e] * A[e]; ko[e] = k[e] * __builtin_amdgcn_rcpf(A[e]); kt[e][d ? 7 - u : u] = ko[e]; }
            u32x2 w; w[0] = pk2(qo[0], qo[1]); w[1] = pk2(qo[2], qo[3]); *(u32x2*)(p.QH + od + o) = w;
            w[0] = pk2(ko[0], ko[1]); w[1] = pk2(ko[2], ko[3]); *(u32x2*)(p.KP + od + o) = w; }
#pragma unroll
        for (int e = 0; e < 4; ++e) { u32x4 w; w[0] = pk2(kt[e][0], kt[e][1]); w[1] = pk2(kt[e][2], kt[e][3]); w[2] = pk2(kt[e][4], kt[e][5]); w[3] = pk2(kt[e][6], kt[e][7]);
            *(u32x4*)(kpt + (size_t)e * 64 + (d ? 56 - tb * 8 : tb * 8)) = w; }
        if (tb == 7) *(f32x4*)(p.DL + ((size_t)(d * BATCH + b) * GLA_NCH + cidx) * GLA_QK + j) = I;
    } };
constexpr int GL_QS = 272, GL_TS = 144;
constexpr int GL_QH = 0, GL_KP = 64 * GL_QS, GL_KPT = 2 * 64 * GL_QS, GL_DL = GL_KPT + 128 * GL_TS, GL_BUF = GL_DL + 512;
static_assert(2 * GL_BUF <= pg8::STAGE_BYTES && GL_BUF % 16 == 0, "GLA staging buffers");
__device__ __forceinline__ bf16x8 lds8(const LAS unsigned char* q) { return *(const LAS bf16x8*)q; }
__device__ __forceinline__ bf16x8 lds4x2(const LAS unsigned char* lo) { u32x4 r; const u32x2 a = *(const LAS u32x2*)lo, b = *(const LAS u32x2*)(lo + 16); r[0] = a[0]; r[1] = a[1]; r[2] = b[0]; r[3] = b[1]; return __builtin_bit_cast(bf16x8, r); }
__device__ __forceinline__ int gla_chunk_at(int d, int step) { return d ? (step < GLA_CCH ? GLA_CCH - 1 - step : GLA_NCH - 1 - (step - GLA_CCH)) : step; }
constexpr int GL_ATT0 = 2 * GL_BUF, GL_ATT = 6 * 1024;
static_assert(GL_ATT0 + 2 * GL_ATT <= pg8::STAGE_BYTES, "GLA att images");
struct GlStage2 { u32x4 q[4], k[4], t[4]; f32x4 dl; };
__device__ __forceinline__ void gla_load2(const Ptrs& p, int b, int hh, int d, int cidx, int t256, GlStage2& st) {
    const size_t od = (size_t)d * R_ALL * GLA_QK; const int row0 = gla_row0(b, cidx);
    const size_t cc = ((size_t)(d * BATCH + b) * GLA_NCH + cidx) * GLA_QK + hh * GLA_DK;
#pragma unroll
    for (int j = 0; j < 4; ++j) { const int i = t256 + 256 * j;
        const size_t o = od + (size_t)(row0 + (i >> 4)) * GLA_QK + hh * GLA_DK + (i & 15) * 8;
        st.q[j] = *(const u32x4*)(p.QH + o); st.k[j] = *(const u32x4*)(p.KP + o);
        st.t[j] = *(const u32x4*)(p.KPT + (cc + (i >> 3)) * 64 + (i & 7) * 8); }
    st.dl = *(const f32x4*)(p.DL + cc + (t256 & 31) * 4);
}
__device__ __forceinline__ void gla_store2(LAS unsigned char* buf, int t256, const GlStage2& st) {
#pragma unroll
    for (int j = 0; j < 4; ++j) { const int i = t256 + 256 * j;
        *(LAS u32x4*)(buf + GL_QH + (i >> 4) * GL_QS + (i & 15) * 16) = st.q[j]; *(LAS u32x4*)(buf + GL_KP + (i >> 4) * GL_QS + (i & 15) * 16) = st.k[j];
        *(LAS u32x4*)(buf + GL_KPT + (i >> 3) * GL_TS + (i & 7) * 16) = st.t[j]; }
    if (t256 < 32) *(LAS f32x4*)(buf + GL_DL + t256 * 16) = st.dl;
}
struct GlAttOp { u32x4 kf[8], qf[8]; };
__device__ __forceinline__ void gla_att_load(const Ptrs& p, int b, int hh, int d, int cidx, int t3, int c, int hf, GlAttOp& op) {
    const int jb = (t3 == 2) ? 1 : 0, ib = (t3 == 0) ? 0 : 1, JB = d ? ib : jb, IB = d ? jb : ib;
    const size_t od = (size_t)d * R_ALL * GLA_QK; const int row0 = gla_row0(b, cidx);
    const bf16_t* kp = p.KP + od + (size_t)(row0 + 32 * JB + c) * GLA_QK + hh * GLA_DK + 8 * hf; const bf16_t* qp = p.QH + od + (size_t)(row0 + 32 * IB + c) * GLA_QK + hh * GLA_DK + 8 * hf;
#pragma unroll
    for (int ks = 0; ks < 8; ++ks) { op.kf[ks] = *(const u32x4*)(kp + 16 * ks); op.qf[ks] = *(const u32x4*)(qp + 16 * ks); }
}
__device__ __forceinline__ void gla_att_make(const GlAttOp& op, LAS unsigned char* att, int d, int t3, int lane) {
    const int c = lane & 31, hf = lane >> 5;
    f32x16 at;
#pragma unroll
    for (int r = 0; r < 16; ++r) at[r] = 0.f;
#pragma unroll
    for (int ks = 0; ks < 8; ++ks) at = MFMA32(__builtin_bit_cast(bf16x8, op.kf[ks]), __builtin_bit_cast(bf16x8, op.qf[ks]), at);
    if (t3 != 1) {
#pragma unroll
        for (int r = 0; r < 16; ++r) { const int jj = (r & 3) + 8 * (r >> 2) + 4 * hf; at[r] = (d ? jj >= c : jj <= c) ? at[r] : 0.f; }
    }
#pragma unroll
    for (int s = 0; s < 2; ++s) *(LAS bf16x8*)(att + ((t3 * 2 + s) * 64 + lane) * 16) = pack8(at[8 * s], at[8 * s + 1], at[8 * s + 2], at[8 * s + 3], at[8 * s + 4], at[8 * s + 5], at[8 * s + 6], at[8 * s + 7]);
}
struct GlV { bf16x8 a[2][2], s[4]; };
__device__ __forceinline__ void gla_load_va(const bf16_t* vtg, unsigned vo, int tok0, int hf, GlV& v) {
#pragma unroll
    for (int jb = 0; jb < 2; ++jb)
#pragma unroll
        for (int s = 0; s < 2; ++s) { const bf16_t* vp = (const bf16_t*)((const char*)vtg + (vo + (unsigned)(tok0 + 32 * jb + 16 * s + 4 * hf)) * 2u); v.a[jb][s] = ld4x2(vp, vp + 8); }
}
__device__ __forceinline__ void gla_load_vs(const bf16_t* vtg, unsigned vo, int tok0, int hf, GlV& v) {
#pragma unroll
    for (int ks = 0; ks < 4; ++ks) v.s[ks] = ld8((const bf16_t*)((const char*)vtg + (vo + (unsigned)(tok0 + 16 * ks + 8 * hf)) * 2u));
}
template <int d  >
__device__ __forceinline__ void gla_chain2(int wv, const Ptrs& p, int item, LAS unsigned char* lds) {
    const int lane = opaque_lane(), c = lane & 31, hf = lane >> 5, w4 = wv & 3;
    const int chain = item >> 1, half = item & 1;
    const int hh = (chain >> 1) % GLA_HEADS, b = chain / (2 * GLA_HEADS);
    __syncthreads();
    if (wv >= 4) {
        const int t256 = w4 * 64 + lane;
        GlStage2 st; GlAttOp op;
        { const int c0 = gla_chunk_at(d, 0);
          gla_load2(p, b, hh, d, c0, t256, st); if (w4 < 3) gla_att_load(p, b, hh, d, c0, w4, c, hf, op);
          gla_store2(lds, t256, st); if (w4 < 3) gla_att_make(op, lds + GL_ATT0, d, w4, lane);
          const int c1 = gla_chunk_at(d, 1);
          gla_load2(p, b, hh, d, c1, t256, st); if (w4 < 3) gla_att_load(p, b, hh, d, c1, w4, c, hf, op); }
        lds_barrier();
        for (int step = 0; step < GLA_NCH; ++step) {
            if (step + 1 < GLA_NCH) { const int nb = (step + 1) & 1;
                gla_store2(lds + nb * GL_BUF, t256, st); if (w4 < 3) gla_att_make(op, lds + GL_ATT0 + nb * GL_ATT, d, w4, lane);
                if (step + 2 < GLA_NCH) { const int cn = gla_chunk_at(d, step + 2);
                    gla_load2(p, b, hh, d, cn, t256, st); if (w4 < 3) gla_att_load(p, b, hh, d, cn, w4, c, hf, op); } }
            lds_barrier();
        }
    } else {
        const int strip = 4 * half + w4;
        f32x16 S[4];
#pragma unroll
        for (int kb = 0; kb < 4; ++kb)
#pragma unroll
            for (int r = 0; r < 16; ++r) S[kb][r] = 0.f;
        const unsigned vo = (unsigned)((b * GLA_HEADS + hh) * GLA_DV + 32 * strip + c) * T_ALL;
        GlV vc; gla_load_va(p.VTG, vo, gla_tok0(gla_chunk_at(d, 0)), hf, vc); gla_load_vs(p.VTG, vo, gla_tok0(gla_chunk_at(d, 0)), hf, vc);
        lds_barrier();
        for (int step = 0; step < GLA_NCH; ++step) {
            const int tokn = gla_tok0(gla_chunk_at(d, step + 1 < GLA_NCH ? step + 1 : step));
            const int cidx = gla_chunk_at(d, step), row0 = gla_row0(b, cidx);
            const LAS unsigned char* buf = lds + (step & 1) * GL_BUF; const LAS unsigned char* att = lds + GL_ATT0 + (step & 1) * GL_ATT + lane * 16;
            f32x16 y[2];
#pragma unroll
            for (int ib = 0; ib < 2; ++ib)
#pragma unroll
                for (int r = 0; r < 16; ++r) y[ib][r] = 0.f;
#pragma unroll
            for (int s = 0; s < 2; ++s) {
                y[0] = MFMA32(*(const LAS bf16x8*)(att + (0 * 2 + s) * 1024), vc.a[0][s], y[0]);
                const bf16x8 a1 = *(const LAS bf16x8*)(att + (1 * 2 + s) * 1024);
                if (d) y[0] = MFMA32(a1, vc.a[1][s], y[0]); else y[1] = MFMA32(a1, vc.a[0][s], y[1]);
                y[1] = MFMA32(*(const LAS bf16x8*)(att + (2 * 2 + s) * 1024), vc.a[1][s], y[1]);
            }
            gla_load_va(p.VTG, vo, tokn, hf, vc);
#pragma unroll
            for (int kb = 0; kb < 4; ++kb)
#pragma unroll
                for (int s = 0; s < 2; ++s) {
                    const bf16x8 sf = pack8(S[kb][8 * s], S[kb][8 * s + 1], S[kb][8 * s + 2], S[kb][8 * s + 3], S[kb][8 * s + 4], S[kb][8 * s + 5], S[kb][8 * s + 6], S[kb][8 * s + 7]);
#pragma unroll
                    for (int ib = 0; ib < 2; ++ib) y[ib] = MFMA32(lds4x2(buf + GL_QH + (32 * ib + c) * GL_QS + (32 * kb + 16 * s + 4 * hf) * 2), sf, y[ib]);
                }
            const unsigned go = ((unsigned)(d * R_ALL + row0 + 4 * hf) * GLA_V + hh * GLA_DV + 32 * strip + c) * 2u;
#pragma unroll
            for (int ib = 0; ib < 2; ++ib)
#pragma unroll
                for (int r = 0; r < 16; ++r) *(bf16_t*)((char*)p.GY + go + (unsigned)((32 * ib + (r & 3) + 8 * (r >> 2)) * GLA_V) * 2u) = (bf16_t)pk2(y[ib][r], 0.f);
#pragma unroll
            for (int kb = 0; kb < 4; ++kb) {
#pragma unroll
                for (int ks = 0; ks < 4; ++ks) S[kb] = MFMA32(lds8(buf + GL_KPT + (32 * kb + c) * GL_TS + 32 * ks + 16 * hf), vc.s[ks], S[kb]);
#pragma unroll
                for (int g = 0; g < 4; ++g) { const f32x4 dv = *(const LAS f32x4*)(buf + GL_DL + (32 * kb + 8 * g + 4 * hf) * 4);
#pragma unroll
                    for (int k = 0; k < 4; ++k) S[kb][4 * g + k] *= dv[k]; }
            }
            gla_load_vs(p.VTG, vo, tokn, hf, vc);
            lds_barrier();
        }
    }
}
__device__ __forceinline__ void gla_phase(int wv, const Ptrs& p, LAS unsigned char* lds, int wg0) {
    const int B = opaque_block(), G = opaque_grid();
    if (B >= wg0) for (int c = B - wg0; c < BATCH * GLA_HEADS * 2 * 2; c += G - wg0) { if ((c >> 1) & 1) gla_chain2<1>(wv, p, c, lds); else gla_chain2<0>(wv, p, c, lds); }
}

constexpr int NA_LAT_UNITS = BATCH * NA_HEADS * (SEQ / GRID_W);
constexpr int NA_CTX_UNITS = BATCH * NA_HEADS * (CTX_LEN / 64);
constexpr int NA_RPB_N = NA_HEADS * (2 * NA_WIN_R_MAX - 1) * (2 * NA_WIN_C - 1);
constexpr int NA_LAND0 = 32768;
static_assert(256 + (NA_RPB_N + 2 * GRID_W) * 4 <= NA_LAND0 - 16 && (NA_LAT_UNITS % 8) == 0 && (NA_CTX_UNITS % 8) == 0 && NA_LAND0 + 8 * 8192 <= pg8::STAGE_BYTES, "NA LDS layout");
static_assert(GRID_W == 64 && NA_HD == 64 && SEQ / GRID_W == 32 && NA_HEADS == 16 && CTX_LEN % 64 == 0, "NA kernel geometry");
struct NaQ { bf16x8 qf[4]; f32x16 o0, o1; float m, ls; };
__device__ __forceinline__ void na_softmax_pv(const float (&s)[16], NaQ& q, const bf16x8 (&vf)[2][2]) {
    float bm = s[0];
#pragma unroll
    for (int r = 1; r < 16; ++r) bm = fmaxf(bm, s[r]);
    bm = half_swap_max(bm);
    const float mn = fmaxf(q.m, bm), ms = (mn == -INFINITY) ? 0.f : mn;
    const float alpha = __builtin_amdgcn_exp2f(q.m - ms);
    const bool moved = __builtin_amdgcn_ballot_w64(mn != q.m) != 0ull;
    q.m = mn;
    float pv[16], psum = 0.f;
#pragma unroll
    for (int r = 0; r < 16; ++r) { pv[r] = __builtin_amdgcn_exp2f(s[r] - ms); psum += pv[r]; }
    q.ls = q.ls * alpha + psum;
    if (moved) {
#pragma unroll
        for (int r = 0; r < 16; ++r) { q.o0[r] *= alpha; q.o1[r] *= alpha; } }
#pragma unroll
    for (int ks = 0; ks < 2; ++ks) {
        const bf16x8 pb = pack8(pv[8 * ks], pv[8 * ks + 1], pv[8 * ks + 2], pv[8 * ks + 3], pv[8 * ks + 4], pv[8 * ks + 5], pv[8 * ks + 6], pv[8 * ks + 7]);
        q.o0 = MFMA32(vf[0][ks], pb, q.o0);
        q.o1 = MFMA32(vf[1][ks], pb, q.o1);
    }
}
__device__ __forceinline__ void na_load_v(const bf16_t* vtb, int c, int hh, bf16x8 (&vf)[2][2]) {
#pragma unroll
    for (int dt = 0; dt < 2; ++dt)
#pragma unroll
        for (int ks = 0; ks < 2; ++ks) { const bf16_t* v0 = vtb + (size_t)(32 * dt + c) * T_ALL + 16 * ks + 4 * hh; vf[dt][ks] = ld4x2(v0, v0 + 8); }
}
__device__ __forceinline__ void na_unit(const Ptrs& p, int u, int, const LAS float* rpb, LAS unsigned char* nab) {
    const int lane = opaque_lane(), c = lane & 31, hh = lane >> 5;
    int b, h, gr = 0, nloc, qrow0;
    if (u < NA_LAT_UNITS) { gr = u & 31; h = (u >> 5) & 15; b = u >> 9; qrow0 = b * SEQ + gr * GRID_W; nloc = NA_WIN_R_MAX; }
    else { const int v = u - NA_LAT_UNITS; h = (v >> 2) & 15; b = v >> 6; qrow0 = R_LAT + b * CTX_LEN + 64 * (v & 3); nloc = 0; }
    NaQ q[2];
#pragma unroll
    for (int qi = 0; qi < 2; ++qi) {
#pragma unroll
        for (int ks = 0; ks < 4; ++ks) q[qi].qf[ks] = ld8((const bf16_t*)((const char*)p.QN + ((unsigned)(qrow0 + 32 * qi + c) * NA_W + h * NA_HD + ks * 16 + 8 * hh) * 2u));
#pragma unroll
        for (int r = 0; r < 16; ++r) { q[qi].o0[r] = 0.f; q[qi].o1[r] = 0.f; }
        q[qi].m = -INFINITY; q[qi].ls = 0.f;
    }
    int rs = gr - NA_WIN_R_MAX / 2; rs = rs < 0 ? 0 : (rs > SEQ / GRID_W - NA_WIN_R_MAX ? SEQ / GRID_W - NA_WIN_R_MAX : rs);
    const int nl2 = 2 * nloc, nblk = nl2 + CTX_LEN / 32;
    bf16x8 kf[4], vf[2][2];
    for (int blk = 0; blk < nblk; ++blk) {
#pragma unroll
        for (int ph = 0; ph < 2; ++ph) {
            if (ph == 0 ? blk == 0 : blk + 1 < nblk) {
                const int i = blk + ph;
                const bool loc = i < nl2; const int ci = i - nl2;
                const int tok0 = loc ? (rs + (i >> 1)) * GRID_W + 32 * (i & 1) : SEQ + 32 * ci;
                const int lz = opaque_lane(), cz = lz & 31, hz = lz >> 5;
                const unsigned ko = ((unsigned)((loc ? b * SEQ + tok0 : R_LAT + b * CTX_LEN + 32 * ci) + cz) * NA_W + h * NA_HD + 8 * hz) * 2u;
                const unsigned vo = ((unsigned)((b * NA_HEADS + h) * NA_HD + cz) * T_ALL + tok0 + 8 * hz) * 2u;
                asm volatile("s_waitcnt lgkmcnt(0)" ::: "memory");
#pragma unroll
                for (int ks = 0; ks < 4; ++ks) __builtin_amdgcn_global_load_lds((const unsigned*)((const char*)p.KN + ko + ks * 32), (LAS unsigned*)(nab + ks * 1024), 16, 0, 0);
#pragma unroll
                for (int dt = 0; dt < 2; ++dt)
#pragma unroll
                    for (int ks = 0; ks < 2; ++ks) __builtin_amdgcn_global_load_lds((const unsigned*)((const char*)p.VTN + vo + (unsigned)(32 * dt * T_ALL + 16 * ks) * 2u), (LAS unsigned*)(nab + 4096 + (dt * 2 + ks) * 1024), 16, 0, 0);
            }
            if (ph == 0) {
                asm volatile("s_waitcnt vmcnt(0)" ::: "memory");
#pragma unroll
                for (int ks = 0; ks < 4; ++ks) kf[ks] = *(const LAS bf16x8*)(nab + ks * 1024 + (c + 32 * hh) * 16);
#pragma unroll
                for (int dt = 0; dt < 2; ++dt)
#pragma unroll
                    for (int ks = 0; ks < 2; ++ks) { const LAS unsigned char* s0 = nab + 4096 + (dt * 2 + ks) * 1024 + c * 16 + 8 * hh;
                        const u32x2 lo = *(const LAS u32x2*)s0, hi = *(const LAS u32x2*)(s0 + 512); u32x4 r; r[0] = lo[0]; r[1] = lo[1]; r[2] = hi[0]; r[3] = hi[1]; vf[dt][ks] = __builtin_bit_cast(bf16x8, r); }
            }
        }
        if (blk < nl2) {
            const int n = blk >> 1, kb = blk & 1;
            const LAS float* rp = rpb + (h * (2 * NA_WIN_R_MAX - 1) + (rs + n - gr + NA_WIN_R_MAX - 1)) * (2 * NA_WIN_C - 1);
#pragma unroll
            for (int qi = 0; qi < 2; ++qi) {
                f32x16 S;
#pragma unroll
                for (int r = 0; r < 16; ++r) S[r] = 0.f;
#pragma unroll
                for (int ks = 0; ks < 4; ++ks) S = MFMA32(kf[ks], q[qi].qf[ks], S);
                const int lz = opaque_lane(), cz = lz & 31, hz = lz >> 5;
                const int qc = 32 * qi + cz; int cs = qc - NA_WIN_C / 2; cs = cs < 0 ? 0 : (cs > GRID_W - NA_WIN_C ? GRID_W - NA_WIN_C : cs);
                const int k0 = 32 * kb + 4 * hz; const int mb = k0 - cs; const LAS float* rb = rp + (k0 - qc + NA_WIN_C - 1);
                float s[16];
#pragma unroll
                for (int r = 0; r < 16; ++r) { const int o = (r & 3) + 8 * (r >> 2); s[r] = ((unsigned)(mb + o) < (unsigned)NA_WIN_C) ? S[r] + rb[o] : -INFINITY; }
                na_softmax_pv(s, q[qi], vf);
            }
        } else {
#pragma unroll
            for (int qi = 0; qi < 2; ++qi) {
                f32x16 S;
#pragma unroll
                for (int r = 0; r < 16; ++r) S[r] = 0.f;
#pragma unroll
                for (int ks = 0; ks < 4; ++ks) S = MFMA32(kf[ks], q[qi].qf[ks], S);
                float s[16];
#pragma unroll
                for (int r = 0; r < 16; ++r) s[r] = S[r];
                na_softmax_pv(s, q[qi], vf);
            }
        }
    }
#pragma unroll
    for (int qi = 0; qi < 2; ++qi) {
        const float inv = 1.0f / half_swap_sum(q[qi].ls);
        bf16_t* yo = (bf16_t*)((char*)p.Y3 + ((unsigned)(qrow0 + 32 * qi + c) * BW + h * NA_HD + 4 * hh) * 2u);
#pragma unroll
        for (int g = 0; g < 4; ++g) {
            u32x2 w0, w1; w0[0] = pk2(q[qi].o0[4 * g] * inv, q[qi].o0[4 * g + 1] * inv); w0[1] = pk2(q[qi].o0[4 * g + 2] * inv, q[qi].o0[4 * g + 3] * inv);
            w1[0] = pk2(q[qi].o1[4 * g] * inv, q[qi].o1[4 * g + 1] * inv); w1[1] = pk2(q[qi].o1[4 * g + 2] * inv, q[qi].o1[4 * g + 3] * inv);
            *(u32x2*)(yo + 8 * g) = w0; *(u32x2*)(yo + 32 + 8 * g) = w1;
        }
    }
}
__device__ __forceinline__ void na_phase(int wv, const Ptrs& p, int l, LAS unsigned char* lds, int u1, unsigned* ctr, int nw  ) {
    const int tid = opaque_tid(wv), lane = tid & 63;
    LAS float* rpb = (LAS float*)(lds + 256);
    volatile LAS int* slot = (volatile LAS int*)(lds + NA_LAND0 - 16);
    __syncthreads();
    for (int i = tid; i < NA_RPB_N; i += MEGA_THREADS) rpb[i] = p.na_rpb[(size_t)l * NA_RPB_N + i] * LOG2E;
    for (;;) {
        __syncthreads();
        if (tid == 0) *slot = (int)__hip_atomic_fetch_add(ctr, (unsigned)nw, __ATOMIC_RELAXED, __HIP_MEMORY_SCOPE_AGENT);
        __syncthreads();
        const int u = __builtin_amdgcn_readfirstlane(*slot) + wv;
        if (u - wv >= u1) break;
        if (u < u1 && wv < nw) na_unit(p, u, lane, rpb, lds + NA_LAND0 + wv * 8192);
    }
}

__device__ __forceinline__ void ld8f(const bf16_t* p, float (&v)[8]) { const u32x4 w = *(const u32x4*)p;
#pragma unroll
    for (int k = 0; k < 4; ++k) { v[2 * k] = __uint_as_float(w[k] << 16); v[2 * k + 1] = __uint_as_float(w[k] & 0xffff0000u); } }
__device__ __forceinline__ void cv8f(const u32x4 w, float (&v)[8]) {
#pragma unroll
    for (int k = 0; k < 4; ++k) { v[2 * k] = __uint_as_float(w[k] << 16); v[2 * k + 1] = __uint_as_float(w[k] & 0xffff0000u); } }
__device__ __forceinline__ void st8f(bf16_t* p, const float (&v)[8]) { u32x4 w;
#pragma unroll
    for (int k = 0; k < 4; ++k) w[k] = pk2(v[2 * k], v[2 * k + 1]);
    *(u32x4*)p = w; }
__device__ __forceinline__ float sum8(float x) { x += dpp_mov<0xB1>(x); x += dpp_mov<0x4E>(x); x += dpp_mov<0x141>(x); return x; }
__device__ __forceinline__ float sum32(float x) { x = row16_sum(x); const auto t = __builtin_amdgcn_permlane16_swap(__float_as_uint(x), __float_as_uint(x), false, false); return __uint_as_float(t[0]) + __uint_as_float(t[1]); }
__device__ __forceinline__ float fast_tanh(float x) { return 1.0f - 2.0f / (__expf(2.0f * x) + 1.0f); }
struct FRope { Ptrs p;
    __device__ __forceinline__ void operator()(long i) const { const int pos = (int)(i / (GLA_DK / 4)), f = (int)(i % (GLA_DK / 4)); const float ang = (float)pos * powf(10000.0f, -(float)(2 * f) / (float)(GLA_DK / 2));
        p.ROPE[2 * i] = cosf(ang); p.ROPE[2 * i + 1] = sinf(ang); } };
constexpr int RWP_ITEMS = RW_W * (4 * 16 + 32);
struct FRwWt { Ptrs p; int l; int pad_;
    __device__ __forceinline__ void operator()(long i) const {
        const int n = (int)(i % RW_W), g8 = (int)(i / RW_W), pl = g8 < 64 ? g8 >> 4 : 4, k0 = (g8 < 64 ? (g8 & 15) : g8 - 64) * 8;
        const int klen = pl < 2 ? RW_DR : (pl < 4 ? RW_AR : RW_GR), Kp = pl < 4 ? 128 : 256;
        const float* W = pl < 2 ? p.rw_w2 + ((size_t)l * 2 + pl) * RW_DR * RW_W : (pl < 4 ? p.rw_a2 + ((size_t)l * 2 + pl - 2) * RW_AR * RW_W : p.rw_g2 + (size_t)l * RW_GR * RW_W);
        float v[8];
#pragma unroll
        for (int e = 0; e < 8; ++e) v[e] = (k0 + e < klen) ? W[(size_t)(k0 + e) * RW_W + n] : 0.f;
        st8f(p.WT_RW + (size_t)RW_W * 128 * pl + (size_t)n * Kp + k0, v);
    } };
static_assert(RW_DR % 8 == 0 && RW_AR % 8 == 0 && RW_DR == 96 && RW_AR == 96 && RW_GR == 256 && RW_W == 1024, "RWKV low-rank GEMM geometry");

constexpr int PR_W2 = 0, PR_GB = PR_W2 + 2 * GLA_RANK * GLA_QK, PR_ROPE = PR_GB + 2 * GLA_QK, PR_MU = PR_ROPE + GRID_W * (GLA_DK / 4) * 2, PR_KK = PR_MU + RW_IN, PR_END = PR_KK + RW_W;
static_assert(PR_END * 4 <= pg8::STAGE_BYTES && RW_IN % 8 == 0 && (RW_IN / 8) <= 8 * 64 && ZO_RW % 8 == 0 && GLA_QK == 512 && NA_W == 1024 && RW_W == 1024, "prep_rows geometry");
__device__ __forceinline__ void prep_rows(int wv, const Ptrs& p, int l, LAS unsigned char* lds) {
    const int tid = opaque_tid(wv), lane = tid & 63; const int G = opaque_grid(), B = opaque_block();
    LAS float* T = (LAS float*)lds;
    __syncthreads();
    for (int i = tid; i < 2 * GLA_RANK * GLA_QK; i += MEGA_THREADS) T[PR_W2 + i] = p.gla_gate_w2[(size_t)l * 2 * GLA_RANK * GLA_QK + i];
    for (int i = tid; i < 2 * GLA_QK; i += MEGA_THREADS) T[PR_GB + i] = p.gla_gate_b[(size_t)l * 2 * GLA_QK + i];
    for (int i = tid; i < GRID_W * (GLA_DK / 4) * 2; i += MEGA_THREADS) T[PR_ROPE + i] = p.ROPE[i];
    for (int i = tid; i < RW_IN; i += MEGA_THREADS) T[PR_MU + i] = p.rw_mu[(size_t)l * RW_IN + i];
    for (int i = tid; i < RW_W; i += MEGA_THREADS) T[PR_KK + i] = p.rw_k_k[(size_t)l * RW_W + i];
    __syncthreads();
    const int rstep = G * (MEGA_THREADS / 64);
    u32x4 wn[4], wg[4], wgd[2 * GLA_RANK / 8], w0[8], wp[8], wx[8];
    const int j0 = lane * 8, i2 = j0 % (GLA_DK / 2), sect = (j0 % GLA_DK) / (GLA_DK / 2); const bool first = i2 < GLA_DK / 4; const int f0 = i2 % (GLA_DK / 4), pj = first ? j0 + GLA_DK / 4 : j0 - GLA_DK / 4;
    auto load_ab = [&](int rr) {
        const bf16_t* z = p.Z + (size_t)rr * ZLD;
#pragma unroll
        for (int it = 0; it < 4; ++it) wn[it] = *(const u32x4*)(z + ((it >> 1) ? ZO_NAK : ZO_NAQ) + (it & 1) * 512 + lane * 8);
        wg[0] = *(const u32x4*)(z + ZO_GQ + j0); wg[1] = *(const u32x4*)(z + ZO_GK + j0); wg[2] = *(const u32x4*)(z + ZO_GQ + pj); wg[3] = *(const u32x4*)(z + ZO_GK + pj);
#pragma unroll
        for (int c = 0; c < 2 * GLA_RANK / 8; ++c) wgd[c] = *(const u32x4*)(z + ZO_GGD + 8 * c);
    };
    auto load_rw = [&](int rr, int h) {
        const bf16_t* z = p.Z + (size_t)rr * ZLD; const bf16_t* zp = row_first(rr) ? z : z - ZLD; const bf16_t* zn = row_last(rr) ? z : z + ZLD;
#pragma unroll
        for (int it = 4 * h; it < 4 * h + 4; ++it) { const int ci = it * 64 + lane, col = (it < 7 || ci < RW_IN / 8 ? ci : lane) * 8;
            w0[it] = *(const u32x4*)(z + ZO_RW + col); wp[it] = *(const u32x4*)(zp + ZO_RW + col); wx[it] = *(const u32x4*)(zn + ZO_RW + col); }
    };
    { const int r0 = wv * G + B; if (r0 < R_ALL) { load_ab(r0); load_rw(r0, 0); } }
    for (int r = wv * G + B; r < R_ALL; r += rstep) {
        asm volatile("" ::: "memory");
        const int rn = r + rstep < R_ALL ? r + rstep : r;
        const bool lat = r < R_LAT; const int tk = r % SEQ, gr = tk / GRID_W, gc = tk % GRID_W;
        const bool rf = row_first(r), rl = row_last(r);
        load_rw(r, 1);
#pragma unroll
        for (int it = 0; it < 4; ++it) {
            const int isk = it >> 1, col = (it & 1) * 512 + lane * 8;
            float v[8]; cv8f(wn[it], v);
            float ss = 0.f;
#pragma unroll
            for (int e = 0; e < 8; ++e) ss += v[e] * v[e];
            ss = sum8(ss);
            const float rn_ = 1.0f / sqrtf(ss / NA_HD + EPS) * (isk ? 1.0f : LOG2E / sqrtf((float)NA_HD));
            const float* g = (isk ? p.na_k_norm : p.na_q_norm) + l * NA_HD + (col % NA_HD);
#pragma unroll
            for (int e = 0; e < 8; ++e) v[e] *= rn_ * g[e];
            st8f((isk ? p.KN : p.QN) + (size_t)r * NA_W + col, v);
        }
        {
            float q[8], k[8], qp[8], kp[8];
            cv8f(wg[0], q); cv8f(wg[1], k);
            const float qs = 1.0f / sqrtf((float)GLA_DK);
            if (lat) {
                cv8f(wg[2], qp); cv8f(wg[3], kp);
                const LAS float* cs = T + PR_ROPE + ((sect ? gc : gr) * (GLA_DK / 4) + f0) * 2;
#pragma unroll
                for (int e = 0; e < 8; ++e) { const float c = cs[2 * e], s = cs[2 * e + 1];
                    q[e] = first ? q[e] * c - qp[e] * s : qp[e] * s + q[e] * c; k[e] = first ? k[e] * c - kp[e] * s : kp[e] * s + k[e] * c; }
            }
#pragma unroll
            for (int e = 0; e < 8; ++e) q[e] *= qs;
            st8f(p.GQ + (size_t)r * GLA_QK + j0, q); st8f(p.GK + (size_t)r * GLA_QK + j0, k);
            float gd[2 * GLA_RANK];
#pragma unroll
            for (int c = 0; c < 2 * GLA_RANK / 8; ++c) { float t8[8]; cv8f(wgd[c], t8);
#pragma unroll
                for (int e = 0; e < 8; ++e) gd[8 * c + e] = t8[e]; }
#pragma unroll
            for (int d = 0; d < 2; ++d) {
                float pre[8];
#pragma unroll
                for (int e = 0; e < 8; ++e) pre[e] = T[PR_GB + d * GLA_QK + j0 + e];
#pragma unroll
                for (int kk = 0; kk < GLA_RANK; ++kk) { const LAS f32x4* w = (const LAS f32x4*)(T + PR_W2 + (d * GLA_RANK + kk) * GLA_QK + j0); const f32x4 w0v = w[0], w1v = w[1]; const float gv = gd[d * GLA_RANK + kk];
                    pre[0] += gv * w0v[0]; pre[1] += gv * w0v[1]; pre[2] += gv * w0v[2]; pre[3] += gv * w0v[3]; pre[4] += gv * w1v[0]; pre[5] += gv * w1v[1]; pre[6] += gv * w1v[2]; pre[7] += gv * w1v[3]; }
                f32x4 a0, a1;
#pragma unroll
                for (int e = 0; e < 4; ++e) { a0[e] = __expf(-softplusf_(-pre[e]) * (1.0f / GLA_TAU)); a1[e] = __expf(-softplusf_(-pre[4 + e]) * (1.0f / GLA_TAU)); }
                f32x4* ga = (f32x4*)(p.GA + ((size_t)d * R_ALL + r) * GLA_QK + j0); ga[0] = a0; ga[1] = a1;
            }
        }
        load_ab(rn);
#pragma unroll
        for (int it = 0; it < 8; ++it) {
            if (it == 4) load_rw(rn, 0);
            const int ci = it * 64 + lane;
            if (it < 7 || ci < RW_IN / 8) {
                const int col = ci * 8;
                float z0[8], zp[8], zn[8], zs[8];
                cv8f(w0[it], z0); cv8f(wp[it], zp); cv8f(wx[it], zn);
                if (rf) {
#pragma unroll
                    for (int e = 0; e < 8; ++e) zp[e] = 0.f; }
                if (rl) {
#pragma unroll
                    for (int e = 0; e < 8; ++e) zn[e] = 0.f; }
#pragma unroll
                for (int e = 0; e < 8; ++e) zs[e] = z0[e] + T[PR_MU + col + e] * (0.5f * (zp[e] + zn[e]) - z0[e]);
                if (it < 2) st8f(p.RS + (size_t)r * RW_W + col, zs);
                else if (it < 4) { const int c2 = col - RW_W;
                    st8f(p.KS + (size_t)r * RW_W + c2, zs);
                    float kk[8], ss = 0.f;
#pragma unroll
                    for (int e = 0; e < 8; ++e) { kk[e] = zs[e] * T[PR_KK + c2 + e]; ss += kk[e] * kk[e]; }
                    ss = sum8(ss);
                    const float rn_ = 1.0f / sqrtf(ss + EPS);
#pragma unroll
                    for (int e = 0; e < 8; ++e) kk[e] *= rn_;
                    st8f(p.KK + (size_t)r * RW_W + c2, kk); }
                else if (it < 6) st8f(p.VS + (size_t)r * RW_W + col - 2 * RW_W, zs);
                else { const int q = col - 3 * RW_W;
#pragma unroll
                    for (int e = 0; e < 8; ++e) zs[e] = q < 2 * RW_DR ? fast_tanh(zs[e]) : (q < 2 * RW_DR + 2 * RW_AR ? zs[e] : 1.0f / (1.0f + __expf(-zs[e])));
                    const int pl = q < 2 * RW_DR ? q / RW_DR : (q < 2 * RW_DR + 2 * RW_AR ? 2 + (q - 2 * RW_DR) / RW_AR : 4), kq = pl < 4 ? q - pl * RW_DR : q - 4 * RW_DR, Kp = pl < 4 ? 128 : 256;
                    bf16_t* lp = p.LOW + (size_t)R_ALL * 128 * pl + (size_t)r * Kp;
                    st8f(lp + kq, zs);
                    if (pl < 4 && kq == RW_DR - 8) {
#pragma unroll
                        for (int e = 0; e < 8; ++e) zs[e] = 0.f;
#pragma unroll
                        for (int z8 = 0; z8 < 4; ++z8) st8f(lp + RW_DR + 8 * z8, zs); } }
            }
        }
    }
}
__device__ __forceinline__ void finish_rows(int wv, const Ptrs& p, int l, int ro) {
    const int tid = opaque_tid(wv), lane = tid & 63; const int G = opaque_grid(), B = opaque_block();
    for (int r = wv * G + B; r < ro; r += G * (MEGA_THREADS / 64)) {
        asm volatile("" ::: "memory");
#pragma unroll
        for (int it = 0; it < 2; ++it) {
            const int col = it * 512 + lane * 8;
            float y0[8], y1[8], rg[8];
            ld8f(p.GY + (size_t)r * GLA_V + col, y0); ld8f(p.GY + ((size_t)R_ALL + r) * GLA_V + col, y1); ld8f(p.Z + (size_t)r * ZLD + ZO_GR + col, rg);
            float ss = 0.f;
#pragma unroll
            for (int e = 0; e < 8; ++e) { y0[e] += y1[e]; ss += y0[e] * y0[e]; }
            ss = sum32(ss);
            const float rn = 1.0f / sqrtf(ss / GLA_DV + EPS);
            const float* g = p.gla_norm_g + (size_t)l * GLA_DV + (col % GLA_DV);
#pragma unroll
            for (int e = 0; e < 8; ++e) y0[e] = y0[e] * rn * g[e] * (rg[e] / (1.0f + __expf(-rg[e])));
            st8f(p.Y3 + (size_t)R_ALL * BW + (size_t)r * BW + col, y0);
        }
#pragma unroll
        for (int it = 0; it < 2; ++it) {
            const int col = it * 512 + lane * 8; const size_t o = (size_t)r * RW_W + col;
            float y0[8], y1[8], rs[8], ks[8], vs[8], gg[8];
            ld8f(p.RY + o, y0); ld8f(p.RY + (size_t)R_ALL * RW_W + o, y1); ld8f(p.RS + o, rs); ld8f(p.KS + o, ks); ld8f(p.VS + o, vs); ld8f(p.G + o, gg);
            const float* rk = p.rw_r_k + (size_t)l * RW_W + col; const float* gng = p.rw_gn_g + (size_t)l * RW_W + col; const float* gnb = p.rw_gn_b + (size_t)l * RW_W + col;
            float sm = 0.f, bonus = 0.f;
#pragma unroll
            for (int e = 0; e < 8; ++e) { y0[e] += y1[e]; sm += y0[e]; bonus += rs[e] * ks[e] * rk[e]; }
            const float mean = sum8(sm) * (1.0f / RW_HEAD); bonus = sum8(bonus);
            float var = 0.f;
#pragma unroll
            for (int e = 0; e < 8; ++e) { y0[e] -= mean; var += y0[e] * y0[e]; }
            const float rn = 1.0f / sqrtf(sum8(var) * (1.0f / RW_HEAD) + RW_GN_EPS);
#pragma unroll
            for (int e = 0; e < 8; ++e) y0[e] = (y0[e] * rn * gng[e] + gnb[e] + bonus * vs[e]) * gg[e];
            st8f(p.Y3 + (size_t)2 * R_ALL * BW + (size_t)r * BW + col, y0);
        }
    }
}
struct EpiRw {
    static constexpr bool PERM = true, AFTER_DRAIN = false, CARRY = false;
    float* DEC; bf16_t *AA, *Gt; const float *w0, *a0; int cb, pad_;
    __device__ __forceinline__ void operator()(const pg8::f32x4 (&acc)[2][2][4][2], const pg8::Unit& u, int wr, int wc, int fr, int fq) const {
        const int row0 = u.pm * 256 + wr * 64 + fr, col0 = u.pn * 256 + wc * 32 + 8 * fq;
#pragma unroll
        for (int ai = 0; ai < 2; ++ai)
#pragma unroll
            for (int m = 0; m < 4; ++m) { const size_t row = (size_t)(row0 + ai * 128 + m * 16);
#pragma unroll
                for (int bj = 0; bj < 2; ++bj) { const int j = col0 + bj * 128;
                    float v[8];
#pragma unroll
                    for (int e = 0; e < 4; ++e) { v[e] = acc[ai][bj][m][0][e]; v[4 + e] = acc[ai][bj][m][1][e]; }
                    if (cb < 2) { f32x4 d0, d1;
#pragma unroll
                        for (int e = 0; e < 4; ++e) { d0[e] = __expf(-0.60653065971f * __builtin_amdgcn_rcpf(1.0f + __expf(-(v[e] + w0[cb * RW_W + j + e]))));
                                                      d1[e] = __expf(-0.60653065971f * __builtin_amdgcn_rcpf(1.0f + __expf(-(v[4 + e] + w0[cb * RW_W + j + 4 + e])))); }
                        f32x4* dp = (f32x4*)(DEC + ((size_t)cb * R_ALL + row) * RW_W + j); dp[0] = d0; dp[1] = d1; }
                    else if (cb < 4) { const int d = cb - 2;
#pragma unroll
                        for (int e = 0; e < 8; ++e) v[e] = 1.0f / (1.0f + __expf(-(v[e] + a0[d * RW_W + j + e])));
                        st8f(AA + ((size_t)d * R_ALL + row) * RW_W + j, v); }
                    else st8f(Gt + row * RW_W + j, v);
                } }
    }
};
static_assert(sizeof(EpiRw) % 8 == 0, "kernel-argument padding");
typedef float f32x2m __attribute__((ext_vector_type(2)));
__device__ __forceinline__ void mod_phase(int wv, const Ptrs& p, LAS unsigned char* lds) {
    const int tid = opaque_tid(wv), lane = tid & 63, w = tid >> 6; const int G = opaque_grid(), B = opaque_block();
    LAS float* sc = (LAS float*)lds;
    LAS float* red = sc + NMOD * D_MODEL;
    __syncthreads();
    for (int i = tid; i < NMOD * D_MODEL; i += MEGA_THREADS) { const int bt = i / D_MODEL, k = i % D_MODEL; const float c = bt < BATCH ? p.c[(size_t)bt * D_MODEL + k] : p.c_ctx[k]; sc[i] = c / (1.0f + __expf(-c)); }
    __syncthreads();
    constexpr int NCB = D6 / 128, KW = D_MODEL / 8;
    for (int u = B; u < DEPTH * NCB; u += G) {
        const int l = u / NCB, cb = u % NCB;
        const f32x2m* wp = (const f32x2m*)(p.ada_w + ((size_t)l * D_MODEL + w * KW) * D6 + cb * 128) + lane;
        f32x2m acc[NMOD];
#pragma unroll
        for (int bt = 0; bt < NMOD; ++bt) acc[bt] = (f32x2m){0.f, 0.f};
#pragma unroll 8
        for (int k = 0; k < KW; ++k) { const f32x2m wv2 = wp[(size_t)k * (D6 / 2)];
#pragma unroll
            for (int bt = 0; bt < NMOD; ++bt) acc[bt] += wv2 * sc[bt * D_MODEL + w * KW + k]; }
#pragma unroll
        for (int bt = 0; bt < NMOD; ++bt) { red[(w * NMOD + bt) * 128 + 2 * lane] = acc[bt][0]; red[(w * NMOD + bt) * 128 + 2 * lane + 1] = acc[bt][1]; }
        __syncthreads();
        for (int o = tid; o < NMOD * 128; o += MEGA_THREADS) { const int bt = o / 128, cl = o % 128; float s = p.ada_b[(size_t)l * D6 + cb * 128 + cl];
#pragma unroll
            for (int ww = 0; ww < 8; ++ww) s += red[(ww * NMOD + bt) * 128 + cl];
            p.MOD[((size_t)l * NMOD + bt) * D6 + cb * 128 + cl] = s; }
        __syncthreads();
    }
}

__device__ __forceinline__ void norm_rows(int wv, const Ptrs& p, int l, int which, int nrows, bool addmoe, LAS unsigned char* lds) {
    static_assert(D_MODEL == 2048, "norm_rows lane mapping");
    const int tid = opaque_tid(wv); const int lane = tid & 63, w = tid >> 6;
    const float* gain = (which ? p.norm2_g : p.norm1_g) + (size_t)l * D_MODEL;
    LAS f32x4* rwl = (LAS f32x4*)lds;
    if (which) {
        static_assert(D_MODEL * N_EXPERTS * 4 <= pg8::STAGE_BYTES, "router matrix fits the LDS stage region");
        __syncthreads();
        for (int i = tid; i < D_MODEL * N_EXPERTS / 4; i += MEGA_THREADS) { const int row = i >> 2, j = i & 3, c = row >> 2, k = row & 3;
            rwl[(k * 4 + j) * (D_MODEL / 4) + c] = ((const f32x4*)p.router_w)[i]; }
        __syncthreads();
    }
    const int G = opaque_grid(), B = opaque_block();
    for (int r = w * G + B; r < nrows; r += G * (MEGA_THREADS / 64)) {
        const f32x4* xr = (const f32x4*)((l == 0 && which == 0) ? (r < R_LAT ? p.x + (size_t)r * D_MODEL : p.ctx + (size_t)(r - R_LAT) * D_MODEL) : p.X + (size_t)r * D_MODEL);
        f32x4 v[8]; float ss = 0.f;
        const int bt = row_bt(r);
#pragma unroll
        for (int i = 0; i < 8; ++i) v[i] = xr[lane + 64 * i];
        if (l == 0 && which == 0) {
#pragma unroll
            for (int i = 0; i < 8; ++i) ((f32x4*)(p.X + (size_t)r * D_MODEL))[lane + 64 * i] = v[i]; }
        if (addmoe) {
            const f32x4* g2p = (const f32x4*)modp(p, l - 1, bt, 5);
#pragma unroll
            for (int i = 0; i < 8; ++i) { const int c = lane + 64 * i;
                const u32x2 a = *(const u32x2*)(p.YK + (size_t)r * D_MODEL + 4 * c), b = *(const u32x2*)(p.YK + ((size_t)R_ALL + r) * D_MODEL + 4 * c); const f32x4 g = g2p[c];
                v[i][0] += g[0] * (__uint_as_float(a[0] << 16) + __uint_as_float(b[0] << 16)); v[i][1] += g[1] * (__uint_as_float(a[0] & 0xffff0000u) + __uint_as_float(b[0] & 0xffff0000u));
                v[i][2] += g[2] * (__uint_as_float(a[1] << 16) + __uint_as_float(b[1] << 16)); v[i][3] += g[3] * (__uint_as_float(a[1] & 0xffff0000u) + __uint_as_float(b[1] & 0xffff0000u));
                ((f32x4*)(p.X + (size_t)r * D_MODEL))[c] = v[i]; }
        }
#pragma unroll
        for (int i = 0; i < 8; ++i) ss += v[i][0] * v[i][0] + v[i][1] * v[i][1] + v[i][2] * v[i][2] + v[i][3] * v[i][3];
        ss = wave_sum(ss);
        const float rstd = 1.0f / sqrtf(ss / D_MODEL + EPS);
        const f32x4* sh = (const f32x4*)modp(p, l, bt, which ? 3 : 0); const f32x4* sc = (const f32x4*)modp(p, l, bt, which ? 4 : 1); const f32x4* g4 = (const f32x4*)gain;
        float lg[N_EXPERTS];
#pragma unroll
        for (int e = 0; e < N_EXPERTS; ++e) lg[e] = 0.f;
#pragma unroll
        for (int i = 0; i < 8; ++i) {
            const int c = lane + 64 * i; const f32x4 g = g4[c], s = sc[c], b = sh[c]; f32x4 h;
#pragma unroll
            for (int k = 0; k < 4; ++k) h[k] = v[i][k] * rstd * g[k] * (1.0f + s[k]) + b[k];
            u32x2 pk; pk[0] = pg8::cvt_pk_bf16(h[0], h[1]); pk[1] = pg8::cvt_pk_bf16(h[2], h[3]);
            *(u32x2*)(p.H + (size_t)r * D_MODEL + 4 * c) = pk;
            if (which) {
#pragma unroll
                for (int k = 0; k < 4; ++k) {
#pragma unroll
                    for (int q = 0; q < 4; ++q) { const f32x4 wv = rwl[(k * 4 + q) * (D_MODEL / 4) + c]; lg[4 * q] += h[k] * wv[0]; lg[4 * q + 1] += h[k] * wv[1]; lg[4 * q + 2] += h[k] * wv[2]; lg[4 * q + 3] += h[k] * wv[3]; } }
            }
        }
        if (which) {
#pragma unroll
            for (int e = 0; e < N_EXPERTS; ++e) lg[e] = wave_sum(lg[e]);
            if (lane == 0) { int i1, i2; float s1, s2; route_select(lg, p.router_bias, i1, i2, s1, s2); const float inv = 1.0f / (s1 + s2);
                p.SELI[2 * r] = i1; p.SELI[2 * r + 1] = i2; p.SELW[2 * r] = s1 * inv; p.SELW[2 * r + 1] = s2 * inv;
                unsigned* cnt = p.BAR + CNT_WORD0 + l * N_EXPERTS * 16;
                p.POS[2 * r] = (int)__hip_atomic_fetch_add(cnt + i1 * 16, 1u, __ATOMIC_RELAXED, __HIP_MEMORY_SCOPE_AGENT);
                p.POS[2 * r + 1] = (int)__hip_atomic_fetch_add(cnt + i2 * 16, 1u, __ATOMIC_RELAXED, __HIP_MEMORY_SCOPE_AGENT); }
        }
    }
}

__device__ __forceinline__ float tr16_reduce(const float (&a)[16], int cg) {
    const bool c0 = cg & 1, c1 = cg & 2, c2 = cg & 4, c3 = cg & 8;
    float b[8], c[4], d[2];
#pragma unroll
    for (int j = 0; j < 8; ++j) { const float keep = c0 ? a[2 * j + 1] : a[2 * j], send = c0 ? a[2 * j] : a[2 * j + 1]; b[j] = keep + dpp_mov<0xB1>(send); }
#pragma unroll
    for (int j = 0; j < 4; ++j) { const float keep = c1 ? b[2 * j + 1] : b[2 * j], send = c1 ? b[2 * j] : b[2 * j + 1]; c[j] = keep + dpp_mov<0x4E>(send); }
#pragma unroll
    for (int j = 0; j < 2; ++j) { const float keep = c2 ? c[2 * j + 1] : c[2 * j], send = c2 ? c[2 * j] : c[2 * j + 1];
        const float r4 = dpp_mov<0x124>(send), r12 = dpp_mov<0x12C>(send); d[j] = keep + (c2 ? r4 : r12); }
    const float keep = c3 ? d[1] : d[0], send = c3 ? d[0] : d[1];
    return keep + dpp_mov<0x128>(send);
}

__device__ __forceinline__ void conv_block(const float* __restrict__ W  , int ldw, bool valid, bf16_t* __restrict__ dst  , int ldt) {
#pragma unroll 1
    for (int kc = 0; kc < 4; ++kc) {
        f32x4 v[16];
#pragma unroll
        for (int j = 0; j < 16; ++j) v[j] = valid ? *(const f32x4*)(W + (size_t)(kc * 16 + j) * ldw) : (f32x4){0.f, 0.f, 0.f, 0.f};
#pragma unroll
        for (int e = 0; e < 4; ++e) {
            u32x4 w0, w1;
#pragma unroll
            for (int q = 0; q < 4; ++q) { w0[q] = pg8::cvt_pk_bf16(v[2 * q][e], v[2 * q + 1][e]); w1[q] = pg8::cvt_pk_bf16(v[8 + 2 * q][e], v[9 + 2 * q][e]); }
            u32x4* o = (u32x4*)(dst + (size_t)e * ldt + kc * 16); o[0] = w0; o[1] = w1;
        }
    }
}
__device__ __forceinline__ void conv_dense(int wv, const Ptrs& p, int l, int parts, int wg0, int f0 = 0, int f1 = 1024) {
    const int tid = opaque_tid(wv), lane = tid & 63; const int G = opaque_grid() - wg0, B = opaque_block() - wg0;
    if (B < 0) return;
    constexpr int KT = D_MODEL / 64, NB_IN = ZLD / 256, N_IN = NB_IN * KT, NB_D = D_MODEL / 256, N_BR = 3 * NB_D * (BW / 64), N_OUT = NB_D * KT;
    static_assert(ZLD % 256 == 0 && D_MODEL % 256 == 0 && D_IN % 4 == 0, "conv_dense blocks");
    const int ulo = (parts & 1) ? (int)((long)N_IN * f0 / 1024) : N_IN, uhi = (parts & 2) ? N_IN + N_BR + N_OUT : (int)((long)N_IN * f1 / 1024);
    for (int u = ulo + wv * G + B; u < uhi; u += G * (MEGA_THREADS / 64)) {
        if (u < N_IN) { const int nb = u % NB_IN, kb = u / NB_IN, n = nb * 256 + lane * 4;
            conv_block(p.w_in + ((size_t)l * D_MODEL + kb * 64) * D_IN + n, D_IN, n < D_IN, p.WT_IN + (size_t)n * D_MODEL + kb * 64, D_MODEL); }
        else if (u < N_IN + N_BR) { const int v = u - N_IN, br = v / (NB_D * (BW / 64)), q = v % (NB_D * (BW / 64)), nb = q % NB_D, kb = q / NB_D, n = nb * 256 + lane * 4;
            conv_block(p.w_branch + (((size_t)l * 3 + br) * BW + kb * 64) * D_MODEL + n, D_MODEL, true, p.WT_BR + ((size_t)br * D_MODEL + n) * BW + kb * 64, BW); }
        else { const int v = u - N_IN - N_BR, nb = v % NB_D, kb = v / NB_D, n = nb * 256 + lane * 4;
            conv_block(p.w_out + ((size_t)l * D_MODEL + kb * 64) * D_MODEL + n, D_MODEL, true, p.WT_OUT + (size_t)n * D_MODEL + kb * 64, D_MODEL); }
    }
}
__device__ __forceinline__ void conv_dyn(const Ptrs& p, int l, unsigned* ctr, bool all) {
    constexpr int KT = D_MODEL / 64, NB_IN = ZLD / 256, N_IN = NB_IN * KT, NB_D = D_MODEL / 256, N_BR = 3 * NB_D * (BW / 64), N_OUT = NB_D * KT;
    const int lane = opaque_lane(); const int nu = all ? N_IN + N_BR + N_OUT : N_IN;
    for (;;) {
        int u = 0;
        if (lane == 0) u = (int)__hip_atomic_fetch_add(ctr, 1u, __ATOMIC_RELAXED, __HIP_MEMORY_SCOPE_AGENT);
        u = __builtin_amdgcn_readfirstlane(u);
        if (u >= nu) break;
        if (u < N_IN) { const int nb = u % NB_IN, kb = u / NB_IN, n = nb * 256 + lane * 4;
            conv_block(p.w_in + ((size_t)l * D_MODEL + kb * 64) * D_IN + n, D_IN, n < D_IN, p.WT_IN + (size_t)n * D_MODEL + kb * 64, D_MODEL); }
        else if (u < N_IN + N_BR) { const int v = u - N_IN, br = v / (NB_D * (BW / 64)), q = v % (NB_D * (BW / 64)), nb = q % NB_D, kb = q / NB_D, n = nb * 256 + lane * 4;
            conv_block(p.w_branch + (((size_t)l * 3 + br) * BW + kb * 64) * D_MODEL + n, D_MODEL, true, p.WT_BR + ((size_t)br * D_MODEL + n) * BW + kb * 64, BW); }
        else { const int v = u - N_IN - N_BR, nb = v % NB_D, kb = v / NB_D, n = nb * 256 + lane * 4;
            conv_block(p.w_out + ((size_t)l * D_MODEL + kb * 64) * D_MODEL + n, D_MODEL, true, p.WT_OUT + (size_t)n * D_MODEL + kb * 64, D_MODEL); }
    }
}
__device__ __forceinline__ void conv_moe(int wv, const Ptrs& p, int l, int f0, int f1, int wg0) {
    const int tid = opaque_tid(wv), lane = tid & 63; const int G = opaque_grid() - wg0, B = opaque_block() - wg0;
    if (B < 0) return;
    constexpr int KT = D_MODEL / 64, RT = 2 * D_EXPERT / 256, N_GU = N_EXPERTS * RT * KT, KTD = D_EXPERT / 64, NB_D = D_MODEL / 256, N_D = N_EXPERTS * NB_D * KTD;
    const int ulo = (int)((long)(N_GU + N_D) * f0 / 1024), uhi = (int)((long)(N_GU + N_D) * f1 / 1024);
    for (int u = ulo + wv * G + B; u < uhi; u += G * (MEGA_THREADS / 64)) {
        if (u < N_GU) { const int pn = u % RT, kb = (u / RT) % KT, e = u / (RT * KT);
            const int up = lane >> 5, c0 = pn * 128 + (lane & 31) * 4;
            const float* W = (up ? p.moe_w_up : p.moe_w_gate) + (((size_t)l * N_EXPERTS + e) * D_MODEL + kb * 64) * D_EXPERT + c0;
            conv_block(W, D_EXPERT, true, p.WGU + ((size_t)e * 2 * D_EXPERT + pn * 256 + lane * 4) * D_MODEL + kb * 64, D_MODEL); }
        else { const int v = u - N_GU, nb = v % NB_D, kb = (v / NB_D) % KTD, e = v / (NB_D * KTD), n = nb * 256 + lane * 4;
            conv_block(p.moe_w_down + (((size_t)l * N_EXPERTS + e) * D_EXPERT + kb * 64) * D_MODEL + n, D_MODEL, true, p.WD + ((size_t)e * D_MODEL + n) * D_EXPERT + kb * 64, D_EXPERT); }
    }
}

struct EpiZ {
    static constexpr bool PERM = true, AFTER_DRAIN = false, CARRY = false;
    bf16_t* O;
    __device__ __forceinline__ void operator()(const f32x4 (&acc)[2][2][4][2], const pg8::Unit& u, int wr, int wc, int fr, int fq) const {
        const int row0 = u.pm * 256 + wr * 64 + fr, col0 = u.pn * 256 + wc * 32 + 8 * fq;
#pragma unroll
        for (int ai = 0; ai < 2; ++ai)
#pragma unroll
            for (int m = 0; m < 4; ++m) { bf16_t* rowp = O + (size_t)(row0 + ai * 128 + m * 16) * ZLD + col0;
#pragma unroll
                for (int bj = 0; bj < 2; ++bj) { const f32x4 v0 = acc[ai][bj][m][0], v1 = acc[ai][bj][m][1];
                    u32x4 pk; pk[0] = pg8::cvt_pk_bf16(v0[0], v0[1]); pk[1] = pg8::cvt_pk_bf16(v0[2], v0[3]); pk[2] = pg8::cvt_pk_bf16(v1[0], v1[1]); pk[3] = pg8::cvt_pk_bf16(v1[2], v1[3]);
                    *(u32x4*)(rowp + bj * 128) = pk; } }
    }
};
struct BranchOrder {
    pg8::StaticOrder S; int rt;
    __device__ __forceinline__ bool next(int i, pg8::Unit& u) const { pg8::Unit t; if (!S.next(i / 3, t)) return false; const int br = i % 3; u.pm = br * rt + t.pm; u.pn = br * (D_MODEL / 256) + t.pn; return true; }
    __device__ __forceinline__ void a_ready(const pg8::Unit&) const {}
    __device__ __forceinline__ void done(const pg8::Unit&) const {}
};
template <bool WT  > struct EpiBranch3T {
    static constexpr bool PERM = false, AFTER_DRAIN = false, CARRY = true;
    const bf16_t* Z; bf16_t* MB; int rt;
    __device__ __forceinline__ f32x4 gate4(size_t row, int br, int col) const { const u32x2 gz = *(const u32x2*)(Z + row * ZLD + ZO_GATE + br * D_MODEL + col);
        f32x4 g; g[0] = __uint_as_float(gz[0] << 16); g[1] = __uint_as_float(gz[0] & 0xffff0000u); g[2] = __uint_as_float(gz[1] << 16); g[3] = __uint_as_float(gz[1] & 0xffff0000u); return g; }
    __device__ __forceinline__ void carry(f32x4 (&acc)[2][2][4][2], const pg8::Unit& u, int wr, int wc, int fr, int fq) const {
        const int br = u.pm / rt, brn = br < 2 ? br + 1 : 2;
        const int row0 = (u.pm - br * rt) * 256 + wr * 64 + fr, col0 = (u.pn - br * (D_MODEL / 256)) * 256 + wc * 32 + 4 * fq;
#pragma unroll
        for (int ai = 0; ai < 2; ++ai)
#pragma unroll
            for (int m = 0; m < 4; ++m) { const size_t row = (size_t)(row0 + ai * 128 + m * 16);
#pragma unroll
                for (int bj = 0; bj < 2; ++bj)
#pragma unroll
                    for (int n = 0; n < 2; ++n) { const int col = col0 + bj * 128 + n * 16; const f32x4 ga = gate4(row, br, col), gb = gate4(row, brn, col); f32x4 v;
#pragma unroll
                        for (int k = 0; k < 4; ++k) { const float num = br < 2 ? 1.0f + __expf(-gb[k]) : 1.0f; v[k] = acc[ai][bj][m][n][k] * num * __builtin_amdgcn_rcpf(1.0f + __expf(-ga[k])); }
                        if (br < 2) acc[ai][bj][m][n] = v;
                        else { u32x2 pk; pk[0] = pg8::cvt_pk_bf16(v[0], v[1]); pk[1] = pg8::cvt_pk_bf16(v[2], v[3]);
                            if constexpr (WT) __hip_atomic_store((unsigned long long*)(MB + row * D_MODEL + col), (unsigned long long)pk[0] | ((unsigned long long)pk[1] << 32), __ATOMIC_RELAXED, __HIP_MEMORY_SCOPE_AGENT);
                            else *(u32x2*)(MB + row * D_MODEL + col) = pk;
                            acc[ai][bj][m][n] = (f32x4){0.f, 0.f, 0.f, 0.f}; } }
                asm volatile("" ::: "memory"); }
    }
    __device__ __forceinline__ void operator()(const f32x4 (&)[2][2][4][2], const pg8::Unit&, int, int, int, int) const {}
};
typedef EpiBranch3T<false> EpiBranch3;
constexpr unsigned CH_SPIN_CAP = 1u << 20;
static_assert(R_ALL / 256 == 36 && D_MODEL / 256 == 8, "chained layer-0 branch / output GEMM orders");
struct BranchOrderL0 {
    int c, rt; unsigned* cnt;
    __device__ __forceinline__ bool next(int i, pg8::Unit& u) const { const int ti = i / 3, br = i - 3 * ti; int pm, pn;
        if (ti == 0) { const int x = c & 7, k = c >> 3; pm = 4 * x + (k & 3); pn = k >> 2; } else if (ti == 1 && c < 32) { pm = 32 + (c >> 3); pn = c & 7; } else return false;
        u.pm = br * rt + pm; u.pn = br * (D_MODEL / 256) + pn; return true; }
    __device__ __forceinline__ void a_ready(const pg8::Unit&) const {}
    __device__ __forceinline__ void done(const pg8::Unit& u) const {
        if (u.pm >= 2 * rt) {
            asm volatile("s_waitcnt vmcnt(0)" ::: "memory");
            if (opaque_lane() == 0) (void)__hip_atomic_fetch_add(cnt + (u.pm - 2 * rt) * 16, 1u, __ATOMIC_RELAXED, __HIP_MEMORY_SCOPE_AGENT); } }
};
struct OutOrderL0 {
    int c; unsigned* cnt;
    __device__ __forceinline__ bool next(int i, pg8::Unit& u) const {
        if (c >= 32) { const int cc = c - 32, x = cc & 7, k = cc >> 3, ux = k + 28 * i; if (i > 1 || ux >= 32) return false; u.pm = 4 * x + (ux & 3); u.pn = ux >> 2; return true; }
        if (i > 0) return false; u.pm = 32 + (c >> 3); u.pn = c & 7; return true; }
    __device__ __forceinline__ void a_ready(const pg8::Unit& u) const {
        unsigned* cp = cnt + u.pm * 16; unsigned sp = 0u;
        for (;;) { unsigned v = 0u; if (opaque_lane() == 0) v = __hip_atomic_load(cp, __ATOMIC_RELAXED, __HIP_MEMORY_SCOPE_AGENT);
            v = (unsigned)__builtin_amdgcn_readfirstlane((int)v); if (v >= 64u) break; __builtin_amdgcn_s_sleep(8); if (++sp > CH_SPIN_CAP) break; }
        __builtin_amdgcn_fence(__ATOMIC_ACQUIRE, "agent");
        asm volatile("s_waitcnt vmcnt(0)" ::: "memory"); }
    __device__ __forceinline__ void done(const pg8::Unit&) const {}
};
struct EpiOut {
    static constexpr bool PERM = false, AFTER_DRAIN = false, CARRY = false;
    float* X; const float* MODL;
    __device__ __forceinline__ void operator()(const f32x4 (&acc)[2][2][4][2], const pg8::Unit& u, int wr, int wc, int fr, int fq) const {
        const int row0 = u.pm * 256 + wr * 64 + fr, col0 = u.pn * 256 + wc * 32 + 4 * fq;
#pragma unroll
        for (int ai = 0; ai < 2; ++ai)
#pragma unroll
            for (int m = 0; m < 4; ++m) { const int row = row0 + ai * 128 + m * 16; const float* g1 = MODL + ((size_t)row_bt(row) * 6 + 2) * D_MODEL;
#pragma unroll
                for (int bj = 0; bj < 2; ++bj)
#pragma unroll
                    for (int n = 0; n < 2; ++n) { const int col = col0 + bj * 128 + n * 16; float* xp = X + (size_t)row * D_MODEL + col;
                        *(f32x4*)xp = *(const f32x4*)xp + *(const f32x4*)(g1 + col) * acc[ai][bj][m][n]; }
            }
    }
};


constexpr int RC = 16, RC_NCH = (CTX_LEN + SEQ) / RC, RC_ITERS = RC_NCH / 4;
constexpr int RI_AR = 0, RI_BK = 4096, RI_NN = 8192, RI_GV = 9216, RI_GC = 9728, RI_BYTES = 9984;
constexpr int RS_ROW = 144, RS_BT = 0, RS_KT = 16 * RS_ROW, RS_AT = 32 * RS_ROW, RS_RT = 48 * RS_ROW, RS_MB = 64 * RS_ROW, RS_MK = RS_MB + 1024, RS_BYTES = RS_MK + 1024;
constexpr int RC_SCR0 = 8 * RI_BYTES;
static_assert(RC_SCR0 + 4 * RS_BYTES <= pg8::STAGE_BYTES && RC_NCH % 4 == 0 && CTX_LEN % RC == 0 && SEQ % RC == 0 && RW_HEAD == 64 && MEGA_THREADS == 512, "chunked RWKV scan layout");
#define MFMA16(a, b, c) __builtin_amdgcn_mfma_f32_16x16x32_bf16((a), (b), (c), 0, 0, 0)
struct RcRaw { float dec[RC]; unsigned kk[RC], bb[RC], kd[RC], rs[RC]; };
__device__ __forceinline__ void rc_load(const Ptrs& p, int b, int h, int d, int c, int lane, RcRaw& rw) {
    const size_t od = (size_t)d * R_ALL * RW_W, o0 = (size_t)scan_row(b, d, c * RC) * RW_W + h * RW_HEAD + lane;
    const long dr = d ? -(long)RW_W : (long)RW_W;
    const float* dp = p.DEC + od + o0; const bf16_t *kp = p.KK + o0, *bp = p.BB + od + o0  , *dkp = p.KS + o0  , *rp = p.RS + o0;
#pragma unroll
    for (int s = 0; s < RC; ++s) { rw.dec[s] = dp[s * dr]; rw.kk[s] = kp[s * dr]; rw.bb[s] = bp[s * dr]; rw.kd[s] = dkp[s * dr]; rw.rs[s] = rp[s * dr]; }
}
__device__ __forceinline__ float rc_bf(unsigned v) { return __uint_as_float(v << 16); }
__device__ __forceinline__ void rc_st16(LAS unsigned char* a, float v) { *(LAS unsigned short*)a = (unsigned short)pk2(v, 0.f); }
__device__ __forceinline__ void rc_wave_sync() { __builtin_amdgcn_fence(__ATOMIC_RELEASE, "wavefront"); __builtin_amdgcn_wave_barrier(); __builtin_amdgcn_fence(__ATOMIC_ACQUIRE, "wavefront"); }
__device__ __forceinline__ void rc_stage_a(const RcRaw& rw, float ka, LAS unsigned char* img, LAS unsigned char* sc, int lane, float (&X)[RC]) {
    float g[RC];
    { float a = 1.f;
#pragma unroll
      for (int s = 0; s < RC; ++s) { a *= rw.dec[s]; g[s] = a; } }
    const float gC = g[RC - 1];
    *(LAS float*)(img + RI_GC + lane * 4) = gC;
    const int arw = (lane >> 5) * 1024 + ((lane >> 2) & 3) * 256 + (((lane >> 4) & 1) * 4 + (lane & 3)) * 2;
    unsigned bh[RC / 2], kh[RC / 2]; float bprev = 0.f, kprev = 0.f;
#pragma unroll
    for (int s = 0; s < RC; ++s) {
        const float gp = s ? g[s - 1] : 1.f, ig = __builtin_amdgcn_rcpf(g[s]);
        const float kkf = rc_bf(rw.kk[s]), af = rc_bf(rw.bb[s]);
        const float at = gp * kkf, bt = kkf * af * ig, kt = rc_bf(rw.kd[s]) * (1.0f + (af - 1.0f) * ka) * ig, rt = g[s] * rc_bf(rw.rs[s]);
        X[s] = at;
        rc_st16(sc + RS_BT + s * RS_ROW + lane * 2, bt); rc_st16(sc + RS_KT + s * RS_ROW + lane * 2, kt); rc_st16(sc + RS_AT + s * RS_ROW + lane * 2, at); rc_st16(sc + RS_RT + s * RS_ROW + lane * 2, rt);
        rc_st16(img + RI_AR + 2048 + arw + s * 16, rt);
        const float bhat = gC * bt, khat = gC * kt;
        if (s & 1) { bh[s >> 1] = pk2(-bprev, -bhat); kh[s >> 1] = pk2(kprev, khat); } else { bprev = bhat; kprev = khat; }
    }
#pragma unroll
    for (int gq = 0; gq < 4; ++gq) { u32x4 w; w[0] = bh[2 * gq]; w[1] = bh[2 * gq + 1]; w[2] = kh[2 * gq]; w[3] = kh[2 * gq + 1];
        *(LAS u32x4*)(img + RI_BK + ((lane >> 4) * 64 + (lane & 15) + 16 * gq) * 16) = w; }
}
__device__ __forceinline__ void rc_stage_bc(LAS unsigned char* img, LAS unsigned char* sc, int lane, const float (&X)[RC]) {
    rc_wave_sync();
    const int i = lane & 15, kg = lane >> 4;
    { const LAS unsigned char* rowp = sc + i * RS_ROW + kg * 16;
      const bf16x8 bA0 = *(const LAS bf16x8*)(rowp + RS_BT), bA1 = *(const LAS bf16x8*)(rowp + RS_BT + 64), kA0 = *(const LAS bf16x8*)(rowp + RS_KT), kA1 = *(const LAS bf16x8*)(rowp + RS_KT + 64),
                   aB0 = *(const LAS bf16x8*)(rowp + RS_AT), aB1 = *(const LAS bf16x8*)(rowp + RS_AT + 64), rB0 = *(const LAS bf16x8*)(rowp + RS_RT), rB1 = *(const LAS bf16x8*)(rowp + RS_RT + 64);
      const f32x4 z = {0.f, 0.f, 0.f, 0.f};
      f32x4 Mb = MFMA16(bA0, aB0, z), Mk = MFMA16(kA0, aB0, z), Nb = MFMA16(bA0, rB0, z), Nk = MFMA16(kA0, rB0, z);
      Mb = MFMA16(bA1, aB1, Mb); Mk = MFMA16(kA1, aB1, Mk); Nb = MFMA16(bA1, rB1, Nb); Nk = MFMA16(kA1, rB1, Nk);
#pragma unroll
      for (int e = 0; e < 4; ++e) { const int s = 4 * kg + e; if (!(s < i)) { Mb[e] = 0.f; Mk[e] = 0.f; } if (!(s <= i)) { Nb[e] = 0.f; Nk[e] = 0.f; } }
      u32x4 nn; nn[0] = pk2(-Nb[0], -Nb[1]); nn[1] = pk2(-Nb[2], -Nb[3]); nn[2] = pk2(Nk[0], Nk[1]); nn[3] = pk2(Nk[2], Nk[3]);
      *(LAS u32x4*)(img + RI_NN + lane * 16) = nn;
#pragma unroll
      for (int e = 0; e < 4; ++e) { *(LAS float*)(sc + RS_MB + ((4 * kg + e) * 16 + i) * 4) = Mb[e]; *(LAS float*)(sc + RS_MK + ((4 * kg + e) * 16 + i) * 4) = Mk[e]; }
    }
    rc_wave_sync();
    float X2[RC];
#pragma unroll
    for (int q = 0; q < 4; ++q) { const f32x4 v = *(const LAS f32x4*)(sc + RS_MK + (i * 16 + 4 * q) * 4); X2[4 * q] = v[0]; X2[4 * q + 1] = v[1]; X2[4 * q + 2] = v[2]; X2[4 * q + 3] = v[3]; }
    const int arw = (lane >> 5) * 1024 + ((lane >> 2) & 3) * 256 + (((lane >> 4) & 1) * 4 + (lane & 3)) * 2;
    float x[RC];
#pragma unroll
    for (int t = 0; t < RC; ++t) x[t] = X[t];
#pragma unroll
    for (int s = 0; s < RC; ++s) {
        const float hs = x[s], h2s = X2[s];
        rc_st16(img + RI_AR + arw + s * 16, hs);
        if (lane < 16) rc_st16(img + RI_GV + (s + 16 * (lane >> 2)) * 8 + (lane & 3) * 2, h2s);
#pragma unroll
        for (int q = (s + 1) / 4; q < 4; ++q) { const f32x4 mv = *(const LAS f32x4*)(sc + RS_MB + (s * 16 + 4 * q) * 4);
#pragma unroll
            for (int e = 0; e < 4; ++e) if (4 * q + e > s) { x[4 * q + e] -= hs * mv[e]; X2[4 * q + e] -= h2s * mv[e]; } }
    }
}
__device__ __forceinline__ u32x2 rc_load_v(const Ptrs& p, int b, int h, int d, int c, int col, int g) {
    const bf16_t* vp = p.VS + (size_t)scan_row(b, d, c * RC + 4 * g) * RW_W + h * RW_HEAD + col;
    const long dr = d ? -(long)RW_W : (long)RW_W;
    const unsigned a0 = vp[0], a1 = vp[dr], a2 = vp[2 * dr], a3 = vp[3 * dr];
    u32x2 r; r[0] = a0 | (a1 << 16); r[1] = a2 | (a3 << 16); return r;
}
__device__ __forceinline__ f32x4 rc_consume(f32x4 (&S)[4], const LAS unsigned char* img, int lane, u32x2 vpk) {
    const int g = lane >> 4;
    const bf16x8 sb0 = pack8(S[0][0], S[0][1], S[0][2], S[0][3], S[1][0], S[1][1], S[1][2], S[1][3]), sb1 = pack8(S[2][0], S[2][1], S[2][2], S[2][3], S[3][0], S[3][1], S[3][2], S[3][3]);
    const LAS unsigned char* ar = img + RI_AR + lane * 16;
    f32x4 u = {0.f, 0.f, 0.f, 0.f}, y = {0.f, 0.f, 0.f, 0.f};
    u = MFMA16(*(const LAS bf16x8*)(ar), sb0, u); y = MFMA16(*(const LAS bf16x8*)(ar + 2048), sb0, y);
    u = MFMA16(*(const LAS bf16x8*)(ar + 1024), sb1, u); y = MFMA16(*(const LAS bf16x8*)(ar + 3072), sb1, y);
    const u32x2 gv = *(const LAS u32x2*)(img + RI_GV + lane * 8);
    u32x4 ga, vb; ga[0] = 0u; ga[1] = 0u; ga[2] = gv[0]; ga[3] = gv[1]; vb[0] = 0u; vb[1] = 0u; vb[2] = vpk[0]; vb[3] = vpk[1];
    u = MFMA16(__builtin_bit_cast(bf16x8, ga), __builtin_bit_cast(bf16x8, vb), u);
    u32x4 uvw; uvw[0] = pk2(u[0], u[1]); uvw[1] = pk2(u[2], u[3]); uvw[2] = vpk[0]; uvw[3] = vpk[1];
    const bf16x8 uv = __builtin_bit_cast(bf16x8, uvw);
    y = MFMA16(*(const LAS bf16x8*)(img + RI_NN + lane * 16), uv, y);
#pragma unroll
    for (int tr = 0; tr < 4; ++tr) { const f32x4 gc = *(const LAS f32x4*)(img + RI_GC + (16 * tr + 4 * g) * 4);
        S[tr] = MFMA16(*(const LAS bf16x8*)(img + RI_BK + (tr * 64 + lane) * 16), uv, S[tr] * gc); }
    return y;
}
__device__ __forceinline__ void rwc_chain(int wv, const Ptrs& p, int l, int chain, LAS unsigned char* lds) {
    const int lane = opaque_lane();
    const int d = chain & 1, h = (chain >> 1) % RW_HEADS, b = chain / (2 * RW_HEADS);
    const int w4 = wv & 3;
    __syncthreads();
    if (wv >= 4) {
        LAS unsigned char* sc = lds + RC_SCR0 + w4 * RS_BYTES;
        RcRaw rw;
        const float ka = p.rw_k_a[(size_t)l * RW_W + h * RW_HEAD + lane];
        rc_load(p, b, h, d, w4, lane, rw);
        for (int it = 0; it < RC_ITERS; ++it) {
            LAS unsigned char* img = lds + ((it & 1) * 4 + w4) * RI_BYTES;
            float X[RC];
            rc_stage_a(rw, ka, img, sc, lane, X);
            if (it + 1 < RC_ITERS) rc_load(p, b, h, d, 4 * (it + 1) + w4, lane, rw);
            rc_stage_bc(img, sc, lane, X);
            lds_barrier();
        }
        lds_barrier();
    } else {
        f32x4 S[4]; u32x2 vc[4];
#pragma unroll
        for (int tr = 0; tr < 4; ++tr) S[tr] = (f32x4){0.f, 0.f, 0.f, 0.f};
        const int col = 16 * w4 + (lane & 15), g = lane >> 4;
#pragma unroll
        for (int q = 0; q < 4; ++q) vc[q] = rc_load_v(p, b, h, d, q, col, g);
        lds_barrier();
        for (int it = 0; it < RC_ITERS; ++it) {
            u32x2 vn[4];
            if (it + 1 < RC_ITERS) {
#pragma unroll
                for (int q = 0; q < 4; ++q) vn[q] = rc_load_v(p, b, h, d, 4 * (it + 1) + q, col, g); }
#pragma unroll
            for (int q = 0; q < 4; ++q) { const int c = 4 * it + q;
                const f32x4 y = rc_consume(S, lds + ((it & 1) * 4 + q) * RI_BYTES, lane, vc[q]);
                bf16_t* yp = p.RY + (size_t)d * R_ALL * RW_W + (size_t)scan_row(b, d, c * RC + 4 * g) * RW_W + h * RW_HEAD + col;
                const long dr = d ? -(long)RW_W : (long)RW_W;
#pragma unroll
                for (int e = 0; e < 4; ++e) yp[e * dr] = (bf16_t)pk2(y[e], 0.f); }
            if (it + 1 < RC_ITERS) {
#pragma unroll
                for (int q = 0; q < 4; ++q) vc[q] = vn[q]; }
            lds_barrier();
        }
    }
}

__device__ __forceinline__ void moe_gather(int wv, const Ptrs& p, int l, int ro, int* so  , bool copy  ) {
    const int tid = opaque_tid(wv), lane = tid & 63, w = tid >> 6;
    const unsigned* cnt = p.BAR + CNT_WORD0 + l * N_EXPERTS * 16;
    __syncthreads();
    if (tid == 0) { int o = 0; for (int e = 0; e < N_EXPERTS; ++e) { so[e] = o; const int c = (int)__hip_atomic_load(cnt + e * 16, __ATOMIC_RELAXED, __HIP_MEMORY_SCOPE_AGENT); so[32 + e] = c; o += (c + 255) & ~255; } so[N_EXPERTS] = o; }
    __syncthreads();
    const int ntiles = so[N_EXPERTS] / 256;
    if (opaque_block() == 0) {
        for (int t = tid; t < ntiles; t += MEGA_THREADS) { int e = 0; for (int q = 1; q < N_EXPERTS; ++q) if (so[q] <= t * 256) e = q; p.TILE_E[t] = e; }
        if (tid == 0) p.TILE_E[MOE_TILES] = ntiles;
    }
    if (opaque_block() < N_EXPERTS) { const int e = opaque_block(); for (int rr = so[e] + so[32 + e] + tid; rr < so[e + 1]; rr += MEGA_THREADS) { p.ROWTOK[rr] = -1; p.ROWW[rr] = 0.f; } }
    const int G = opaque_grid(), B = opaque_block();
    for (int it = w * G + B; it < ro * 2; it += G * (MEGA_THREADS / 64)) {
        const int e = p.SELI[it], dst = so[e] + p.POS[it];
        if (copy) { const u32x4* src = (const u32x4*)(p.H + (size_t)(it >> 1) * D_MODEL); u32x4* d = (u32x4*)(p.HS + (size_t)dst * D_MODEL);
#pragma unroll
            for (int i = 0; i < 4; ++i) d[lane + 64 * i] = src[lane + 64 * i]; }
        if (lane == 0) { p.ROWTOK[dst] = it; p.ROWW[dst] = p.SELW[it]; }
    }
}
struct MoeOrder {
    int ntiles, nN, G, c; const int* tile_e;
    __device__ __forceinline__ bool next(int i, pg8::Unit& u) const { const long L = (long)i * G + c; if (L >= (long)ntiles * nN) return false; const int t = (int)(L / nN); u.pm = t; u.pn = tile_e[t] * nN + (int)(L % nN); return true; }
    __device__ __forceinline__ void a_ready(const pg8::Unit&) const {}
    __device__ __forceinline__ void done(const pg8::Unit&) const {}
};
template <bool WT  > struct EpiMoeUpT {
    static constexpr bool PERM = true, AFTER_DRAIN = false, CARRY = false;
    bf16_t* ACTB; const float* ROWW;
    __device__ __forceinline__ void operator()(const f32x4 (&acc)[2][2][4][2], const pg8::Unit& u, int wr, int wc, int fr, int fq) const {
        const int row0 = u.pm * 256 + wr * 64 + fr, col0 = (u.pn & 3) * 128 + wc * 32 + 8 * fq;
        static_assert(2 * D_EXPERT / 256 == 4, "EpiMoeUp column tiles");
#pragma unroll
        for (int ai = 0; ai < 2; ++ai)
#pragma unroll
            for (int m = 0; m < 4; ++m) { const int row = row0 + ai * 128 + m * 16; const float w = ROWW[row];
                float a[8];
#pragma unroll
                for (int n = 0; n < 2; ++n)
#pragma unroll
                    for (int k = 0; k < 4; ++k) { const float g = acc[ai][0][m][n][k], uu = acc[ai][1][m][n][k]; a[4 * n + k] = g / (1.0f + __expf(-g)) * uu * w; }
                u32x4 pk; pk[0] = pg8::cvt_pk_bf16(a[0], a[1]); pk[1] = pg8::cvt_pk_bf16(a[2], a[3]); pk[2] = pg8::cvt_pk_bf16(a[4], a[5]); pk[3] = pg8::cvt_pk_bf16(a[6], a[7]);
                if constexpr (WT) { unsigned long long* dq = (unsigned long long*)(ACTB + (size_t)row * D_EXPERT + col0);
                    __hip_atomic_store(dq, (unsigned long long)pk[0] | ((unsigned long long)pk[1] << 32), __ATOMIC_RELAXED, __HIP_MEMORY_SCOPE_AGENT);
                    __hip_atomic_store(dq + 1, (unsigned long long)pk[2] | ((unsigned long long)pk[3] << 32), __ATOMIC_RELAXED, __HIP_MEMORY_SCOPE_AGENT); }
                else *(u32x4*)(ACTB + (size_t)row * D_EXPERT + col0) = pk; }
    }
};
typedef EpiMoeUpT<false> EpiMoeUp;
struct EpiMoeDown {
    static constexpr bool PERM = true, AFTER_DRAIN = false, CARRY = false;
    bf16_t* YK; const int* ROWTOK;
    __device__ __forceinline__ void operator()(const f32x4 (&acc)[2][2][4][2], const pg8::Unit& u, int wr, int wc, int fr, int fq) const {
        static_assert(D_MODEL / 256 == 8, "EpiMoeDown column tiles");
        const int row0 = u.pm * 256 + wr * 64 + fr, col0 = (u.pn & 7) * 256 + wc * 32 + 8 * fq;
#pragma unroll
        for (int ai = 0; ai < 2; ++ai)
#pragma unroll
            for (int m = 0; m < 4; ++m) { const int tok = ROWTOK[row0 + ai * 128 + m * 16];
                if (tok >= 0) { bf16_t* rowp = YK + ((size_t)(tok & 1) * R_ALL + (tok >> 1)) * D_MODEL + col0;
#pragma unroll
                    for (int bj = 0; bj < 2; ++bj) { const f32x4 v0 = acc[ai][bj][m][0], v1 = acc[ai][bj][m][1];
                        u32x4 pk; pk[0] = pg8::cvt_pk_bf16(v0[0], v0[1]); pk[1] = pg8::cvt_pk_bf16(v0[2], v0[3]); pk[2] = pg8::cvt_pk_bf16(v1[0], v1[1]); pk[3] = pg8::cvt_pk_bf16(v1[2], v1[3]);
                        *(u32x4*)(rowp + bj * 128) = pk; } } }
    }
};
template <class Epi> __device__ __forceinline__ void moe_gemm_call(int wv, LAS unsigned char* lds, const Ptrs& p, const bf16_t* A, const bf16_t* Bt, int nN, int K, const Epi& E) {
    pg8::Gemm g{A, Bt, 0, 0, K}; MoeOrder S{p.TILE_E[MOE_TILES], nN, opaque_grid(), opaque_block(), p.TILE_E};
    pg8::gemm_phase<Epi, MoeOrder, true, true>(lds, g, S, E, wv);
}
__device__ __forceinline__ void final_out(int wv, const Ptrs& p) {
    const int tid = opaque_tid(wv);
    const size_t n4 = (size_t)R_LAT * D_MODEL / 4;
    const int G = opaque_grid(), B = opaque_block();
    for (size_t i = (size_t)B * MEGA_THREADS + tid; i < n4; i += (size_t)G * MEGA_THREADS) {
        const int r = (int)(i / (D_MODEL / 4)), c = (int)(i % (D_MODEL / 4));
        const f32x4 g = ((const f32x4*)modp(p, DEPTH - 1, row_bt(r), 5))[c]; f32x4 v = ((const f32x4*)p.X)[i];
        const u32x2 a = *(const u32x2*)(p.YK + i * 4), b = *(const u32x2*)(p.YK + (size_t)R_ALL * D_MODEL + i * 4);
        v[0] += g[0] * (__uint_as_float(a[0] << 16) + __uint_as_float(b[0] << 16)); v[1] += g[1] * (__uint_as_float(a[0] & 0xffff0000u) + __uint_as_float(b[0] & 0xffff0000u));
        v[2] += g[2] * (__uint_as_float(a[1] << 16) + __uint_as_float(b[1] << 16)); v[3] += g[3] * (__uint_as_float(a[1] & 0xffff0000u) + __uint_as_float(b[1] & 0xffff0000u));
        ((f32x4*)p.out)[i] = v;
    }
}

template <class Epi, bool ALIGN = true> __device__ __forceinline__ void gemm_call(int wv, LAS unsigned char* lds, const bf16_t* A, const bf16_t* Bt, int M, int N, int K, const Epi& E, int wg0 = 0) {
    const int Bq = opaque_block(); if (Bq < wg0) return;
    pg8::Gemm g{A, Bt, M, N, K}; pg8::StaticOrder S; S.init(M, N, opaque_grid() - wg0, Bq - wg0);
    pg8::gemm_phase<Epi, pg8::StaticOrder, ALIGN, true>(lds, g, S, E, wv);
}

__global__ void __launch_bounds__(MEGA_THREADS, 2) mega_fwd(Ptrs p) {
    extern __shared__ __attribute__((aligned(16))) unsigned char smem[];
    LAS unsigned char* lds = (LAS unsigned char*)smem;
    volatile LAS unsigned* stw = (volatile LAS unsigned*)(lds + pg8::STAGE_BYTES);
    const int wv = __builtin_amdgcn_readfirstlane(threadIdx.x >> 6);
    if (threadIdx.x < 4) stw[threadIdx.x] = 0u;
    __syncthreads();
    const XcdBarrier bar = xcd_barrier_post(p.BAR, stw);
#define GRID_SYNC() xcd_barrier(bar)
#if PROBE_SET
    unsigned long long pr_t0 = 0;
#define PB(g) do { if ((PROBE_SET >> (g)) & 1) pr_t0 = __builtin_amdgcn_s_memrealtime(); } while (0)
#define PE(g) do { if ((PROBE_SET >> (g)) & 1) { const unsigned long long pr_t1 = __builtin_amdgcn_s_memrealtime(); while (__builtin_amdgcn_s_memrealtime() - pr_t1 < pr_t1 - pr_t0) __builtin_amdgcn_s_sleep(8); } } while (0)
#else
#define PB(g) do {} while (0)
#define PE(g) do {} while (0)
#endif

    PB(0); { mod_phase(wv, p, lds); }
    { run_items(wv, FRope{p}, (long)GRID_W * (GLA_DK / 4)); } PE(0);
#pragma unroll
    for (int l = 0; l < DEPTH; ++l) {
        const int ro = rows_out(l);
        PB(1); { conv_dense(wv, p, l, 3, 0, l == 0 ? 0 : CONV_EARLY); }
        { run_items(wv, FRwWt{p, l}, (long)RWP_ITEMS); } PE(1);
        if (l == 0) GRID_SYNC();
        PB(2); { norm_rows(wv, p, l, 0, R_ALL, l > 0, lds); } PE(2);
        GRID_SYNC();
        PB(3); { gemm_call<EpiZ, false>(wv, lds, p.H, p.WT_IN, R_ALL, ZLD, D_MODEL, EpiZ{p.Z}); } PE(3);
        GRID_SYNC();
        PB(4); PB(20); { prep_rows(wv, p, l, lds); } PE(20); PB(21);
        { run_items(wv, FVt{p, p.VTN, ZO_NAV, NA_HEADS, NA_HD}, (long)BATCH * NA_HEADS * NA_HD * (T_ALL / 8)); }
        { run_items(wv, FVt{p, p.VTG, ZO_GV, GLA_HEADS, GLA_DV}, (long)BATCH * GLA_V * (T_ALL / 8)); } PE(21); PE(4);
        GRID_SYNC();
        PB(5); PB(17); { run_items(wv, FGlaChunk{p}, (long)2 * BATCH * GLA_NCH * (GLA_QK / 4) * 8); } PE(17);
        PB(16); {
#pragma unroll 1
            for (int pl = 0; pl < 5; ++pl) {
                const int G = opaque_grid(), rot = ((pl * (R_ALL / 256) * (RW_W / 256)) % G) & ~7;
                pg8::Gemm gq{p.LOW + (size_t)R_ALL * 128 * pl, p.WT_RW + (size_t)RW_W * 128 * pl, R_ALL, RW_W, pl < 4 ? 128 : 256}; pg8::StaticOrder S; S.init(R_ALL, RW_W, G, (opaque_block() + G - rot) % G);
                pg8::gemm_phase<EpiRw, pg8::StaticOrder, true, true>(lds, gq, S, EpiRw{p.DEC, p.BB, p.G, p.rw_w0 + (size_t)l * 2 * RW_W, p.rw_a0 + (size_t)l * 2 * RW_W, pl, 0}, wv); } } PE(16); PE(5);
        GRID_SYNC();
        PB(6); PB(13); { for (int ch = opaque_block(); ch < BATCH * RW_HEADS * 2; ch += opaque_grid()) rwc_chain(wv, p, l, ch, lds); } PE(13);
        const bool wide = opaque_grid() >= 256;
        PB(14); { gla_phase(wv, p, lds, wide ? 128 : 0); } PE(14);
        PB(15); { na_phase(wv, p, l, lds, NA_LAT_UNITS + (l < DEPTH - 1 ? NA_CTX_UNITS : 0), p.BAR + NA_CTR_WORD0 + l * 16, (wide && opaque_block() < 192) ? 4 : 8); } PE(15);
        if (l + 1 < DEPTH) { conv_dyn(p, l + 1, p.BAR + NA_CTR_WORD0 + 32 + l * 16, false); } PE(6);
        GRID_SYNC();
        PB(7); { finish_rows(wv, p, l, ro); } PE(7);
        GRID_SYNC();
        PB(8);
        if (l == 0 && opaque_grid() == 256) {
            unsigned* chc = p.BAR + CH_WORD0 + 4096;
            { pg8::Gemm gq{p.Y3, p.WT_BR, 0, 0, BW}; BranchOrderL0 S{opaque_block(), R_ALL / 256, chc};
              pg8::gemm_phase<EpiBranch3T<true>, BranchOrderL0, true, true>(lds, gq, S, EpiBranch3T<true>{p.Z, p.MB, R_ALL / 256}, wv); }
            { pg8::Gemm gq{p.MB, p.WT_OUT, ro, D_MODEL, D_MODEL}; OutOrderL0 S{opaque_block(), chc};
              pg8::gemm_phase<EpiOut, OutOrderL0, true, true>(lds, gq, S, EpiOut{p.X, p.MOD + (size_t)l * NMOD * D6}, wv); }
            { conv_moe(wv, p, l, 0, 1024, 64); }
        } else {
            { pg8::Gemm gq{p.Y3, p.WT_BR, 0, 0, BW}; BranchOrder S; S.S.init(ro, D_MODEL, opaque_grid(), opaque_block()); S.rt = R_ALL / 256;
              pg8::gemm_phase<EpiBranch3, BranchOrder, true, true>(lds, gq, S, EpiBranch3{p.Z, p.MB, R_ALL / 256}, wv); }
            GRID_SYNC();
            { gemm_call(wv, lds, p.MB, p.WT_OUT, ro, D_MODEL, D_MODEL, EpiOut{p.X, p.MOD + (size_t)l * NMOD * D6}); }
        }
        PE(8);
        GRID_SYNC();
        PB(9); PB(18); { norm_rows(wv, p, l, 1, ro, false, lds); } PE(18);
        PB(19); { if (!(l == 0 && opaque_grid() == 256)) conv_moe(wv, p, l, 0, 1024, 0); } PE(19); PE(9);
        GRID_SYNC();
        const bool gath = opaque_grid() * 2 >= MOE_TILES * 4;
        PB(10); { moe_gather(wv, p, l, ro, (int*)smem, !gath); } PE(10);
        GRID_SYNC();
        PB(11); { if (gath) { pg8::Gemm gq{p.H, p.WGU, 0, 0, D_MODEL}; MoeOrder S{p.TILE_E[MOE_TILES], 4, opaque_grid(), opaque_block(), p.TILE_E};
                      pg8::gemm_phase<EpiMoeUp, MoeOrder, true, true, true>(lds, gq, S, EpiMoeUp{p.ACTB, p.ROWW}, wv, p.ROWTOK); }
                  else moe_gemm_call(wv, lds, p, p.HS, p.WGU, 4, D_MODEL, EpiMoeUp{p.ACTB, p.ROWW}); } PE(11);
        GRID_SYNC();
        PB(11); { moe_gemm_call(wv, lds, p, p.ACTB, p.WD, 8, D_EXPERT, EpiMoeDown{p.YK, p.ROWTOK}); } PE(11);
        GRID_SYNC();
    }
    PB(12); { final_out(wv, p); } PE(12);
#undef GRID_SYNC
}

extern "C" void kernel_launch(void* const* d_in, const int* in_sizes, int n_in, void* d_out, int out_size, void* d_ws, size_t ws_size, hipStream_t stream) {
    static int grid = 0;
    Ptrs p{};
    fill_inputs(p, d_in);
    p.out = (float*)d_out;
    const size_t need = ws_carve(p, (char*)d_ws);
    if (grid == 0) {
        if (need > ws_size || n_in != 33) { fprintf(stderr, "kernel_launch: workspace %zu < %zu or n_in %d != 33; nothing launched\n", ws_size, need, n_in); grid = -1; return; }
        int dev = 0, cus = 0, per_cu = 0;
        if (hipGetDevice(&dev) != hipSuccess || hipDeviceGetAttribute(&cus, hipDeviceAttributeMultiprocessorCount, dev) != hipSuccess) { grid = -1; return; }
        if (hipFuncSetAttribute((const void*)mega_fwd, hipFuncAttributeMaxDynamicSharedMemorySize, LDS_BYTES) != hipSuccess) { fprintf(stderr, "kernel_launch: hipFuncSetAttribute failed\n"); grid = -1; return; }
        if (hipOccupancyMaxActiveBlocksPerMultiprocessor(&per_cu, (const void*)mega_fwd, MEGA_THREADS, LDS_BYTES) != hipSuccess || per_cu < 1) { fprintf(stderr, "kernel_launch: occupancy query says %d blocks per CU; nothing launched\n", per_cu); (void)hipGetLastError(); grid = -1; return; }
        grid = cus;
    }
    if (grid < 0) return;
    (void)hipMemsetAsync(p.BAR, 0, BAR_BYTES, stream);
    hipLaunchKernelGGL(mega_fwd, dim3(grid), dim3(MEGA_THREADS), LDS_BYTES, stream, p);
}
#endif
```

```cpp
#ifndef CPU_TEST
#include <hip/hip_runtime.h>
#define HD __host__ __device__ __forceinline__
#else
#define HD inline
#endif
#include <cmath>
#include <cstdint>
#include <cstddef>
#include <cstdio>

#ifndef PROBE_SET
#define PROBE_SET 0
#endif
#ifdef CFG_SMALL
constexpr int D_MODEL = 48, BATCH = 2, GRID_W = 32, SEQ = 384, DEPTH = 2, CTX_LEN = 64;
constexpr int NA_HEADS = 2, NA_HD = 16;
constexpr int GLA_HEADS = 2, GLA_DK = 8, GLA_DV = 16, GLA_RANK = 4;
constexpr int RW_HEADS = 2, RW_HEAD = 16, RW_DR = 6, RW_AR = 6, RW_GR = 8;
constexpr int D_EXPERT = 12;
#else
constexpr int D_MODEL = 2048, BATCH = 4, GRID_W = 64, SEQ = 2048, DEPTH = 2, CTX_LEN = 256;
constexpr int NA_HEADS = 16, NA_HD = 64;
constexpr int GLA_HEADS = 4, GLA_DK = 128, GLA_DV = 256, GLA_RANK = 16;
constexpr int RW_HEADS = 16, RW_HEAD = 64, RW_DR = 96, RW_AR = 96, RW_GR = 256;
constexpr int D_EXPERT = 512;
#endif
constexpr int NA_WIN_R_MAX = 8, NA_WIN_C = 16;
constexpr int NA_W = NA_HEADS * NA_HD;
constexpr int GLA_QK = GLA_HEADS * GLA_DK, GLA_V = GLA_HEADS * GLA_DV;
constexpr float GLA_TAU = 16.0f;
constexpr int RW_W = RW_HEADS * RW_HEAD;
constexpr int RW_IN = 3 * RW_W + 2 * RW_DR + 2 * RW_AR + RW_GR;
constexpr int RW_LOW = 2 * RW_DR + 2 * RW_AR + RW_GR;
constexpr float RW_GN_EPS = 64e-5f;
constexpr int BW = NA_W;
static_assert(GLA_V == BW && RW_W == BW, "branch widths");
constexpr int N_EXPERTS = 16, N_GROUPS = 4, EPG = 4;
constexpr float EPS = 1e-6f;
constexpr int D6 = 6 * D_MODEL;
constexpr int ZO_NAQ = 0, ZO_NAK = NA_W, ZO_NAV = 2 * NA_W;
constexpr int ZO_GQ = 3 * NA_W, ZO_GK = ZO_GQ + GLA_QK, ZO_GV = ZO_GK + GLA_QK, ZO_GR = ZO_GV + GLA_V, ZO_GGD = ZO_GR + GLA_V;
constexpr int ZO_RW = ZO_GGD + 2 * GLA_RANK, ZO_GATE = ZO_RW + RW_IN, D_IN = ZO_GATE + 3 * D_MODEL;
constexpr int RO_R = 0, RO_K = RW_W, RO_V = 2 * RW_W, RO_WD = 3 * RW_W, RO_AD = RO_WD + 2 * RW_DR, RO_GD = RO_AD + 2 * RW_AR;
#ifdef CFG_SMALL
constexpr int ZLD = D_IN;
#else
constexpr int ZLD = 16128;
static_assert(D_IN == 16032, "D_IN");
#endif
constexpr int R_LAT = BATCH * SEQ, R_CTX = BATCH * CTX_LEN, R_ALL = R_LAT + R_CTX;
constexpr int NMOD = BATCH + 1;
constexpr int MOE_TILES = (R_ALL * 2 + N_EXPERTS * 255) / 256 + 1, MOE_ROWS = MOE_TILES * 256;
constexpr int CNT_WORD0 = 3456;
constexpr int BAR_BYTES = 65536;
constexpr int CH_WORD0 = 4096;
constexpr int NA_CTR_WORD0 = 3968;

typedef unsigned short bf16_t;
HD float bf2f(bf16_t b) { union { unsigned u; float f; } v; v.u = ((unsigned)b) << 16; return v.f; }
HD bf16_t f2bf(float f) { union { unsigned u; float f; } v; v.f = f; unsigned u = v.u; if ((u & 0x7fffffffu) > 0x7f800000u) return (bf16_t)0x7fc0; u += 0x7FFFu + ((u >> 16) & 1u); return (bf16_t)(u >> 16); }
HD float ldf(const float* p, size_t i) { return p[i]; }
HD float ldf(const bf16_t* p, size_t i) { return bf2f(p[i]); }
HD void stf(float* p, size_t i, float v) { p[i] = v; }
HD void stf(bf16_t* p, size_t i, float v) { p[i] = f2bf(v); }

#ifdef CPU_TEST
typedef float ZT; typedef float AT; typedef float RT;
#else
typedef bf16_t ZT; typedef bf16_t AT; typedef bf16_t RT;
#endif

#if defined(__HIP_DEVICE_COMPILE__)
#define EXPF_(x) __expf(x)
#define LOGF_(x) __logf(x)
#else
#define EXPF_(x) expf(x)
#define LOGF_(x) logf(x)
#endif
HD float sigmoidf_(float x) { return 1.0f / (1.0f + EXPF_(-x)); }
HD float siluf_(float x) { return x / (1.0f + EXPF_(-x)); }
HD float softplusf_(float x) { return (x > 0.f ? x : 0.f) + LOGF_(1.0f + EXPF_(-fabsf(x))); }

struct Ptrs {
    const float *x, *c, *ctx, *c_ctx, *ada_w, *ada_b, *norm1_g, *norm2_g, *w_in, *na_q_norm, *na_k_norm, *na_rpb, *gla_gate_w2, *gla_gate_b, *gla_norm_g,
        *rw_mu, *rw_w0, *rw_w2, *rw_a0, *rw_a2, *rw_g2, *rw_k_k, *rw_k_a, *rw_r_k, *rw_gn_g, *rw_gn_b, *w_branch, *w_out, *router_w, *router_bias,
        *moe_w_gate, *moe_w_up, *moe_w_down;
    float* out;
    float* MOD;
    float* X;
    float* RSTD;
    AT* H;
    ZT* Z;
    AT* Y3;
    RT *GQ, *GK, *GY; float* GA;
    bf16_t *QH, *KP, *KPT, *VTG; float* DL;
    bf16_t *QN, *KN, *VTN;
    float* DEC;
    RT *G, *LOW, *KK, *RS, *VS, *KS, *KD, *BB, *RY;
    bf16_t* WT_RW;
    float* ROPE;
    float* MF;
    int* SELI;
    float* SELW;
    float* ACT;
    bf16_t *WT_IN, *WT_BR, *WT_OUT;
    bf16_t* MB;
    unsigned* BAR;
    bf16_t *WGU, *WD;
    bf16_t *HS, *ACTB;
    bf16_t* YK;
    int *POS, *ROWTOK, *TILE_E;
    float* ROWW;
};

HD int row_bt(int r) { return r < R_LAT ? r / SEQ : BATCH; }
HD int rows_out(int l) { return l < DEPTH - 1 ? R_ALL : R_LAT; }
HD bool row_first(int r) { return r < R_LAT ? (r % SEQ == 0) : ((r - R_LAT) % CTX_LEN == 0); }
HD bool row_last(int r) { return r < R_LAT ? (r % SEQ == SEQ - 1) : ((r - R_LAT) % CTX_LEN == CTX_LEN - 1); }
HD const float* modp(const Ptrs& p, int l, int bt, int k) { return p.MOD + (((size_t)l * NMOD + bt) * 6 + k) * D_MODEL; }
HD int scan_row(int b, int d, int st) {
    if (st < CTX_LEN) return R_LAT + b * CTX_LEN + (d ? CTX_LEN - 1 - st : st);
    const int t = st - CTX_LEN; return b * SEQ + (d ? SEQ - 1 - t : t);
}

struct FMod { Ptrs p;
    HD void operator()(long i) const {
        const int j = (int)(i % D6); const int bt = (int)((i / D6) % NMOD); const int l = (int)(i / ((long)D6 * NMOD));
        const float* cv = bt < BATCH ? p.c + (size_t)bt * D_MODEL : p.c_ctx;
        const float* w = p.ada_w + (size_t)l * D_MODEL * D6 + j;
        float acc = p.ada_b[(size_t)l * D6 + j];
        for (int k = 0; k < D_MODEL; ++k) acc += siluf_(cv[k]) * w[(size_t)k * D6];
        p.MOD[((size_t)l * NMOD + bt) * D6 + j] = acc;
    } };
struct FCopyX { Ptrs p;
    HD void operator()(long i) const { const size_t n = (size_t)R_LAT * D_MODEL; p.X[i] = (size_t)i < n ? p.x[i] : p.ctx[i - n]; } };
struct FRstd { Ptrs p;
    HD void operator()(long r) const { const float* xr = p.X + (size_t)r * D_MODEL; float s = 0.f; for (int d = 0; d < D_MODEL; ++d) s += xr[d] * xr[d]; p.RSTD[r] = 1.0f / sqrtf(s / D_MODEL + EPS); } };
struct FNormMod { Ptrs p; int l, which;
    HD void operator()(long i) const {
        const int r = (int)(i / D_MODEL), d = (int)(i % D_MODEL); const int bt = row_bt(r);
        const float g = (which ? p.norm2_g : p.norm1_g)[(size_t)l * D_MODEL + d];
        const float sh = modp(p, l, bt, which ? 3 : 0)[d], sc = modp(p, l, bt, which ? 4 : 1)[d];
        stf(p.H, (size_t)i, p.X[i] * p.RSTD[r] * g * (1.0f + sc) + sh);
    } };

struct FNaAttn { Ptrs p; int l; int pad_;
    HD void operator()(long i) const {
        const int r = (int)(i / NA_HEADS), h = (int)(i % NA_HEADS);
        const ZT* zr = p.Z + (size_t)r * ZLD;
        float q[NA_HD], acc[NA_HD];
        float ssq = 0.f;
#pragma unroll
        for (int d = 0; d < NA_HD; ++d) { q[d] = ldf(zr, ZO_NAQ + h * NA_HD + d); ssq += q[d] * q[d]; }
        const float rq = 1.0f / sqrtf(ssq / NA_HD + EPS) * (1.0f / sqrtf((float)NA_HD));
#pragma unroll
        for (int d = 0; d < NA_HD; ++d) { q[d] = q[d] * rq * p.na_q_norm[l * NA_HD + d] * p.na_k_norm[l * NA_HD + d]; acc[d] = 0.f; }
        float m = -INFINITY, ls = 0.f;
        auto key = [&](int kr, float bias) {
            const ZT* zk = p.Z + (size_t)kr * ZLD;
            float dot = 0.f, ks = 0.f;
#pragma unroll
            for (int d = 0; d < NA_HD; ++d) { const float kv = ldf(zk, ZO_NAK + h * NA_HD + d); dot += q[d] * kv; ks += kv * kv; }
            const float s = dot / sqrtf(ks / NA_HD + EPS) + bias;
            const float mn = s > m ? s : m; const float corr = expf(m - mn), pe = expf(s - mn);
            ls = ls * corr + pe;
#pragma unroll
            for (int d = 0; d < NA_HD; ++d) acc[d] = acc[d] * corr + pe * ldf(zk, ZO_NAV + h * NA_HD + d);
            m = mn;
        };
        int b;
        if (r < R_LAT) {
            b = r / SEQ; const int t = r % SEQ, gr = t / GRID_W, gc = t % GRID_W;
            constexpr int n_rows = SEQ / GRID_W; constexpr int win_r = NA_WIN_R_MAX < n_rows ? NA_WIN_R_MAX : n_rows;
            int rs = gr - win_r / 2; rs = rs < 0 ? 0 : (rs > n_rows - win_r ? n_rows - win_r : rs);
            int cs = gc - NA_WIN_C / 2; cs = cs < 0 ? 0 : (cs > GRID_W - NA_WIN_C ? GRID_W - NA_WIN_C : cs);
            const float* rp = p.na_rpb + ((size_t)l * NA_HEADS + h) * (2 * NA_WIN_R_MAX - 1) * (2 * NA_WIN_C - 1);
            for (int n = 0; n < win_r; ++n)
                for (int j = 0; j < NA_WIN_C; ++j)
                    key(b * SEQ + (rs + n) * GRID_W + cs + j, rp[(rs + n - gr + NA_WIN_R_MAX - 1) * (2 * NA_WIN_C - 1) + (cs + j - gc + NA_WIN_C - 1)]);
        } else b = (r - R_LAT) / CTX_LEN;
        for (int c = 0; c < CTX_LEN; ++c) key(R_LAT + b * CTX_LEN + c, 0.f);
        const float inv = 1.0f / ls;
#pragma unroll
        for (int d = 0; d < NA_HD; ++d) stf(p.Y3, (size_t)r * BW + h * NA_HD + d, acc[d] * inv);
    } };

struct FGlaPrep { Ptrs p; int l; int pad_;
    HD void operator()(long i) const {
        const int r = (int)(i / GLA_QK), j = (int)(i % GLA_QK), ii = j % GLA_DK, hb = j - ii;
        const ZT* zr = p.Z + (size_t)r * ZLD;
        const float qs = 1.0f / sqrtf((float)GLA_DK);
        float qv = ldf(zr, ZO_GQ + j) * qs, kv = ldf(zr, ZO_GK + j);
        if (r < R_LAT) {
            constexpr int half = GLA_DK / 2, hh2 = half / 2;
            const int t = r % SEQ; const int sect = ii / half, i2 = ii % half, f = i2 % hh2;
            const float pos = (float)(sect == 0 ? t / GRID_W : t % GRID_W);
            const float ang = pos * powf(10000.0f, -(float)(2 * f) / (float)half);
            const float cs = cosf(ang), sn = sinf(ang);
            const int pj = hb + sect * half + (i2 < hh2 ? i2 + hh2 : i2 - hh2);
            const float qp = ldf(zr, ZO_GQ + pj) * qs, kp = ldf(zr, ZO_GK + pj);
            if (i2 < hh2) { qv = qv * cs - qp * sn; kv = kv * cs - kp * sn; } else { qv = qp * sn + qv * cs; kv = kp * sn + kv * cs; }
        }
        stf(p.GQ, (size_t)i, qv); stf(p.GK, (size_t)i, kv);
        for (int d = 0; d < 2; ++d) {
            float pre = p.gla_gate_b[((size_t)l * 2 + d) * GLA_QK + j];
            for (int k = 0; k < GLA_RANK; ++k) pre += ldf(zr, ZO_GGD + d * GLA_RANK + k) * p.gla_gate_w2[(((size_t)l * 2 + d) * GLA_RANK + k) * GLA_QK + j];
            p.GA[(size_t)d * R_ALL * GLA_QK + i] = expf(-softplusf_(-pre) / GLA_TAU);
        }
    } };
struct FGlaScan { Ptrs p; int l; int pad_;
    HD void operator()(long i) const {
        const int vc = (int)(i % GLA_DV); const int ch = (int)(i / GLA_DV); const int d = ch % 2, hh = (ch / 2) % GLA_HEADS, b = ch / (2 * GLA_HEADS);
        float s[GLA_DK];
#pragma unroll
        for (int k = 0; k < GLA_DK; ++k) s[k] = 0.f;
        const float* ga = p.GA + (size_t)d * R_ALL * GLA_QK;
        RT* gy = p.GY + (size_t)d * R_ALL * GLA_V;
        for (int st = 0; st < CTX_LEN + SEQ; ++st) {
            const int r = scan_row(b, d, st);
            const size_t o = (size_t)r * GLA_QK + hh * GLA_DK;
            const float v = ldf(p.Z, (size_t)r * ZLD + ZO_GV + hh * GLA_DV + vc);
            float y = 0.f;
#pragma unroll
            for (int k = 0; k < GLA_DK; ++k) { s[k] = ga[o + k] * s[k] + ldf(p.GK, o + k) * v; y += ldf(p.GQ, o + k) * s[k]; }
            stf(gy, (size_t)r * GLA_V + hh * GLA_DV + vc, y);
        }
    } };
struct FGlaFinish { Ptrs p; int l; int pad_;
    HD void operator()(long i) const {
        const int r = (int)(i / GLA_HEADS), hh = (int)(i % GLA_HEADS);
        const size_t o = (size_t)r * GLA_V + hh * GLA_DV; const RT* y0 = p.GY + o; const RT* y1 = p.GY + (size_t)R_ALL * GLA_V + o;
        float ss = 0.f; for (int v = 0; v < GLA_DV; ++v) { const float y = ldf(y0, v) + ldf(y1, v); ss += y * y; }
        const float rn = 1.0f / sqrtf(ss / GLA_DV + EPS);
        for (int v = 0; v < GLA_DV; ++v) {
            const float y = (ldf(y0, v) + ldf(y1, v)) * rn * p.gla_norm_g[(size_t)l * GLA_DV + v];
            stf(p.Y3, (size_t)R_ALL * BW + o + v, y * siluf_(ldf(p.Z, (size_t)r * ZLD + ZO_GR + hh * GLA_DV + v)));
        }
    } };

HD float rwz(const Ptrs& p, int l, int r, int col) {
    const size_t o = (size_t)r * ZLD + ZO_RW + col;
    const float z0 = ldf(p.Z, o), zp = row_first(r) ? 0.f : ldf(p.Z, o - ZLD), zn = row_last(r) ? 0.f : ldf(p.Z, o + ZLD);
    return z0 + p.rw_mu[(size_t)l * RW_IN + col] * (0.5f * (zp + zn) - z0);
}
struct FRwLow { Ptrs p; int l; int pad_;
    HD void operator()(long i) const {
        const int r = (int)(i / RW_LOW), q = (int)(i % RW_LOW);
        const float z = rwz(p, l, r, RO_WD + q);
        stf(p.LOW, (size_t)i, q < 2 * RW_DR ? tanhf(z) : (q < 2 * RW_DR + 2 * RW_AR ? z : sigmoidf_(z)));
    } };
struct FRwHead { Ptrs p; int l; int pad_;
    HD void operator()(long i) const {
        const int r = (int)(i / RW_HEADS), h = (int)(i % RW_HEADS);
        float ss = 0.f;
        for (int j = 0; j < RW_HEAD; ++j) { const float k = rwz(p, l, r, RO_K + h * RW_HEAD + j) * p.rw_k_k[(size_t)l * RW_W + h * RW_HEAD + j]; ss += k * k; }
        const float rn = 1.0f / sqrtf(ss + EPS);
        for (int j = 0; j < RW_HEAD; ++j) { const int c = h * RW_HEAD + j;
            stf(p.KK, (size_t)r * RW_W + c, rwz(p, l, r, RO_K + c) * p.rw_k_k[(size_t)l * RW_W + c] * rn);
            stf(p.RS, (size_t)r * RW_W + c, rwz(p, l, r, RO_R + c));
            stf(p.VS, (size_t)r * RW_W + c, rwz(p, l, r, RO_V + c)); }
    } };
struct FRwG { Ptrs p; int l; int pad_;
    HD void operator()(long i) const {
        const int r = (int)(i / RW_W), j = (int)(i % RW_W);
        const RT* lo = p.LOW + (size_t)r * RW_LOW + 2 * RW_DR + 2 * RW_AR; float acc = 0.f;
        for (int q = 0; q < RW_GR; ++q) acc += ldf(lo, q) * p.rw_g2[((size_t)l * RW_GR + q) * RW_W + j];
        stf(p.G, (size_t)i, acc);
    } };
struct FRwDir { Ptrs p; int l, d;
    HD void operator()(long i) const {
        const int r = (int)(i / RW_W), j = (int)(i % RW_W);
        const RT* lo = p.LOW + (size_t)r * RW_LOW;
        float wpre = p.rw_w0[((size_t)l * 2 + d) * RW_W + j];
        for (int q = 0; q < RW_DR; ++q) wpre += ldf(lo, d * RW_DR + q) * p.rw_w2[(((size_t)l * 2 + d) * RW_DR + q) * RW_W + j];
        const float w_log = -softplusf_(-wpre) - 0.5f;
        float apre = p.rw_a0[((size_t)l * 2 + d) * RW_W + j];
        for (int q = 0; q < RW_AR; ++q) apre += ldf(lo, 2 * RW_DR + d * RW_AR + q) * p.rw_a2[(((size_t)l * 2 + d) * RW_AR + q) * RW_W + j];
        const float a = sigmoidf_(apre);
        const float kraw = rwz(p, l, r, RO_K + j);
        const size_t o = (size_t)d * R_ALL * RW_W + i;
        p.DEC[o] = EXPF_(-EXPF_(w_log));
        stf(p.KD, o, kraw * (1.0f + (a - 1.0f) * p.rw_k_a[(size_t)l * RW_W + j]));
        stf(p.BB, o, ldf(p.KK, (size_t)i) * a);
    } };
struct FRwScan { Ptrs p; int l, d;
    HD void operator()(long i) const {
        const int vi = (int)(i % RW_HEAD); const int bh = (int)(i / RW_HEAD); const int h = bh % RW_HEADS, b = bh / RW_HEADS;
        float s[RW_HEAD];
#pragma unroll
        for (int j = 0; j < RW_HEAD; ++j) s[j] = 0.f;
        const size_t od = (size_t)d * R_ALL * RW_W;
        for (int st = 0; st < CTX_LEN + SEQ; ++st) {
            const int r = scan_row(b, d, st);
            const size_t o = (size_t)r * RW_W + h * RW_HEAD;
            const float v = ldf(p.VS, o + vi);
            float sa = 0.f;
#pragma unroll
            for (int j = 0; j < RW_HEAD; ++j) sa += s[j] * ldf(p.KK, o + j);
            float y = 0.f;
#pragma unroll
            for (int j = 0; j < RW_HEAD; ++j) { s[j] = s[j] * p.DEC[od + o + j] - sa * ldf(p.BB, od + o + j) + v * ldf(p.KD, od + o + j); y += s[j] * ldf(p.RS, o + j); }
            stf(p.RY, od + o + vi, y);
        }
    } };
struct FRwFinish { Ptrs p; int l; int pad_;
    HD void operator()(long i) const {
        const int r = (int)(i / RW_HEADS), h = (int)(i % RW_HEADS);
        const size_t o = (size_t)r * RW_W + h * RW_HEAD; const RT* y0 = p.RY + o; const RT* y1 = p.RY + (size_t)R_ALL * RW_W + o;
        float mean = 0.f; for (int j = 0; j < RW_HEAD; ++j) mean += ldf(y0, j) + ldf(y1, j);
        mean /= RW_HEAD;
        float var = 0.f, bonus = 0.f;
        for (int j = 0; j < RW_HEAD; ++j) { const float dv = ldf(y0, j) + ldf(y1, j) - mean; var += dv * dv;
            bonus += ldf(p.RS, o + j) * rwz(p, l, r, RO_K + h * RW_HEAD + j) * p.rw_r_k[((size_t)l * RW_HEADS + h) * RW_HEAD + j]; }
        const float rn = 1.0f / sqrtf(var / RW_HEAD + RW_GN_EPS);
        for (int j = 0; j < RW_HEAD; ++j) { const int c = h * RW_HEAD + j;
            float y = (ldf(y0, j) + ldf(y1, j) - mean) * rn * p.rw_gn_g[(size_t)l * RW_W + c] + p.rw_gn_b[(size_t)l * RW_W + c];
            y += bonus * ldf(p.VS, (size_t)r * RW_W + c);
            stf(p.Y3, (size_t)2 * R_ALL * BW + (size_t)r * BW + c, y * ldf(p.G, (size_t)r * RW_W + c)); }
    } };

HD void route_select(const float (&lg)[N_EXPERTS], const float* router_bias, int& i1, int& i2, float& s1, float& s2) {
        float s[N_EXPERTS], bz[N_EXPERTS];
#pragma unroll
        for (int e = 0; e < N_EXPERTS; ++e) { s[e] = sigmoidf_(lg[e]); bz[e] = s[e] + router_bias[e]; }
        int gsel = 0; float gbest = -INFINITY;
#pragma unroll
        for (int gi = 0; gi < N_GROUPS; ++gi) {
            float m1 = -INFINITY, m2 = -INFINITY;
#pragma unroll
            for (int k = 0; k < EPG; ++k) { const float v = bz[gi * EPG + k]; if (v > m1) { m2 = m1; m1 = v; } else if (v > m2) m2 = v; }
            const float sc2 = m1 + m2; if (sc2 > gbest) { gbest = sc2; gsel = gi; }
        }
        int a1 = 0, a2 = 0; float t1 = 0.f, t2 = 0.f, v1 = -INFINITY, v2 = -INFINITY;
#pragma unroll
        for (int e = 0; e < N_EXPERTS; ++e) { const float v = (e / EPG == gsel) ? bz[e] : -INFINITY; const bool g1 = v > v1, g2 = v > v2;
            v2 = g1 ? v1 : (g2 ? v : v2); a2 = g1 ? a1 : (g2 ? e : a2); t2 = g1 ? t1 : (g2 ? s[e] : t2);
            v1 = g1 ? v : v1; a1 = g1 ? e : a1; t1 = g1 ? s[e] : t1; }
        i1 = a1; i2 = a2; s1 = t1; s2 = t2;
}
struct FRouter { Ptrs p; int l; int pad_;
    HD void operator()(long r) const {
        const int bt = row_bt((int)r); const float* xr = p.X + (size_t)r * D_MODEL; const float rstd = p.RSTD[r];
        const float* sh = modp(p, l, bt, 3); const float* sc = modp(p, l, bt, 4); const float* g = p.norm2_g + (size_t)l * D_MODEL;
        float lg[N_EXPERTS];
#pragma unroll
        for (int e = 0; e < N_EXPERTS; ++e) lg[e] = 0.f;
        for (int d = 0; d < D_MODEL; ++d) { const float h = xr[d] * rstd * g[d] * (1.0f + sc[d]) + sh[d]; const float* w = p.router_w + (size_t)d * N_EXPERTS;
#pragma unroll
            for (int e = 0; e < N_EXPERTS; ++e) lg[e] += h * w[e]; }
        int i1, i2; float s1, s2; route_select(lg, p.router_bias, i1, i2, s1, s2);
        const float inv = 1.0f / (s1 + s2);
        p.SELI[2 * r] = i1; p.SELI[2 * r + 1] = i2; p.SELW[2 * r] = s1 * inv; p.SELW[2 * r + 1] = s2 * inv;
    } };
struct FMoeUp { Ptrs p; int l; int pad_;
    HD void operator()(long i) const {
        const int j = (int)(i % D_EXPERT), k = (int)((i / D_EXPERT) % 2), r = (int)(i / (2 * D_EXPERT));
        const int e = p.SELI[2 * r + k];
        const size_t wo = ((size_t)l * N_EXPERTS + e) * D_MODEL * D_EXPERT + j;
        const float* wg = p.moe_w_gate + wo; const float* wu = p.moe_w_up + wo; const AT* h = p.H + (size_t)r * D_MODEL;
        float g = 0.f, u = 0.f;
        for (int d = 0; d < D_MODEL; ++d) { const float hv = ldf(h, d); g += hv * wg[(size_t)d * D_EXPERT]; u += hv * wu[(size_t)d * D_EXPERT]; }
        p.ACT[i] = siluf_(g) * u * p.SELW[2 * r + k];
    } };
struct FMoeDown { Ptrs p; int l; int pad_;
    HD void operator()(long i) const {
        const int r = (int)(i / D_MODEL), d = (int)(i % D_MODEL);
        float acc = 0.f;
        for (int k = 0; k < 2; ++k) { const int e = p.SELI[2 * r + k];
            const float* wd = p.moe_w_down + ((size_t)l * N_EXPERTS + e) * D_EXPERT * D_MODEL + d; const float* a = p.ACT + ((size_t)r * 2 + k) * D_EXPERT;
            for (int j = 0; j < D_EXPERT; ++j) acc += a[j] * wd[(size_t)j * D_MODEL]; }
        p.X[i] += modp(p, l, row_bt(r), 5)[d] * acc;
    } };
struct FOut { Ptrs p; HD void operator()(long i) const { p.out[i] = p.X[i]; } };

struct GIn { Ptrs p; int l; int M, N, K;
    HD float a(int m, int k) const { return ldf(p.H, (size_t)m * D_MODEL + k); }
    HD float b(int k, int n) const { return p.w_in[((size_t)l * D_MODEL + k) * D_IN + n]; }
    HD void epi(int m, int n, float acc) const { stf(p.Z, (size_t)m * ZLD + n, acc); } };
struct GBranch { Ptrs p; int l, br; int M, N, K; int pad_;
    HD float a(int m, int k) const { return ldf(p.Y3, ((size_t)br * R_ALL + m) * BW + k); }
    HD float b(int k, int n) const { return p.w_branch[(((size_t)l * 3 + br) * BW + k) * D_MODEL + n]; }
    HD void epi(int m, int n, float acc) const { const float g = sigmoidf_(ldf(p.Z, (size_t)m * ZLD + ZO_GATE + br * D_MODEL + n)); float* o = p.MF + (size_t)m * D_MODEL + n; *o = (br ? *o : 0.f) + g * acc; } };
struct GOut { Ptrs p; int l; int M, N, K;
    HD float a(int m, int k) const { return p.MF[(size_t)m * D_MODEL + k]; }
    HD float b(int k, int n) const { return p.w_out[((size_t)l * D_MODEL + k) * D_MODEL + n]; }
    HD void epi(int m, int n, float acc) const { p.X[(size_t)m * D_MODEL + n] += modp(p, l, row_bt(m), 2)[n] * acc; } };

static_assert(sizeof(FNaAttn) % 8 == 0 && sizeof(GBranch) % 8 == 0 && sizeof(FRwDir) % 8 == 0 && sizeof(GIn) % 8 == 0 && sizeof(FMod) % 8 == 0, "no tail padding in by-value kernel arguments");
struct WsMap { size_t total; };
inline size_t ws_carve(Ptrs& p, char* base) {
    size_t off = 0;
    auto take = [&](size_t bytes) { char* q = base ? base + off : nullptr; off += (bytes + 255) & ~(size_t)255; return q; };
    p.BAR = (unsigned*)take(BAR_BYTES);
    p.MOD = (float*)take((size_t)DEPTH * NMOD * D6 * 4);
    p.WT_IN = (bf16_t*)take((size_t)ZLD * D_MODEL * 2); p.WT_BR = (bf16_t*)take((size_t)3 * D_MODEL * BW * 2); p.WT_OUT = (bf16_t*)take((size_t)D_MODEL * D_MODEL * 2);
    p.WT_RW = (bf16_t*)take((size_t)5 * RW_W * RW_LOW * 2); p.ROPE = (float*)take((size_t)GRID_W * (GLA_DK / 4) * 2 * 4);
    p.X = (float*)take((size_t)R_ALL * D_MODEL * 4);
    p.RSTD = (float*)take((size_t)R_ALL * 4);
    p.H = (AT*)take((size_t)R_ALL * D_MODEL * sizeof(AT)); p.MB = (bf16_t*)p.H;
    p.Z = (ZT*)take((size_t)R_ALL * ZLD * sizeof(ZT));
    p.Y3 = (AT*)take((size_t)3 * R_ALL * BW * sizeof(AT));
    const size_t u0 = off;
    p.GQ = (RT*)take((size_t)R_ALL * GLA_QK * sizeof(RT)); p.GK = (RT*)take((size_t)R_ALL * GLA_QK * sizeof(RT)); p.GA = (float*)take((size_t)2 * R_ALL * GLA_QK * 4);
#ifdef CPU_TEST
    p.GY = (RT*)take((size_t)2 * R_ALL * GLA_V * sizeof(RT));
#else
    static_assert(2 * GLA_V * sizeof(RT) <= 2 * GLA_QK * 4, "GY fits over GA"); p.GY = (RT*)p.GA;
#endif
    p.QH = (bf16_t*)take((size_t)2 * R_ALL * GLA_QK * 2); p.KP = (bf16_t*)take((size_t)2 * R_ALL * GLA_QK * 2); p.KPT = (bf16_t*)take((size_t)2 * R_ALL * GLA_QK * 2);
    p.VTG = (bf16_t*)take((size_t)BATCH * GLA_V * (SEQ + CTX_LEN) * 2); p.DL = (float*)take((size_t)2 * (R_ALL / 64) * GLA_QK * 4);
    p.QN = (bf16_t*)take((size_t)R_ALL * NA_W * 2); p.KN = (bf16_t*)take((size_t)R_ALL * NA_W * 2); p.VTN = (bf16_t*)take((size_t)BATCH * NA_HEADS * NA_HD * (SEQ + CTX_LEN) * 2);
    p.LOW = (RT*)take((size_t)R_ALL * (RW_LOW > 768 ? RW_LOW : 768) * sizeof(RT));
    p.KK = (RT*)take((size_t)R_ALL * RW_W * sizeof(RT)); p.RS = (RT*)take((size_t)R_ALL * RW_W * sizeof(RT)); p.VS = (RT*)take((size_t)R_ALL * RW_W * sizeof(RT));
    p.G = (RT*)take((size_t)R_ALL * RW_W * sizeof(RT)); p.KS = (RT*)take((size_t)R_ALL * RW_W * sizeof(RT));
    p.DEC = (float*)take((size_t)2 * R_ALL * RW_W * 4); p.KD = (RT*)take((size_t)2 * R_ALL * RW_W * sizeof(RT)); p.BB = (RT*)take((size_t)2 * R_ALL * RW_W * sizeof(RT));
    p.RY = (RT*)take((size_t)2 * R_ALL * RW_W * sizeof(RT));
    const size_t u1 = off; off = u0;
    p.MF = (float*)take((size_t)R_ALL * D_MODEL * 4);
    p.SELI = (int*)take((size_t)R_ALL * 2 * 4); p.SELW = (float*)take((size_t)R_ALL * 2 * 4);
    p.ACT = (float*)take((size_t)R_ALL * 2 * D_EXPERT * 4);
    p.WGU = (bf16_t*)take((size_t)N_EXPERTS * 2 * D_EXPERT * D_MODEL * 2); p.WD = (bf16_t*)take((size_t)N_EXPERTS * D_MODEL * D_EXPERT * 2);
    p.HS = (bf16_t*)take((size_t)MOE_ROWS * D_MODEL * 2); p.ACTB = (bf16_t*)take((size_t)MOE_ROWS * D_EXPERT * 2);
    p.YK = (bf16_t*)take((size_t)2 * R_ALL * D_MODEL * 2);
    p.POS = (int*)take((size_t)R_ALL * 2 * 4); p.ROWTOK = (int*)take((size_t)MOE_ROWS * 4); p.TILE_E = (int*)take((size_t)(MOE_TILES + 1) * 4); p.ROWW = (float*)take((size_t)MOE_ROWS * 4);
    if (off < u1) off = u1;
    return off;
}

template <class Exec> void run_forward(Exec& ex, const Ptrs& p) {
    ex.items(FMod{p}, (long)DEPTH * NMOD * D6);
    ex.items(FCopyX{p}, (long)R_ALL * D_MODEL);
    for (int l = 0; l < DEPTH; ++l) {
        const int ro = rows_out(l);
        ex.items(FRstd{p}, R_ALL);
        ex.items(FNormMod{p, l, 0}, (long)R_ALL * D_MODEL);
        ex.gemm(GIn{p, l, R_ALL, D_IN, D_MODEL});
        ex.items(FNaAttn{p, l}, (long)ro * NA_HEADS);
        ex.items(FGlaPrep{p, l}, (long)R_ALL * GLA_QK);
        ex.items(FGlaScan{p, l}, (long)BATCH * GLA_HEADS * 2 * GLA_DV);
        ex.items(FGlaFinish{p, l}, (long)ro * GLA_HEADS);
        ex.items(FRwLow{p, l}, (long)R_ALL * RW_LOW);
        ex.items(FRwHead{p, l}, (long)R_ALL * RW_HEADS);
        ex.items(FRwG{p, l}, (long)R_ALL * RW_W);
        for (int d = 0; d < 2; ++d) ex.items(FRwDir{p, l, d}, (long)R_ALL * RW_W);
        for (int d = 0; d < 2; ++d) ex.items(FRwScan{p, l, d}, (long)BATCH * RW_HEADS * RW_HEAD);
        ex.items(FRwFinish{p, l}, (long)ro * RW_HEADS);
        ex.mark(l, 0);
        for (int br = 0; br < 3; ++br) ex.gemm(GBranch{p, l, br, ro, D_MODEL, BW});
        ex.gemm(GOut{p, l, ro, D_MODEL, D_MODEL});
        ex.mark(l, 1);
        ex.items(FRstd{p}, ro);
        ex.items(FRouter{p, l}, ro);
        ex.items(FNormMod{p, l, 1}, (long)ro * D_MODEL);
        ex.items(FMoeUp{p, l}, (long)ro * 2 * D_EXPERT);
        ex.items(FMoeDown{p, l}, (long)ro * D_MODEL);
        ex.mark(l, 2);
    }
    ex.items(FOut{p}, (long)R_LAT * D_MODEL);
}

inline void fill_inputs(Ptrs& p, void* const* d_in) {
    const float** f = (const float**)d_in;
    p.x = f[0]; p.c = f[1]; p.ctx = f[2]; p.c_ctx = f[3]; p.ada_w = f[4]; p.ada_b = f[5]; p.norm1_g = f[6]; p.norm2_g = f[7]; p.w_in = f[8];
    p.na_q_norm = f[9]; p.na_k_norm = f[10]; p.na_rpb = f[11]; p.gla_gate_w2 = f[12]; p.gla_gate_b = f[13]; p.gla_norm_g = f[14];
    p.rw_mu = f[15]; p.rw_w0 = f[16]; p.rw_w2 = f[17]; p.rw_a0 = f[18]; p.rw_a2 = f[19]; p.rw_g2 = f[20]; p.rw_k_k = f[21]; p.rw_k_a = f[22]; p.rw_r_k = f[23];
    p.rw_gn_g = f[24]; p.rw_gn_b = f[25]; p.w_branch = f[26]; p.w_out = f[27]; p.router_w = f[28]; p.router_bias = f[29];
    p.moe_w_gate = f[30]; p.moe_w_up = f[31]; p.moe_w_down = f[32];
}

#ifndef CPU_TEST
namespace pg8 {
#define PG8_LAS __attribute__((address_space(3)))
typedef unsigned short bf16_t;
typedef short bf16x8 __attribute__((ext_vector_type(8)));
typedef float f32x4 __attribute__((ext_vector_type(4)));
typedef unsigned u32x4 __attribute__((ext_vector_type(4)));
constexpr int BM = 256, BK = 64, HALF = 128, HTB = HALF * BK * 2  , STAGE_BYTES = 8 * HTB, NXCD = 8, WGM = 4;

__host__ __device__ __forceinline__ int lds_byte(int r, int c) { const int st = (r >> 4) * 2 + (c >> 5), rr = r & 15, cc = c & 31, ob = rr * 64 + cc * 2; return st * 1024 + (ob ^ (((ob >> 9) & 1) << 5)); }
__host__ __device__ __forceinline__ void stage_rc(int b, int& R, int& C) { const int st = b / 1024, sb = b % 1024, swz = sb ^ (((sb >> 9) & 1) << 5); R = (st >> 1) * 16 + swz / 64; C = (st & 1) * 32 + (swz % 64) / 2; }
__host__ __device__ __forceinline__ int perm32(int rho) { const int n = rho >> 4, i = rho & 15; return 8 * (i >> 2) + 4 * n + (i & 3); }

struct Unit { int pm, pn; };
struct Gemm { const bf16_t* A; const bf16_t* Bt; int M, N, K; };

struct StaticOrder {
    int nM, nN, nwg, G, c;
    __host__ __device__ void init(int M, int N, int G_, int c_) { nM = M / BM; nN = N / BM; nwg = nM * nN; G = G_; c = c_; }
    __host__ __device__ bool next(int i, Unit& u) const {
        const long L = (long)i * G + c; if (L >= nwg) return false;
        int wgid = (int)L; { const int q = nwg / NXCD, r = nwg % NXCD, xcd = wgid % NXCD, off = wgid / NXCD; wgid = (xcd < r ? xcd * (q + 1) : r * (q + 1) + (xcd - r) * q) + off; }
        const int nig = WGM * nN, gid = wgid / nig, fm = gid * WGM, gsz = (nM - fm) < WGM ? (nM - fm) : WGM;
        u.pm = fm + ((wgid % nig) % gsz); u.pn = (wgid % nig) / gsz; return true;
    }
    __device__ __forceinline__ void a_ready(const Unit&) const {}
    __device__ __forceinline__ void done(const Unit&) const {}
};

__device__ __forceinline__ unsigned cvt_pk_bf16(float lo, float hi) { unsigned r; asm volatile("v_cvt_pk_bf16_f32 %0, %1, %2" : "=v"(r) : "v"(lo), "v"(hi)); return r; }
template <class Epi, class Sched, bool ALIGN_EPI = false, bool SP2 = false, bool GATHER = false>
__device__ __forceinline__ void gemm_phase(PG8_LAS unsigned char* lds, const Gemm g, const Sched& S, const Epi& E, const int wv  , const int* arow = nullptr) {
    static_assert(!GATHER || SP2, "gathered A rows: SP2 loop only");
    int tid_; asm volatile("v_mbcnt_lo_u32_b32 %0, -1, 0\n\tv_mbcnt_hi_u32_b32 %0, -1, %0" : "=v"(tid_)); tid_ += wv * 64;
    const int tid = tid_, wid = __builtin_amdgcn_readfirstlane(tid >> 6), lane = tid & 63, wr = wid >> 2, wc = wid & 3, fr = lane & 15, fq = lane >> 4;
    const int K = g.K, nt = K / BK;
    unsigned voffA[2], voffB[2];
#pragma unroll
    for (int i = 0; i < 2; ++i) { int R, C; stage_rc(tid * 16 + i * 8192, R, C); const int Rb = Epi::PERM ? ((R & ~31) + perm32(R & 31)) : R;
        voffA[i] = (unsigned)(R * K + C) * 2u; voffB[i] = (unsigned)(Rb * K + C) * 2u; }
    unsigned gvA[2][2][2];
    if constexpr (GATHER) {
#pragma unroll
        for (int u = 0; u < 2; ++u) { Unit uu; const bool have = S.next(u, uu);
#pragma unroll
            for (int h = 0; h < 2; ++h)
#pragma unroll
                for (int i = 0; i < 2; ++i) { int R, C; stage_rc(tid * 16 + i * 8192, R, C);
                    int tok = have ? arow[uu.pm * 256 + h * HALF + R] : 0; tok = tok < 0 ? 0 : tok >> 1;
                    gvA[u][h][i] = (unsigned)(tok * K + C) * 2u; } }
    }
    const size_t kstep = (size_t)(BK * 2);
    const size_t hstep = (size_t)HALF * K * 2;
    const size_t tstep = 2 * hstep;
    const unsigned ldsw = (unsigned)wid * 1024u;
    const int aoff = lds_byte(wr * 64 + fr, fq * 8), boff = lds_byte(wc * 32 + fr, fq * 8);
#define PG8_SA(b, h) (((b) * 2 + (h)) * HTB)
#define PG8_SB(b, h) ((4 + (b) * 2 + (h)) * HTB)
#define PG8_STAGE(bufoff, gbase, voff) do { _Pragma("unroll") for (int _i = 0; _i < 2; ++_i) \
        __builtin_amdgcn_global_load_lds((const unsigned*)((const char*)(gbase) + (voff)[_i]), (PG8_LAS unsigned*)(lds + (bufoff) + ldsw + _i * 8192), 16, 0, 0); } while (0)
#define PG8_LDA(dst, b, h) do { _Pragma("unroll") for (int m = 0; m < 4; ++m) _Pragma("unroll") for (int k = 0; k < 2; ++k) dst[m][k] = *(const PG8_LAS bf16x8*)(lds + PG8_SA(b, h) + aoff + m * 2048 + k * 1024); } while (0)
#define PG8_LDB(dst, b, h) do { _Pragma("unroll") for (int n = 0; n < 2; ++n) _Pragma("unroll") for (int k = 0; k < 2; ++k) dst[n][k] = *(const PG8_LAS bf16x8*)(lds + PG8_SB(b, h) + boff + n * 2048 + k * 1024); } while (0)
#define PG8_MMA(ai, bj, At, Bt) do { __builtin_amdgcn_s_setprio(1); _Pragma("unroll") for (int m = 0; m < 4; ++m) _Pragma("unroll") for (int n = 0; n < 2; ++n) _Pragma("unroll") for (int k = 0; k < 2; ++k) \
        acc[ai][bj][m][n] = __builtin_amdgcn_mfma_f32_16x16x32_bf16(Bt[n][k], At[m][k], acc[ai][bj][m][n], 0, 0, 0); __builtin_amdgcn_s_setprio(0); } while (0)
#define PG8_WAIT_V(n) asm volatile("s_waitcnt vmcnt(" #n ")" ::: "memory")
#define PG8_WAIT_L(n) asm volatile("s_waitcnt lgkmcnt(" #n ")" ::: "memory")
#define PG8_BAR __builtin_amdgcn_s_barrier()
#define PG8_SCHED __builtin_amdgcn_sched_barrier(0)
    Unit cur, nxt; int ui = 0;
    if (!S.next(0, cur)) return;
    f32x4 acc[2][2][4][2];
#pragma unroll
    for (int a = 0; a < 2; ++a)
#pragma unroll
        for (int b = 0; b < 2; ++b)
#pragma unroll
            for (int m = 0; m < 4; ++m)
#pragma unroll
                for (int n = 0; n < 2; ++n) acc[a][b][m][n] = (f32x4){0.f, 0.f, 0.f, 0.f};
    bf16x8 At[4][2], B0[2][2], B1[2][2];
    const char* cA = (const char*)g.A + (GATHER ? (size_t)0 : (size_t)cur.pm * tstep); const char* cB = (const char*)g.Bt + (size_t)cur.pn * tstep;
    const size_t hstepA = GATHER ? (size_t)0 : hstep;
    unsigned gc[2][2], gn[2][2];
#pragma unroll
    for (int h = 0; h < 2; ++h)
#pragma unroll
        for (int i = 0; i < 2; ++i) { gc[h][i] = GATHER ? gvA[0][h][i] : voffA[i]; gn[h][i] = GATHER ? gvA[1][h][i] : voffA[i]; }
    S.a_ready(cur);
    if constexpr (SP2) {
        PG8_STAGE(PG8_SB(0, 0), cB, voffB); PG8_STAGE(PG8_SB(0, 1), cB + hstep, voffB); PG8_STAGE(PG8_SA(0, 0), cA, gc[0]); PG8_STAGE(PG8_SA(0, 1), cA + hstepA, gc[1]);
        if (wr == 1) PG8_BAR;
        PG8_WAIT_V(2); PG8_BAR;
        PG8_STAGE(PG8_SB(1, 0), cB + kstep, voffB); PG8_STAGE(PG8_SA(1, 0), cA + kstep, gc[0]); PG8_STAGE(PG8_SB(1, 1), cB + hstep + kstep, voffB);
        PG8_WAIT_V(6); PG8_BAR;
    } else {
        PG8_STAGE(PG8_SB(0, 0), cB, voffB); PG8_STAGE(PG8_SA(0, 0), cA, voffA); PG8_STAGE(PG8_SB(0, 1), cB + hstep, voffB); PG8_STAGE(PG8_SA(0, 1), cA + hstep, voffA);
        if (wr == 1) PG8_BAR;
        PG8_WAIT_V(4); PG8_BAR;
        PG8_STAGE(PG8_SB(1, 0), cB + kstep, voffB); PG8_STAGE(PG8_SA(1, 0), cA + kstep, voffA); PG8_STAGE(PG8_SB(1, 1), cB + hstep + kstep, voffB);
        PG8_WAIT_V(6); PG8_BAR;
    }
    for (;;) {
        const bool has_next = S.next(ui + 1, nxt);
        const char* nA = (has_next && !GATHER) ? (const char*)g.A + (size_t)nxt.pm * tstep : cA; const char* nB = has_next ? (const char*)g.Bt + (size_t)nxt.pn * tstep : cB;
        if constexpr (GATHER) { if (!has_next) {
#pragma unroll
            for (int h = 0; h < 2; ++h)
#pragma unroll
                for (int i = 0; i < 2; ++i) gn[h][i] = gc[h][i]; } }
        for (int t = 0; t < nt; t += 2) {
            const bool last = (t == nt - 2);
            const char* a1 = cA + (size_t)(t + 1) * kstep;
            const char* a2 = last ? nA : cA + (size_t)(t + 2) * kstep; const char* b2 = last ? nB : cB + (size_t)(t + 2) * kstep;
            const char* a3 = a2 + kstep; const char* b3 = b2 + kstep;
            if (last && has_next) S.a_ready(nxt);
            if constexpr (SP2) {
            unsigned g2[2][2];
#pragma unroll
            for (int h = 0; h < 2; ++h)
#pragma unroll
                for (int i = 0; i < 2; ++i) g2[h][i] = last ? gn[h][i] : gc[h][i];
            PG8_LDB(B0, 0, 0); PG8_LDB(B1, 0, 1); PG8_SCHED; PG8_LDA(At, 0, 0); PG8_STAGE(PG8_SA(1, 1), a1 + hstepA, gc[1]);
            PG8_WAIT_V(8); PG8_WAIT_L(0); PG8_BAR; PG8_MMA(0, 0, At, B0); PG8_MMA(0, 1, At, B1); PG8_BAR; PG8_SCHED;
            PG8_LDA(At, 0, 1); PG8_STAGE(PG8_SB(0, 0), b2, voffB); PG8_STAGE(PG8_SB(0, 1), b2 + hstep, voffB); PG8_STAGE(PG8_SA(0, 0), a2, g2[0]);
            PG8_WAIT_V(8); PG8_WAIT_L(0); PG8_BAR; PG8_MMA(1, 0, At, B0); PG8_MMA(1, 1, At, B1); PG8_BAR; PG8_SCHED;
            PG8_LDB(B0, 1, 0); PG8_LDB(B1, 1, 1); PG8_SCHED; PG8_LDA(At, 1, 0); PG8_STAGE(PG8_SA(0, 1), a2 + hstepA, g2[1]);
            PG8_WAIT_V(8); PG8_WAIT_L(0); PG8_BAR; PG8_MMA(0, 0, At, B0); PG8_MMA(0, 1, At, B1); PG8_BAR; PG8_SCHED;
            PG8_LDA(At, 1, 1); PG8_STAGE(PG8_SB(1, 0), b3, voffB); PG8_STAGE(PG8_SB(1, 1), b3 + hstep, voffB); PG8_STAGE(PG8_SA(1, 0), a3, g2[0]);
            PG8_WAIT_V(8); PG8_WAIT_L(0); PG8_BAR; PG8_MMA(1, 0, At, B0); PG8_MMA(1, 1, At, B1); PG8_BAR; PG8_SCHED;
            } else {
            PG8_LDB(B0, 0, 0); PG8_SCHED; PG8_LDA(At, 0, 0); PG8_STAGE(PG8_SA(1, 1), a1 + hstep, voffA);
            PG8_WAIT_L(8); PG8_BAR; PG8_WAIT_L(0); PG8_MMA(0, 0, At, B0); PG8_BAR; PG8_SCHED;
            PG8_LDB(B1, 0, 1); PG8_STAGE(PG8_SB(0, 0), b2, voffB);
            PG8_BAR; PG8_WAIT_L(0); PG8_MMA(0, 1, At, B1); PG8_BAR;
            PG8_LDA(At, 0, 1); PG8_STAGE(PG8_SA(0, 0), a2, voffA);
            PG8_BAR; PG8_WAIT_L(0); PG8_MMA(1, 0, At, B0); PG8_BAR; PG8_SCHED;
            PG8_STAGE(PG8_SB(0, 1), b2 + hstep, voffB);
            PG8_WAIT_V(6); PG8_BAR; PG8_MMA(1, 1, At, B1); PG8_BAR;
            PG8_LDB(B0, 1, 0); PG8_SCHED; PG8_LDA(At, 1, 0); PG8_STAGE(PG8_SA(0, 1), a2 + hstep, voffA);
            PG8_WAIT_L(8); PG8_BAR; PG8_WAIT_L(0); PG8_MMA(0, 0, At, B0); PG8_BAR; PG8_SCHED;
            PG8_LDB(B1, 1, 1); PG8_STAGE(PG8_SB(1, 0), b3, voffB);
            PG8_BAR; PG8_WAIT_L(0); PG8_MMA(0, 1, At, B1); PG8_BAR;
            PG8_LDA(At, 1, 1); PG8_STAGE(PG8_SA(1, 0), a3, voffA);
            PG8_BAR; PG8_WAIT_L(0); PG8_MMA(1, 0, At, B0); PG8_BAR; PG8_SCHED;
            PG8_STAGE(PG8_SB(1, 1), b3 + hstep, voffB);
            PG8_WAIT_V(6); PG8_BAR; PG8_MMA(1, 1, At, B1); PG8_BAR;
            }
        }
        if constexpr (ALIGN_EPI) { if (wr == 0) PG8_BAR; }
        if constexpr (Epi::CARRY) { E.carry(acc, cur, wr, wc, fr, fq); S.done(cur); }
        else if constexpr (!Epi::AFTER_DRAIN) { E(acc, cur, wr, wc, fr, fq); S.done(cur); }
        if (!has_next) break;
        if constexpr (!Epi::CARRY) {
#pragma unroll
        for (int a = 0; a < 2; ++a)
#pragma unroll
            for (int b = 0; b < 2; ++b)
#pragma unroll
                for (int m = 0; m < 4; ++m)
#pragma unroll
                    for (int n = 0; n < 2; ++n) acc[a][b][m][n] = (f32x4){0.f, 0.f, 0.f, 0.f};
        }
        cur = nxt; cA = nA; cB = nB; ++ui;
#pragma unroll
        for (int h = 0; h < 2; ++h)
#pragma unroll
            for (int i = 0; i < 2; ++i) gc[h][i] = gn[h][i];
        if constexpr (ALIGN_EPI) { if (wr == 1) PG8_BAR; }
    }
    PG8_WAIT_V(0);
    if constexpr (!ALIGN_EPI) { if (wr == 0) PG8_BAR; }
    PG8_BAR;
    if constexpr (Epi::AFTER_DRAIN) { E.fused(acc, cur, wr, wc, fr, fq, lds, wid, lane); S.done(cur); }
#undef PG8_SA
#undef PG8_SB
#undef PG8_STAGE
#undef PG8_LDA
#undef PG8_LDB
#undef PG8_MMA
#undef PG8_WAIT_V
#undef PG8_WAIT_L
#undef PG8_BAR
#undef PG8_SCHED
}
}
#define XB_TMO      128
#define XB_XCNT(j)  (256  + 64 * (j))
#define XB_XSUB(j)  (1280 + 64 * (j))
#define XB_XGEN(j)  (2304 + 64 * (j))
#define XB_TOP      3328
#define XB_TOPGEN   3392
#define XCD_BAR_WORDS 3456
#define XB_SPIN_CAP (1u << 18)
#define LAS __attribute__((address_space(3)))

__device__ __forceinline__ unsigned xb_ld(unsigned* p)              { return __hip_atomic_load(p, __ATOMIC_RELAXED, __HIP_MEMORY_SCOPE_AGENT); }
__device__ __forceinline__ unsigned xb_add(unsigned* p, unsigned v) { return __hip_atomic_fetch_add(p, v, __ATOMIC_RELAXED, __HIP_MEMORY_SCOPE_AGENT); }
__device__ __forceinline__ unsigned xb_xcc_id() { return (unsigned)__builtin_amdgcn_s_getreg((3 << 11) | 20) & 0xFu; }
#define XB_SPIN(cond, bar) do { unsigned _sp = 0; while (cond) { __builtin_amdgcn_s_sleep(1); \
    if ((++_sp & 255u) == 0u) { if (xb_ld(&(bar)[XB_TMO])) break; if (_sp > XB_SPIN_CAP) { atomicAdd(&(bar)[XB_TMO], 1u); break; } } } } while (0)

struct XcdBarrier {
    unsigned* bar; unsigned x; int wv;
    volatile LAS unsigned* st;
};

__device__ __forceinline__ XcdBarrier xcd_barrier_post(unsigned* bar, volatile LAS unsigned* st) {
    XcdBarrier b; b.bar = bar; b.x = xb_xcc_id(); b.st = st; b.wv = __builtin_amdgcn_readfirstlane(threadIdx.x >> 6);
    if (threadIdx.x == 0) (void)xb_add(&bar[XB_XCNT(b.x)], 1u);
    return b;
}
__device__ __forceinline__ void xcd_barrier_complete(unsigned* bar, unsigned x, unsigned& nloc, unsigned& nx) {
    const unsigned G = gridDim.x * gridDim.y * gridDim.z;
    unsigned sum, cnt, mine, sp = 0u;
    for (;;) {
        sum = 0u; cnt = 0u; mine = 0u;
#pragma unroll
        for (unsigned j = 0; j < 16; ++j) { const unsigned c = xb_ld(&bar[XB_XCNT(j)]); sum += c; cnt += (c > 0u) ? 1u : 0u; mine = (j == x) ? c : mine; }
        if (sum == G) break;
        __builtin_amdgcn_s_sleep(1);
        if ((++sp & 255u) == 0u) { if (xb_ld(&bar[XB_TMO])) break; if (sp > XB_SPIN_CAP) { atomicAdd(&bar[XB_TMO], 1u); break; } }
    }
    nloc = mine > 0u ? mine : 1u; nx = cnt > 0u ? cnt : 1u;
}

__device__ __forceinline__ void xcd_barrier(const XcdBarrier& b) {
    asm volatile("s_waitcnt vmcnt(0)" ::: "memory");
    __syncthreads();
    int xb_lane; asm volatile("v_mbcnt_lo_u32_b32 %0, -1, 0\n\tv_mbcnt_hi_u32_b32 %0, -1, %0" : "=v"(xb_lane));
    if (b.wv == 0 && xb_lane == 0) {
        unsigned* bar = b.bar;
        __builtin_amdgcn_s_waitcnt(0);
        unsigned nloc = b.st[0], nx = b.st[1];
        if (nloc == 0u) { xcd_barrier_complete(bar, b.x, nloc, nx); b.st[0] = nloc; b.st[1] = nx; }
        const unsigned old = xb_add(&bar[XB_XSUB(b.x)], 1u);
        const unsigned gen = old / nloc;
        if (old + 1u == (gen + 1u) * nloc) {
            __builtin_amdgcn_fence(__ATOMIC_RELEASE, "agent");
            asm volatile("s_waitcnt vmcnt(0)" ::: "memory");
            const unsigned og = xb_add(&bar[XB_TOP], 1u);
            const unsigned tg = og / nx;
            if (og + 1u == (tg + 1u) * nx) xb_add(&bar[XB_TOPGEN], 1u);
            else XB_SPIN(xb_ld(&bar[XB_TOPGEN]) == tg, bar);
            __builtin_amdgcn_fence(__ATOMIC_ACQUIRE, "agent");
            xb_add(&bar[XB_XGEN(b.x)], 1u);
            asm volatile("s_waitcnt vmcnt(0)" ::: "memory");
        } else {
            XB_SPIN(xb_ld(&bar[XB_XGEN(b.x)]) == gen, bar);
            __builtin_amdgcn_fence(__ATOMIC_ACQUIRE, "agent");
            asm volatile("s_waitcnt vmcnt(0)" ::: "memory");
        }
    }
    __syncthreads();
}

constexpr int MEGA_THREADS = 512;
constexpr int CONV_EARLY = 1024;
constexpr int NA_SPLIT = 2048;
constexpr int LDS_BYTES = pg8::STAGE_BYTES + 16;
typedef float f32x4 __attribute__((ext_vector_type(4)));
typedef unsigned u32x4 __attribute__((ext_vector_type(4)));
typedef unsigned u32x2 __attribute__((ext_vector_type(2)));

__device__ __forceinline__ int opaque_lane() { int l; asm volatile("v_mbcnt_lo_u32_b32 %0, -1, 0\n\tv_mbcnt_hi_u32_b32 %0, -1, %0" : "=v"(l)); return l; }
__device__ __forceinline__ int opaque_tid(int wv) { return wv * 64 + opaque_lane(); }
__device__ __forceinline__ int opaque_grid() { int g = gridDim.x; asm volatile("" : "+s"(g)); return g; }
__device__ __forceinline__ int opaque_block() { int b = blockIdx.x; asm volatile("" : "+s"(b)); return b; }
template <class F> __device__ __forceinline__ void run_items(int wv, const F& f, long n) {
    const int tid = opaque_tid(wv); const int lane = tid & 63, w = tid >> 6; const int G = opaque_grid(), B = opaque_block();
    const long nw = (long)G * (MEGA_THREADS / 64);
    for (long gw = (long)w * G + B; gw * 64 < n; gw += nw) { const long i = gw * 64 + lane; if (i < n) f(i); }
}

__device__ __forceinline__ void lds_barrier() { asm volatile("s_waitcnt lgkmcnt(0)\n\ts_barrier" ::: "memory"); }

template <int CTRL> __device__ __forceinline__ float dpp_mov(float x) { return __int_as_float(__builtin_amdgcn_mov_dpp(__float_as_int(x), CTRL, 0xf, 0xf, true)); }
__device__ __forceinline__ float row16_sum(float x) {
    x += dpp_mov<0xB1>(x);
    x += dpp_mov<0x4E>(x);
    x += dpp_mov<0x141>(x);
    x += dpp_mov<0x140>(x);
    return x;
}
__device__ __forceinline__ void row16_sum2(float& a, float& b) {
    float a1 = a + dpp_mov<0xB1>(a), b1 = b + dpp_mov<0xB1>(b);
    float a2 = a1 + dpp_mov<0x4E>(a1), b2 = b1 + dpp_mov<0x4E>(b1);
    float a3 = a2 + dpp_mov<0x141>(a2), b3 = b2 + dpp_mov<0x141>(b2);
    a = a3 + dpp_mov<0x140>(a3); b = b3 + dpp_mov<0x140>(b3);
}
__device__ __forceinline__ float wave_sum(float v) {
    v = row16_sum(v);
    const int b = __float_as_int(v);
    return __int_as_float(__builtin_amdgcn_readlane(b, 0)) + __int_as_float(__builtin_amdgcn_readlane(b, 16)) + (__int_as_float(__builtin_amdgcn_readlane(b, 32)) + __int_as_float(__builtin_amdgcn_readlane(b, 48)));
}

typedef short bf16x8 __attribute__((ext_vector_type(8)));
typedef float f32x16 __attribute__((ext_vector_type(16)));
typedef float f32x4 __attribute__((ext_vector_type(4)));
typedef unsigned u32x4 __attribute__((ext_vector_type(4)));
typedef unsigned u32x2 __attribute__((ext_vector_type(2)));
typedef __bf16 bf16x2_t __attribute__((ext_vector_type(2)));
typedef float f32x2_t __attribute__((ext_vector_type(2)));
#define MFMA32(a, b, c) __builtin_amdgcn_mfma_f32_32x32x16_bf16((a), (b), (c), 0, 0, 0)
__device__ __forceinline__ unsigned pk2(float lo, float hi) { const f32x2_t v = {lo, hi}; return __builtin_bit_cast(unsigned, __builtin_convertvector(v, bf16x2_t)); }
__device__ __forceinline__ bf16x8 pack8(float a0, float a1, float a2, float a3, float a4, float a5, float a6, float a7) {
    u32x4 r; r[0] = pk2(a0, a1); r[1] = pk2(a2, a3); r[2] = pk2(a4, a5); r[3] = pk2(a6, a7); return __builtin_bit_cast(bf16x8, r); }
__device__ __forceinline__ bf16x8 ld8(const bf16_t* p) { return *(const bf16x8*)p; }
__device__ __forceinline__ bf16x8 ld4x2(const bf16_t* lo, const bf16_t* hi) { u32x4 r; const u32x2 a = *(const u32x2*)lo, b = *(const u32x2*)hi; r[0] = a[0]; r[1] = a[1]; r[2] = b[0]; r[3] = b[1]; return __builtin_bit_cast(bf16x8, r); }
__device__ __forceinline__ float half_swap_max(float x) { const auto t = __builtin_amdgcn_permlane32_swap(__float_as_uint(x), __float_as_uint(x), false, false); return fmaxf(__uint_as_float(t[0]), __uint_as_float(t[1])); }
__device__ __forceinline__ float half_swap_sum(float x) { const auto t = __builtin_amdgcn_permlane32_swap(__float_as_uint(x), __float_as_uint(x), false, false); return __uint_as_float(t[0]) + __uint_as_float(t[1]); }
constexpr int T_ALL = SEQ + CTX_LEN;
constexpr float LOG2E = 1.4426950408889634f;

struct FNaPrep { Ptrs p; int l; int pad_;
    __device__ __forceinline__ void operator()(long i) const {
        const int isk = (int)(i & 1), h = (int)((i >> 1) % NA_HEADS), r = (int)(i / (2 * NA_HEADS));
        const bf16_t* z = p.Z + (size_t)r * ZLD + (isk ? ZO_NAK : ZO_NAQ) + h * NA_HD;
        float v[NA_HD]; float ss = 0.f;
#pragma unroll
        for (int q = 0; q < NA_HD / 8; ++q) { const u32x4 w = *(const u32x4*)(z + 8 * q);
#pragma unroll
            for (int k = 0; k < 4; ++k) { v[8 * q + 2 * k] = __uint_as_float(w[k] << 16); v[8 * q + 2 * k + 1] = __uint_as_float(w[k] & 0xffff0000u); } }
#pragma unroll
        for (int d = 0; d < NA_HD; ++d) ss += v[d] * v[d];
        const float rn = 1.0f / sqrtf(ss / NA_HD + EPS) * (isk ? 1.0f : LOG2E / sqrtf((float)NA_HD));
        const float* g = (isk ? p.na_k_norm : p.na_q_norm) + l * NA_HD;
        bf16_t* o = (isk ? p.KN : p.QN) + (size_t)r * NA_W + h * NA_HD;
#pragma unroll
        for (int q = 0; q < NA_HD / 8; ++q) { u32x4 w;
#pragma unroll
            for (int k = 0; k < 4; ++k) w[k] = pk2(v[8 * q + 2 * k] * rn * g[8 * q + 2 * k], v[8 * q + 2 * k + 1] * rn * g[8 * q + 2 * k + 1]);
            *(u32x4*)(o + 8 * q) = w; }
    } };
struct FVt { Ptrs p; bf16_t* dst; int zoff, nheads, hd; int pad_;
    __device__ __forceinline__ void operator()(long i) const {
        const int nch = nheads * hd, cq = (int)(i % (nch / 4)), tb = (int)((i / (nch / 4)) % (T_ALL / 8)), b = (int)(i / ((long)(nch / 4) * (T_ALL / 8)));
        const int tok = tb * 8, row0 = tok < SEQ ? b * SEQ + tok : R_LAT + b * CTX_LEN + (tok - SEQ);
        const bf16_t* z = p.Z + (size_t)row0 * ZLD + zoff + 4 * cq;
        u32x2 v[8];
#pragma unroll
        for (int k = 0; k < 8; ++k) v[k] = *(const u32x2*)(z + (size_t)k * ZLD);
        bf16_t* o = dst + ((size_t)b * nch + 4 * cq) * T_ALL + tok;
#pragma unroll
        for (int h2 = 0; h2 < 2; ++h2) { u32x4 lo, hi;
#pragma unroll
            for (int k = 0; k < 4; ++k) { lo[k] = (v[2 * k][h2] & 0xffffu) | (v[2 * k + 1][h2] << 16); hi[k] = (v[2 * k][h2] >> 16) | (v[2 * k + 1][h2] & 0xffff0000u); }
            *(u32x4*)(o + (size_t)(2 * h2) * T_ALL) = lo; *(u32x4*)(o + (size_t)(2 * h2 + 1) * T_ALL) = hi; }
    } };

__device__ __forceinline__ f32x4 bf4_to_f32x(u32x2 w) { f32x4 o; o[0] = __uint_as_float(w[0] << 16); o[1] = __uint_as_float(w[0] & 0xffff0000u); o[2] = __uint_as_float(w[1] << 16); o[3] = __uint_as_float(w[1] & 0xffff0000u); return o; }
constexpr int GLA_NCH = (SEQ + CTX_LEN) / 64, GLA_CCH = CTX_LEN / 64;
static_assert(GLA_DK == 128 && GLA_DV == 256 && GLA_HEADS == 4 && SEQ % 64 == 0 && CTX_LEN % 64 == 0, "GLA kernel geometry");
__device__ __forceinline__ int gla_row0(int b, int cidx) { return cidx < GLA_CCH ? R_LAT + b * CTX_LEN + 64 * cidx : b * SEQ + 64 * (cidx - GLA_CCH); }
__device__ __forceinline__ int gla_tok0(int cidx) { return cidx < GLA_CCH ? SEQ + 64 * cidx : 64 * (cidx - GLA_CCH); }
template <int CTRL> __device__ __forceinline__ float dpp_shr_or(float x, float fill) { return __int_as_float(__builtin_amdgcn_update_dpp(__float_as_int(fill), __float_as_int(x), CTRL, 0xf, 0xf, false)); }
struct FGlaChunk { Ptrs p;
    __device__ __forceinline__ void operator()(long i8) const {
        const int tb = (int)(i8 & 7); const long i = i8 >> 3;
        const int j = (int)(i % (GLA_QK / 4)) * 4, cidx = (int)((i / (GLA_QK / 4)) % GLA_NCH), b = (int)((i / ((long)(GLA_QK / 4) * GLA_NCH)) % BATCH), d = (int)(i / ((long)(GLA_QK / 4) * GLA_NCH * BATCH));
        const int row0 = gla_row0(b, cidx);
        const size_t od = (size_t)d * R_ALL * GLA_QK;
        f32x4 a[8]; u32x2 qv[8], kv[8];
#pragma unroll
        for (int u = 0; u < 8; ++u) { const int t = d ? 63 - (tb * 8 + u) : tb * 8 + u; const size_t o = (size_t)(row0 + t) * GLA_QK + j;
            a[u] = *(const f32x4*)(p.GA + od + o); qv[u] = *(const u32x2*)(p.GQ + o); kv[u] = *(const u32x2*)(p.GK + o); }
        f32x4 P[8];
        P[0] = a[0];
#pragma unroll
        for (int u = 1; u < 8; ++u) P[u] = P[u - 1] * a[u];
        f32x4 I = P[7], E;
#pragma unroll
        for (int e = 0; e < 4; ++e) {
            float v = I[e];
            { const float s = dpp_shr_or<0x111>(v, 1.0f); v *= (tb >= 1) ? s : 1.0f; }
            { const float s = dpp_shr_or<0x112>(v, 1.0f); v *= (tb >= 2) ? s : 1.0f; }
            { const float s = dpp_shr_or<0x114>(v, 1.0f); v *= (tb >= 4) ? s : 1.0f; }
            I[e] = v;
            const float s1 = dpp_shr_or<0x111>(v, 1.0f); E[e] = (tb >= 1) ? s1 : 1.0f;
        }
#pragma unroll
        for (int u = 0; u < 8; ++u) { const int t = d ? 63 - (tb * 8 + u) : tb * 8 + u; const size_t o = (size_t)(row0 + t) * GLA_QK + j;
            const f32x4 A = E * P[u];
            const f32x4 q = bf4_to_f32x(qv[u]), k = bf4_to_f32x(kv[u]); f32x4 qo, ko;
#pragma unroll
            for (int e = 0; e < 4; ++e) { qo[e] = q[e] * A[e]; ko[e] = k[e] * __builtin_amdgcn_rcpf(A[e]); }
            u32x2 w; w[0] = pk2(qo[0], qo[1]); w[1] = pk2(qo[2], qo[3]); *(u32x2*)(p.QH + od + o) = w;
            w[0] = pk2(ko[0], ko[1]); w[1] = pk2(ko[2], ko[3]); *(u32x2*)(p.KP + od + o) = w; }
        if (tb == 7) *(f32x4*)(p.DL + ((size_t)(d * BATCH + b) * GLA_NCH + cidx) * GLA_QK + j) = I;
    } };
constexpr int GL_QS = 272, GL_TS = 144;
constexpr int GL_QH = 0, GL_KP = 64 * GL_QS, GL_KPT = 2 * 64 * GL_QS, GL_DL = GL_KPT + 128 * GL_TS, GL_BUF = GL_DL + 512;
static_assert(2 * GL_BUF <= pg8::STAGE_BYTES && GL_BUF % 16 == 0, "GLA staging buffers");
__device__ __forceinline__ bf16x8 lds8(const LAS unsigned char* q) { return *(const LAS bf16x8*)q; }
__device__ __forceinline__ bf16x8 lds4x2(const LAS unsigned char* lo) { u32x4 r; const u32x2 a = *(const LAS u32x2*)lo, b = *(const LAS u32x2*)(lo + 16); r[0] = a[0]; r[1] = a[1]; r[2] = b[0]; r[3] = b[1]; return __builtin_bit_cast(bf16x8, r); }
__device__ __forceinline__ int gla_chunk_at(int d, int step) { return d ? (step < GLA_CCH ? GLA_CCH - 1 - step : GLA_NCH - 1 - (step - GLA_CCH)) : step; }
constexpr int GL_ATT0 = 2 * GL_BUF, GL_ATT = 6 * 1024;
static_assert(GL_ATT0 + 2 * GL_ATT <= pg8::STAGE_BYTES, "GLA att images");
struct GlStage2 { u32x4 q[4], k[4], t[4]; f32x4 dl; };
__device__ __forceinline__ void gla_load2(const Ptrs& p, int b, int hh, int d, int cidx, int t256, GlStage2& st) {
    const size_t od = (size_t)d * R_ALL * GLA_QK; const int row0 = gla_row0(b, cidx);
    const size_t cc = ((size_t)(d * BATCH + b) * GLA_NCH + cidx) * GLA_QK + hh * GLA_DK;
#pragma unroll
    for (int j = 0; j < 4; ++j) { const int i = t256 + 256 * j;
        const size_t o = od + (size_t)(row0 + (i >> 4)) * GLA_QK + hh * GLA_DK + (i & 15) * 8;
        st.q[j] = *(const u32x4*)(p.QH + o); st.k[j] = *(const u32x4*)(p.KP + o);
        st.t[j] = *(const u32x4*)(p.KPT + (cc + (i >> 3)) * 64 + (i & 7) * 8); }
    st.dl = *(const f32x4*)(p.DL + cc + (t256 & 31) * 4);
}
__device__ __forceinline__ void gla_store2(LAS unsigned char* buf, int t256, const GlStage2& st) {
#pragma unroll
    for (int j = 0; j < 4; ++j) { const int i = t256 + 256 * j;
        *(LAS u32x4*)(buf + GL_QH + (i >> 4) * GL_QS + (i & 15) * 16) = st.q[j]; *(LAS u32x4*)(buf + GL_KP + (i >> 4) * GL_QS + (i & 15) * 16) = st.k[j];
        *(LAS u32x4*)(buf + GL_KPT + (i >> 3) * GL_TS + (i & 7) * 16) = st.t[j]; }
    if (t256 < 32) *(LAS f32x4*)(buf + GL_DL + t256 * 16) = st.dl;
}
struct GlAttOp { u32x4 kf[8], qf[8]; };
__device__ __forceinline__ void gla_att_load(const Ptrs& p, int b, int hh, int d, int cidx, int t3, int c, int hf, GlAttOp& op) {
    const int jb = (t3 == 2) ? 1 : 0, ib = (t3 == 0) ? 0 : 1, JB = d ? ib : jb, IB = d ? jb : ib;
    const size_t od = (size_t)d * R_ALL * GLA_QK; const int row0 = gla_row0(b, cidx);
    const bf16_t* kp = p.KP + od + (size_t)(row0 + 32 * JB + c) * GLA_QK + hh * GLA_DK + 8 * hf; const bf16_t* qp = p.QH + od + (size_t)(row0 + 32 * IB + c) * GLA_QK + hh * GLA_DK + 8 * hf;
#pragma unroll
    for (int ks = 0; ks < 8; ++ks) { op.kf[ks] = *(const u32x4*)(kp + 16 * ks); op.qf[ks] = *(const u32x4*)(qp + 16 * ks); }
}
__device__ __forceinline__ void gla_att_make(const GlAttOp& op, LAS unsigned char* att, int d, int t3, int lane) {
    const int c = lane & 31, hf = lane >> 5;
    f32x16 at;
#pragma unroll
    for (int r = 0; r < 16; ++r) at[r] = 0.f;
#pragma unroll
    for (int ks = 0; ks < 8; ++ks) at = MFMA32(__builtin_bit_cast(bf16x8, op.kf[ks]), __builtin_bit_cast(bf16x8, op.qf[ks]), at);
    if (t3 != 1) {
#pragma unroll
        for (int r = 0; r < 16; ++r) { const int jj = (r & 3) + 8 * (r >> 2) + 4 * hf; at[r] = (d ? jj >= c : jj <= c) ? at[r] : 0.f; }
    }
#pragma unroll
    for (int s = 0; s < 2; ++s) *(LAS bf16x8*)(att + ((t3 * 2 + s) * 64 + lane) * 16) = pack8(at[8 * s], at[8 * s + 1], at[8 * s + 2], at[8 * s + 3], at[8 * s + 4], at[8 * s + 5], at[8 * s + 6], at[8 * s + 7]);
}
struct GlV { bf16x8 a[2][2], s[4]; };
__device__ __forceinline__ void gla_load_va(const bf16_t* vtg, unsigned vo, int tok0, int hf, GlV& v) {
#pragma unroll
    for (int jb = 0; jb < 2; ++jb)
#pragma unroll
        for (int s = 0; s < 2; ++s) { const bf16_t* vp = (const bf16_t*)((const char*)vtg + (vo + (unsigned)(tok0 + 32 * jb + 16 * s + 4 * hf)) * 2u); v.a[jb][s] = ld4x2(vp, vp + 8); }
}
__device__ __forceinline__ void gla_load_vs(const bf16_t* vtg, unsigned vo, int tok0, int hf, GlV& v) {
#pragma unroll
    for (int ks = 0; ks < 4; ++ks) v.s[ks] = ld8((const bf16_t*)((const char*)vtg + (vo + (unsigned)(tok0 + 16 * ks + 8 * hf)) * 2u));
}
constexpr int G3_QH = 0, G3_KP = 64 * GL_QS, G3_DL = 2 * 64 * GL_QS, G3_BUF = G3_DL + 512, G3_ATT0 = 3 * G3_BUF;
static_assert(G3_ATT0 + 2 * GL_ATT <= pg8::STAGE_BYTES && G3_BUF % 16 == 0 && GLA_NCH % 2 == 0 && GLA_NCH >= 4, "GLA three-buffer staging");
struct GlStage3 { u32x4 q[4], k[4]; f32x4 dl; };
__device__ __forceinline__ void gla_load3(const Ptrs& p, int b, int hh, int d, int cidx, int t256, GlStage3& st) {
    const size_t od = (size_t)d * R_ALL * GLA_QK; const int row0 = gla_row0(b, cidx);
    const size_t cc = ((size_t)(d * BATCH + b) * GLA_NCH + cidx) * GLA_QK + hh * GLA_DK;
#pragma unroll
    for (int j = 0; j < 4; ++j) { const int i = t256 + 256 * j;
        const size_t o = od + (size_t)(row0 + (i >> 4)) * GLA_QK + hh * GLA_DK + (i & 15) * 8;
        st.q[j] = *(const u32x4*)(p.QH + o); st.k[j] = *(const u32x4*)(p.KP + o); }
    st.dl = *(const f32x4*)(p.DL + cc + (t256 & 31) * 4);
}
__device__ __forceinline__ void gla_store3(LAS unsigned char* buf, int t256, const GlStage3& st) {
#pragma unroll
    for (int j = 0; j < 4; ++j) { const int i = t256 + 256 * j;
        *(LAS u32x4*)(buf + G3_QH + (i >> 4) * GL_QS + (i & 15) * 16) = st.q[j]; *(LAS u32x4*)(buf + G3_KP + (i >> 4) * GL_QS + (i & 15) * 16) = st.k[j]; }
    if (t256 < 32) *(LAS f32x4*)(buf + G3_DL + t256 * 16) = st.dl;
}
__device__ __forceinline__ void gla_att_lds(const LAS unsigned char* buf, LAS unsigned char* att, int d, int t3, int lane) {
    const int c = lane & 31, hf = lane >> 5;
    const int jb = (t3 == 2) ? 1 : 0, ib = (t3 == 0) ? 0 : 1, JB = d ? ib : jb, IB = d ? jb : ib;
    const LAS unsigned char* ka = buf + G3_KP + (32 * JB + c) * GL_QS + 16 * hf; const LAS unsigned char* qa = buf + G3_QH + (32 * IB + c) * GL_QS + 16 * hf;
    f32x16 at;
#pragma unroll
    for (int r = 0; r < 16; ++r) at[r] = 0.f;
#pragma unroll
    for (int ks = 0; ks < 8; ++ks) at = MFMA32(lds8(ka + 32 * ks), lds8(qa + 32 * ks), at);
    if (t3 != 1) {
#pragma unroll
        for (int r = 0; r < 16; ++r) { const int jj = (r & 3) + 8 * (r >> 2) + 4 * hf; at[r] = (d ? jj >= c : jj <= c) ? at[r] : 0.f; }
    }
#pragma unroll
    for (int s = 0; s < 2; ++s) *(LAS bf16x8*)(att + ((t3 * 2 + s) * 64 + lane) * 16) = pack8(at[8 * s], at[8 * s + 1], at[8 * s + 2], at[8 * s + 3], at[8 * s + 4], at[8 * s + 5], at[8 * s + 6], at[8 * s + 7]);
}
template <int DUMMY> __device__ __forceinline__ void gla_tr8(unsigned a, u32x2 (&t0)[4], u32x2 (&t1)[4]) {
    asm volatile("ds_read_b64_tr_b16 %0, %8\n\tds_read_b64_tr_b16 %1, %8 offset:%9\n\tds_read_b64_tr_b16 %2, %8 offset:%10\n\tds_read_b64_tr_b16 %3, %8 offset:%11\n\t"
                 "ds_read_b64_tr_b16 %4, %8 offset:%12\n\tds_read_b64_tr_b16 %5, %8 offset:%13\n\tds_read_b64_tr_b16 %6, %8 offset:%14\n\tds_read_b64_tr_b16 %7, %8 offset:%15"
                 : "=&v"(t0[0]), "=&v"(t1[0]), "=&v"(t0[1]), "=&v"(t1[1]), "=&v"(t0[2]), "=&v"(t1[2]), "=&v"(t0[3]), "=&v"(t1[3])
                 : "v"(a), "i"(4 * GL_QS), "i"(16 * GL_QS), "i"(20 * GL_QS), "i"(32 * GL_QS), "i"(36 * GL_QS), "i"(48 * GL_QS), "i"(52 * GL_QS) : "memory");
}
template <int d  >
__device__ __forceinline__ void gla_chain2(int wv, const Ptrs& p, int item, LAS unsigned char* lds) {
    const int lane = opaque_lane(), c = lane & 31, hf = lane >> 5, w4 = wv & 3;
    const int chain = item >> 1, half = item & 1;
    const int hh = (chain >> 1) % GLA_HEADS, b = chain / (2 * GLA_HEADS);
    __syncthreads();
    if (wv >= 4) {
        const int t256 = w4 * 64 + lane;
        GlStage3 sa, sb;
        gla_load3(p, b, hh, d, gla_chunk_at(d, 0), t256, sa); gla_load3(p, b, hh, d, gla_chunk_at(d, 1), t256, sb);
        gla_store3(lds, t256, sa); gla_store3(lds + G3_BUF, t256, sb);
        gla_load3(p, b, hh, d, gla_chunk_at(d, 2), t256, sa); gla_load3(p, b, hh, d, gla_chunk_at(d, 3), t256, sb);
        lds_barrier();
        if (w4 < 3) gla_att_lds(lds, lds + G3_ATT0, d, w4, lane);
        lds_barrier();
        int b1 = 1, b2 = 2;
        for (int step = 0; step < GLA_NCH; step += 2) {
#pragma unroll
            for (int par = 0; par < 2; ++par) { const int s = step + par; GlStage3& st = par ? sb : sa;
                if (s + 2 < GLA_NCH) gla_store3(lds + b2 * G3_BUF, t256, st);
                if (s + 4 < GLA_NCH) gla_load3(p, b, hh, d, gla_chunk_at(d, s + 4), t256, st);
                if (s + 1 < GLA_NCH && w4 < 3) gla_att_lds(lds + b1 * G3_BUF, lds + G3_ATT0 + ((s + 1) & 1) * GL_ATT, d, w4, lane);
                b1 = b2; b2 = b2 == 2 ? 0 : b2 + 1;
                lds_barrier(); }
        }
    } else {
        const int strip = 4 * half + w4;
        f32x16 S[4];
#pragma unroll
        for (int kb = 0; kb < 4; ++kb)
#pragma unroll
            for (int r = 0; r < 16; ++r) S[kb][r] = 0.f;
        const unsigned vo = (unsigned)((b * GLA_HEADS + hh) * GLA_DV + 32 * strip + c) * T_ALL;
        GlV vc; gla_load_va(p.VTG, vo, gla_tok0(gla_chunk_at(d, 0)), hf, vc); gla_load_vs(p.VTG, vo, gla_tok0(gla_chunk_at(d, 0)), hf, vc);
        lds_barrier(); lds_barrier();
        int b0 = 0;
        for (int step = 0; step < GLA_NCH; ++step) {
            const int tokn = gla_tok0(gla_chunk_at(d, step + 1 < GLA_NCH ? step + 1 : step));
            const int cidx = gla_chunk_at(d, step), row0 = gla_row0(b, cidx);
            const LAS unsigned char* buf = lds + b0 * G3_BUF; const LAS unsigned char* att = lds + G3_ATT0 + (step & 1) * GL_ATT + lane * 16; b0 = b0 == 2 ? 0 : b0 + 1;
            const unsigned trb = (unsigned)(size_t)(buf + G3_KP) + (unsigned)((8 * (lane >> 5) + ((lane >> 2) & 3)) * GL_QS + (16 * ((lane >> 4) & 1) + 4 * (lane & 3)) * 2);
            f32x16 y[2];
#pragma unroll
            for (int ib = 0; ib < 2; ++ib)
#pragma unroll
                for (int r = 0; r < 16; ++r) y[ib][r] = 0.f;
#pragma unroll
            for (int s = 0; s < 2; ++s) {
                y[0] = MFMA32(*(const LAS bf16x8*)(att + (0 * 2 + s) * 1024), vc.a[0][s], y[0]);
                const bf16x8 a1 = *(const LAS bf16x8*)(att + (1 * 2 + s) * 1024);
                if (d) y[0] = MFMA32(a1, vc.a[1][s], y[0]); else y[1] = MFMA32(a1, vc.a[0][s], y[1]);
                y[1] = MFMA32(*(const LAS bf16x8*)(att + (2 * 2 + s) * 1024), vc.a[1][s], y[1]);
            }
            gla_load_va(p.VTG, vo, tokn, hf, vc);
#pragma unroll
            for (int kb = 0; kb < 4; ++kb)
#pragma unroll
                for (int s = 0; s < 2; ++s) {
                    const bf16x8 sf = pack8(S[kb][8 * s], S[kb][8 * s + 1], S[kb][8 * s + 2], S[kb][8 * s + 3], S[kb][8 * s + 4], S[kb][8 * s + 5], S[kb][8 * s + 6], S[kb][8 * s + 7]);
#pragma unroll
                    for (int ib = 0; ib < 2; ++ib) y[ib] = MFMA32(lds4x2(buf + G3_QH + (32 * ib + c) * GL_QS + (32 * kb + 16 * s + 4 * hf) * 2), sf, y[ib]);
                }
            const unsigned go = ((unsigned)(d * R_ALL + row0 + 4 * hf) * GLA_V + hh * GLA_DV + 32 * strip + c) * 2u;
#pragma unroll
            for (int ib = 0; ib < 2; ++ib)
#pragma unroll
                for (int r = 0; r < 16; ++r) *(bf16_t*)((char*)p.GY + go + (unsigned)((32 * ib + (r & 3) + 8 * (r >> 2)) * GLA_V) * 2u) = (bf16_t)pk2(y[ib][r], 0.f);
#pragma unroll
            for (int kb = 0; kb < 4; ++kb) {
                u32x2 t0[4], t1[4];
                gla_tr8<0>(trb + kb * 64, t0, t1);
                asm volatile("s_waitcnt lgkmcnt(0)" ::: "memory"); __builtin_amdgcn_sched_barrier(0);
#pragma unroll
                for (int ks = 0; ks < 4; ++ks) { u32x4 w; w[0] = t0[ks][0]; w[1] = t0[ks][1]; w[2] = t1[ks][0]; w[3] = t1[ks][1]; S[kb] = MFMA32(__builtin_bit_cast(bf16x8, w), vc.s[ks], S[kb]); }
#pragma unroll
                for (int g = 0; g < 4; ++g) { const f32x4 dv = *(const LAS f32x4*)(buf + G3_DL + (32 * kb + 8 * g + 4 * hf) * 4);
#pragma unroll
                    for (int k = 0; k < 4; ++k) S[kb][4 * g + k] *= dv[k]; }
            }
            gla_load_vs(p.VTG, vo, tokn, hf, vc);
            lds_barrier();
        }
    }
}
__device__ __forceinline__ void gla_phase(int wv, const Ptrs& p, LAS unsigned char* lds, int wg0) {
    const int B = opaque_block(), G = opaque_grid();
    if (B >= wg0) for (int c = B - wg0; c < BATCH * GLA_HEADS * 2 * 2; c += G - wg0) { if ((c >> 1) & 1) gla_chain2<1>(wv, p, c, lds); else gla_chain2<0>(wv, p, c, lds); }
}

constexpr int NA_LAT_UNITS = BATCH * NA_HEADS * (SEQ / GRID_W);
constexpr int NA_CTX_UNITS = BATCH * NA_HEADS * (CTX_LEN / 64);
constexpr int NA_RPB_N = NA_HEADS * (2 * NA_WIN_R_MAX - 1) * (2 * NA_WIN_C - 1);
constexpr int NA_LAND0 = 32768;
static_assert(256 + (NA_RPB_N + 2 * GRID_W) * 4 <= NA_LAND0 - 16 && (NA_LAT_UNITS % 8) == 0 && (NA_CTX_UNITS % 8) == 0 && NA_LAND0 + 8 * 8192 <= pg8::STAGE_BYTES, "NA LDS layout");
static_assert(GRID_W == 64 && NA_HD == 64 && SEQ / GRID_W == 32 && NA_HEADS == 16 && CTX_LEN % 64 == 0, "NA kernel geometry");
struct NaQ { bf16x8 qf[4]; f32x16 o0, o1; float m, ls; };
__device__ __forceinline__ void na_softmax_pv(const float (&s)[16], NaQ& q, const bf16x8 (&vf)[2][2]) {
    float bm = s[0];
#pragma unroll
    for (int r = 1; r < 16; ++r) bm = fmaxf(bm, s[r]);
    bm = half_swap_max(bm);
    const float mn = fmaxf(q.m, bm), ms = (mn == -INFINITY) ? 0.f : mn;
    const float alpha = __builtin_amdgcn_exp2f(q.m - ms);
    const bool moved = __builtin_amdgcn_ballot_w64(mn != q.m) != 0ull;
    q.m = mn;
    float pv[16], psum = 0.f;
#pragma unroll
    for (int r = 0; r < 16; ++r) { pv[r] = __builtin_amdgcn_exp2f(s[r] - ms); psum += pv[r]; }
    q.ls = q.ls * alpha + psum;
    if (moved) {
#pragma unroll
        for (int r = 0; r < 16; ++r) { q.o0[r] *= alpha; q.o1[r] *= alpha; } }
#pragma unroll
    for (int ks = 0; ks < 2; ++ks) {
        const bf16x8 pb = pack8(pv[8 * ks], pv[8 * ks + 1], pv[8 * ks + 2], pv[8 * ks + 3], pv[8 * ks + 4], pv[8 * ks + 5], pv[8 * ks + 6], pv[8 * ks + 7]);
        q.o0 = MFMA32(vf[0][ks], pb, q.o0);
        q.o1 = MFMA32(vf[1][ks], pb, q.o1);
    }
}
__device__ __forceinline__ void na_load_v(const bf16_t* vtb, int c, int hh, bf16x8 (&vf)[2][2]) {
#pragma unroll
    for (int dt = 0; dt < 2; ++dt)
#pragma unroll
        for (int ks = 0; ks < 2; ++ks) { const bf16_t* v0 = vtb + (size_t)(32 * dt + c) * T_ALL + 16 * ks + 4 * hh; vf[dt][ks] = ld4x2(v0, v0 + 8); }
}
__device__ __forceinline__ void na_unit(const Ptrs& p, int u, int, const LAS float* rpb, LAS unsigned char* nab) {
    const int lane = opaque_lane(), c = lane & 31, hh = lane >> 5;
    int b, h, gr = 0, nloc, qrow0;
    if (u < NA_LAT_UNITS) { gr = u & 31; h = (u >> 5) & 15; b = u >> 9; qrow0 = b * SEQ + gr * GRID_W; nloc = NA_WIN_R_MAX; }
    else { const int v = u - NA_LAT_UNITS; h = (v >> 2) & 15; b = v >> 6; qrow0 = R_LAT + b * CTX_LEN + 64 * (v & 3); nloc = 0; }
    NaQ q[2];
#pragma unroll
    for (int qi = 0; qi < 2; ++qi) {
#pragma unroll
        for (int ks = 0; ks < 4; ++ks) q[qi].qf[ks] = ld8((const bf16_t*)((const char*)p.QN + ((unsigned)(qrow0 + 32 * qi + c) * NA_W + h * NA_HD + ks * 16 + 8 * hh) * 2u));
#pragma unroll
        for (int r = 0; r < 16; ++r) { q[qi].o0[r] = 0.f; q[qi].o1[r] = 0.f; }
        q[qi].m = -INFINITY; q[qi].ls = 0.f;
    }
    int rs = gr - NA_WIN_R_MAX / 2; rs = rs < 0 ? 0 : (rs > SEQ / GRID_W - NA_WIN_R_MAX ? SEQ / GRID_W - NA_WIN_R_MAX : rs);
    const int nl2 = 2 * nloc, nblk = nl2 + CTX_LEN / 32;
    bf16x8 kf[4], vf[2][2];
    for (int blk = 0; blk < nblk; ++blk) {
#pragma unroll
        for (int ph = 0; ph < 2; ++ph) {
            if (ph == 0 ? blk == 0 : blk + 1 < nblk) {
                const int i = blk + ph;
                const bool loc = i < nl2; const int ci = i - nl2;
                const int tok0 = loc ? (rs + (i >> 1)) * GRID_W + 32 * (i & 1) : SEQ + 32 * ci;
                const int lz = opaque_lane(), cz = lz & 31, hz = lz >> 5;
                const unsigned ko = ((unsigned)((loc ? b * SEQ + tok0 : R_LAT + b * CTX_LEN + 32 * ci) + cz) * NA_W + h * NA_HD + 8 * hz) * 2u;
                const unsigned vo = ((unsigned)((loc ? b * SEQ + tok0 : R_LAT + b * CTX_LEN + 32 * ci) + (lz >> 3)) * ZLD + ZO_NAV + h * NA_HD + 8 * (lz & 7)) * 2u;
                asm volatile("s_waitcnt lgkmcnt(0)" ::: "memory");
#pragma unroll
                for (int ks = 0; ks < 4; ++ks) __builtin_amdgcn_global_load_lds((const unsigned*)((const char*)p.KN + ko + ks * 32), (LAS unsigned*)(nab + ks * 1024), 16, 0, 0);
#pragma unroll
                for (int i8 = 0; i8 < 4; ++i8) __builtin_amdgcn_global_load_lds((const unsigned*)((const char*)p.Z + vo + (unsigned)(8 * i8 * ZLD) * 2u), (LAS unsigned*)(nab + 4096 + i8 * 1024), 16, 0, 0);
            }
            if (ph == 0) {
                asm volatile("s_waitcnt vmcnt(0)" ::: "memory");
                const int lf = opaque_lane(), cf = lf & 31, hf = lf >> 5;
#pragma unroll
                for (int ks = 0; ks < 4; ++ks) kf[ks] = *(const LAS bf16x8*)(nab + ks * 1024 + lf * 16);
                { const unsigned tb = (unsigned)(size_t)(nab + 4096) + (unsigned)((4 * hf + ((lf >> 2) & 3)) * 128 + (16 * ((lf >> 4) & 1) + 4 * (lf & 3)) * 2);
                  u32x2 t[8];
                  asm volatile("ds_read_b64_tr_b16 %0, %8\n\tds_read_b64_tr_b16 %1, %8 offset:1024\n\tds_read_b64_tr_b16 %2, %8 offset:2048\n\tds_read_b64_tr_b16 %3, %8 offset:3072\n\t"
                               "ds_read_b64_tr_b16 %4, %8 offset:64\n\tds_read_b64_tr_b16 %5, %8 offset:1088\n\tds_read_b64_tr_b16 %6, %8 offset:2112\n\tds_read_b64_tr_b16 %7, %8 offset:3136\n\ts_waitcnt lgkmcnt(0)"
                               : "=&v"(t[0]), "=&v"(t[1]), "=&v"(t[2]), "=&v"(t[3]), "=&v"(t[4]), "=&v"(t[5]), "=&v"(t[6]), "=&v"(t[7]) : "v"(tb) : "memory");
                  __builtin_amdgcn_sched_barrier(0);
#pragma unroll
                  for (int dt = 0; dt < 2; ++dt)
#pragma unroll
                      for (int ks = 0; ks < 2; ++ks) { u32x4 r; r[0] = t[4 * dt + 2 * ks][0]; r[1] = t[4 * dt + 2 * ks][1]; r[2] = t[4 * dt + 2 * ks + 1][0]; r[3] = t[4 * dt + 2 * ks + 1][1]; vf[dt][ks] = __builtin_bit_cast(bf16x8, r); } }
                (void)cf;
            }
        }
        if (blk < nl2) {
            const int n = blk >> 1, kb = blk & 1;
            const LAS float* rp = rpb + (h * (2 * NA_WIN_R_MAX - 1) + (rs + n - gr + NA_WIN_R_MAX - 1)) * (2 * NA_WIN_C - 1);
#pragma unroll
            for (int qi = 0; qi < 2; ++qi) {
                f32x16 S;
#pragma unroll
                for (int r = 0; r < 16; ++r) S[r] = 0.f;
#pragma unroll
                for (int ks = 0; ks < 4; ++ks) S = MFMA32(kf[ks], q[qi].qf[ks], S);
                const int lz = opaque_lane(), cz = lz & 31, hz = lz >> 5;
                const int qc = 32 * qi + cz; int cs = qc - NA_WIN_C / 2; cs = cs < 0 ? 0 : (cs > GRID_W - NA_WIN_C ? GRID_W - NA_WIN_C : cs);
                const int k0 = 32 * kb + 4 * hz; const int mb = k0 - cs; const LAS float* rb = rp + (k0 - qc + NA_WIN_C - 1);
                float s[16];
#pragma unroll
                for (int r = 0; r < 16; ++r) { const int o = (r & 3) + 8 * (r >> 2); s[r] = ((unsigned)(mb + o) < (unsigned)NA_WIN_C) ? S[r] + rb[o] : -INFINITY; }
                na_softmax_pv(s, q[qi], vf);
            }
        } else {
#pragma unroll
            for (int qi = 0; qi < 2; ++qi) {
                f32x16 S;
#pragma unroll
                for (int r = 0; r < 16; ++r) S[r] = 0.f;
#pragma unroll
                for (int ks = 0; ks < 4; ++ks) S = MFMA32(kf[ks], q[qi].qf[ks], S);
                float s[16];
#pragma unroll
                for (int r = 0; r < 16; ++r) s[r] = S[r];
                na_softmax_pv(s, q[qi], vf);
            }
        }
    }
#pragma unroll
    for (int qi = 0; qi < 2; ++qi) {
        const float inv = 1.0f / half_swap_sum(q[qi].ls);
        const int lo = opaque_lane(), co = lo & 31, ho = lo >> 5;
        bf16_t* yo = (bf16_t*)((char*)p.Y3 + ((unsigned)(qrow0 + 32 * qi + co) * BW + h * NA_HD + 4 * ho) * 2u);
#pragma unroll
        for (int g = 0; g < 4; ++g) {
            u32x2 w0, w1; w0[0] = pk2(q[qi].o0[4 * g] * inv, q[qi].o0[4 * g + 1] * inv); w0[1] = pk2(q[qi].o0[4 * g + 2] * inv, q[qi].o0[4 * g + 3] * inv);
            w1[0] = pk2(q[qi].o1[4 * g] * inv, q[qi].o1[4 * g + 1] * inv); w1[1] = pk2(q[qi].o1[4 * g + 2] * inv, q[qi].o1[4 * g + 3] * inv);
            *(u32x2*)(yo + 8 * g) = w0; *(u32x2*)(yo + 32 + 8 * g) = w1;
        }
    }
}
__device__ __forceinline__ void na_phase(int wv, const Ptrs& p, int l, LAS unsigned char* lds, int u1, unsigned* ctr, int nw  ) {
    const int tid = opaque_tid(wv), lane = tid & 63;
    LAS float* rpb = (LAS float*)(lds + 256);
    volatile LAS int* slot = (volatile LAS int*)(lds + NA_LAND0 - 16);
    __syncthreads();
    for (int i = tid; i < NA_RPB_N; i += MEGA_THREADS) rpb[i] = p.na_rpb[(size_t)l * NA_RPB_N + i] * LOG2E;
    for (;;) {
        __syncthreads();
        if (tid == 0) *slot = (int)__hip_atomic_fetch_add(ctr, (unsigned)nw, __ATOMIC_RELAXED, __HIP_MEMORY_SCOPE_AGENT);
        __syncthreads();
        const int u = __builtin_amdgcn_readfirstlane(*slot) + wv;
        if (u - wv >= u1) break;
        if (u < u1 && wv < nw) na_unit(p, u, lane, rpb, lds + NA_LAND0 + wv * 8192);
    }
}

__device__ __forceinline__ void ld8f(const bf16_t* p, float (&v)[8]) { const u32x4 w = *(const u32x4*)p;
#pragma unroll
    for (int k = 0; k < 4; ++k) { v[2 * k] = __uint_as_float(w[k] << 16); v[2 * k + 1] = __uint_as_float(w[k] & 0xffff0000u); } }
__device__ __forceinline__ void cv8f(const u32x4 w, float (&v)[8]) {
#pragma unroll
    for (int k = 0; k < 4; ++k) { v[2 * k] = __uint_as_float(w[k] << 16); v[2 * k + 1] = __uint_as_float(w[k] & 0xffff0000u); } }
__device__ __forceinline__ void st8f(bf16_t* p, const float (&v)[8]) { u32x4 w;
#pragma unroll
    for (int k = 0; k < 4; ++k) w[k] = pk2(v[2 * k], v[2 * k + 1]);
    *(u32x4*)p = w; }
__device__ __forceinline__ float sum8(float x) { x += dpp_mov<0xB1>(x); x += dpp_mov<0x4E>(x); x += dpp_mov<0x141>(x); return x; }
__device__ __forceinline__ float sum32(float x) { x = row16_sum(x); const auto t = __builtin_amdgcn_permlane16_swap(__float_as_uint(x), __float_as_uint(x), false, false); return __uint_as_float(t[0]) + __uint_as_float(t[1]); }
__device__ __forceinline__ float fast_tanh(float x) { return 1.0f - 2.0f / (__expf(2.0f * x) + 1.0f); }
struct FRope { Ptrs p;
    __device__ __forceinline__ void operator()(long i) const { const int pos = (int)(i / (GLA_DK / 4)), f = (int)(i % (GLA_DK / 4)); const float ang = (float)pos * powf(10000.0f, -(float)(2 * f) / (float)(GLA_DK / 2));
        p.ROPE[2 * i] = cosf(ang); p.ROPE[2 * i + 1] = sinf(ang); } };
constexpr int RWP_ITEMS = RW_W * (4 * 16 + 32);
struct FRwWt { Ptrs p; int l; int pad_;
    __device__ __forceinline__ void operator()(long i) const {
        const int n = (int)(i % RW_W), g8 = (int)(i / RW_W), pl = g8 < 64 ? g8 >> 4 : 4, k0 = (g8 < 64 ? (g8 & 15) : g8 - 64) * 8;
        const int klen = pl < 2 ? RW_DR : (pl < 4 ? RW_AR : RW_GR), Kp = pl < 4 ? 128 : 256;
        const float* W = pl < 2 ? p.rw_w2 + ((size_t)l * 2 + pl) * RW_DR * RW_W : (pl < 4 ? p.rw_a2 + ((size_t)l * 2 + pl - 2) * RW_AR * RW_W : p.rw_g2 + (size_t)l * RW_GR * RW_W);
        float v[8];
#pragma unroll
        for (int e = 0; e < 8; ++e) v[e] = (k0 + e < klen) ? W[(size_t)(k0 + e) * RW_W + n] : 0.f;
        st8f(p.WT_RW + (size_t)RW_W * 128 * pl + (size_t)n * Kp + k0, v);
    } };
static_assert(RW_DR % 8 == 0 && RW_AR % 8 == 0 && RW_DR == 96 && RW_AR == 96 && RW_GR == 256 && RW_W == 1024, "RWKV low-rank GEMM geometry");

constexpr int PR_W2 = 0, PR_GB = PR_W2 + 2 * GLA_RANK * GLA_QK, PR_ROPE = PR_GB + 2 * GLA_QK, PR_MU = PR_ROPE + GRID_W * (GLA_DK / 4) * 2, PR_KK = PR_MU + RW_IN, PR_END = PR_KK + RW_W;
static_assert(PR_END * 4 <= pg8::STAGE_BYTES && RW_IN % 8 == 0 && (RW_IN / 8) <= 8 * 64 && ZO_RW % 8 == 0 && GLA_QK == 512 && NA_W == 1024 && RW_W == 1024, "prep_rows geometry");
__device__ __forceinline__ void prep_rows(int wv, const Ptrs& p, int l, LAS unsigned char* lds) {
    const int tid = opaque_tid(wv), lane = tid & 63; const int G = opaque_grid(), B = opaque_block();
    LAS float* T = (LAS float*)lds;
    __syncthreads();
    for (int i = tid; i < 2 * GLA_RANK * GLA_QK; i += MEGA_THREADS) T[PR_W2 + i] = p.gla_gate_w2[(size_t)l * 2 * GLA_RANK * GLA_QK + i];
    for (int i = tid; i < 2 * GLA_QK; i += MEGA_THREADS) T[PR_GB + i] = p.gla_gate_b[(size_t)l * 2 * GLA_QK + i];
    for (int i = tid; i < GRID_W * (GLA_DK / 4) * 2; i += MEGA_THREADS) T[PR_ROPE + i] = p.ROPE[i];
    for (int i = tid; i < RW_IN; i += MEGA_THREADS) T[PR_MU + i] = p.rw_mu[(size_t)l * RW_IN + i];
    for (int i = tid; i < RW_W; i += MEGA_THREADS) T[PR_KK + i] = p.rw_k_k[(size_t)l * RW_W + i];
    __syncthreads();
    const int rstep = G * (MEGA_THREADS / 64);
    u32x4 wn[4], wg[4], wgd[2 * GLA_RANK / 8], w0[8], wp[8], wx[8];
    const int j0 = lane * 8, i2 = j0 % (GLA_DK / 2), sect = (j0 % GLA_DK) / (GLA_DK / 2); const bool first = i2 < GLA_DK / 4; const int f0 = i2 % (GLA_DK / 4), pj = first ? j0 + GLA_DK / 4 : j0 - GLA_DK / 4;
    auto load_ab = [&](int rr) {
        const bf16_t* z = p.Z + (size_t)rr * ZLD;
#pragma unroll
        for (int it = 0; it < 4; ++it) wn[it] = *(const u32x4*)(z + ((it >> 1) ? ZO_NAK : ZO_NAQ) + (it & 1) * 512 + lane * 8);
        wg[0] = *(const u32x4*)(z + ZO_GQ + j0); wg[1] = *(const u32x4*)(z + ZO_GK + j0); wg[2] = *(const u32x4*)(z + ZO_GQ + pj); wg[3] = *(const u32x4*)(z + ZO_GK + pj);
#pragma unroll
        for (int c = 0; c < 2 * GLA_RANK / 8; ++c) wgd[c] = *(const u32x4*)(z + ZO_GGD + 8 * c);
    };
    auto load_rw = [&](int rr, int h) {
        const bf16_t* z = p.Z + (size_t)rr * ZLD; const bf16_t* zp = row_first(rr) ? z : z - ZLD; const bf16_t* zn = row_last(rr) ? z : z + ZLD;
#pragma unroll
        for (int it = 4 * h; it < 4 * h + 4; ++it) { const int ci = it * 64 + lane, col = (it < 7 || ci < RW_IN / 8 ? ci : lane) * 8;
            w0[it] = *(const u32x4*)(z + ZO_RW + col); wp[it] = *(const u32x4*)(zp + ZO_RW + col); wx[it] = *(const u32x4*)(zn + ZO_RW + col); }
    };
    { const int r0 = wv * G + B; if (r0 < R_ALL) { load_ab(r0); load_rw(r0, 0); } }
    for (int r = wv * G + B; r < R_ALL; r += rstep) {
        asm volatile("" ::: "memory");
        const int rn = r + rstep < R_ALL ? r + rstep : r;
        const bool lat = r < R_LAT; const int tk = r % SEQ, gr = tk / GRID_W, gc = tk % GRID_W;
        const bool rf = row_first(r), rl = row_last(r);
        load_rw(r, 1);
        float gqk[2][8];
#pragma unroll
        for (int e = 0; e < 8; ++e) { gqk[0][e] = p.na_q_norm[l * NA_HD + ((lane * 8) % NA_HD) + e]; gqk[1][e] = p.na_k_norm[l * NA_HD + ((lane * 8) % NA_HD) + e]; }
#pragma unroll
        for (int it = 0; it < 4; ++it) {
            const int isk = it >> 1, col = (it & 1) * 512 + lane * 8;
            float v[8]; cv8f(wn[it], v);
            float ss = 0.f;
#pragma unroll
            for (int e = 0; e < 8; ++e) ss += v[e] * v[e];
            ss = sum8(ss);
            const float rn_ = 1.0f / sqrtf(ss / NA_HD + EPS) * (isk ? 1.0f : LOG2E / sqrtf((float)NA_HD));
#pragma unroll
            for (int e = 0; e < 8; ++e) v[e] *= rn_ * gqk[isk][e];
            st8f((isk ? p.KN : p.QN) + (size_t)r * NA_W + col, v);
        }
        {
            float q[8], k[8], qp[8], kp[8];
            cv8f(wg[0], q); cv8f(wg[1], k);
            const float qs = 1.0f / sqrtf((float)GLA_DK);
            if (lat) {
                cv8f(wg[2], qp); cv8f(wg[3], kp);
                const LAS float* cs = T + PR_ROPE + ((sect ? gc : gr) * (GLA_DK / 4) + f0) * 2;
#pragma unroll
                for (int e = 0; e < 8; ++e) { const float c = cs[2 * e], s = cs[2 * e + 1];
                    q[e] = first ? q[e] * c - qp[e] * s : qp[e] * s + q[e] * c; k[e] = first ? k[e] * c - kp[e] * s : kp[e] * s + k[e] * c; }
            }
#pragma unroll
            for (int e = 0; e < 8; ++e) q[e] *= qs;
            st8f(p.GQ + (size_t)r * GLA_QK + j0, q); st8f(p.GK + (size_t)r * GLA_QK + j0, k);
            float gd[2 * GLA_RANK];
#pragma unroll
            for (int c = 0; c < 2 * GLA_RANK / 8; ++c) { float t8[8]; cv8f(wgd[c], t8);
#pragma unroll
                for (int e = 0; e < 8; ++e) gd[8 * c + e] = t8[e]; }
#pragma unroll
            for (int d = 0; d < 2; ++d) {
                float pre[8];
#pragma unroll
                for (int e = 0; e < 8; ++e) pre[e] = T[PR_GB + d * GLA_QK + j0 + e];
#pragma unroll
                for (int kk = 0; kk < GLA_RANK; ++kk) { const LAS f32x4* w = (const LAS f32x4*)(T + PR_W2 + (d * GLA_RANK + kk) * GLA_QK + j0); const f32x4 w0v = w[0], w1v = w[1]; const float gv = gd[d * GLA_RANK + kk];
                    pre[0] += gv * w0v[0]; pre[1] += gv * w0v[1]; pre[2] += gv * w0v[2]; pre[3] += gv * w0v[3]; pre[4] += gv * w1v[0]; pre[5] += gv * w1v[1]; pre[6] += gv * w1v[2]; pre[7] += gv * w1v[3]; }
                f32x4 a0, a1;
#pragma unroll
                for (int e = 0; e < 4; ++e) { a0[e] = __expf(-softplusf_(-pre[e]) * (1.0f / GLA_TAU)); a1[e] = __expf(-softplusf_(-pre[4 + e]) * (1.0f / GLA_TAU)); }
                f32x4* ga = (f32x4*)(p.GA + ((size_t)d * R_ALL + r) * GLA_QK + j0); ga[0] = a0; ga[1] = a1;
            }
        }
        load_ab(rn);
#pragma unroll
        for (int it = 0; it < 8; ++it) {
            if (it == 4) load_rw(rn, 0);
            const int ci = it * 64 + lane;
            if (it < 7 || ci < RW_IN / 8) {
                const int col = ci * 8;
                float z0[8], zp[8], zn[8], zs[8];
                cv8f(w0[it], z0); cv8f(wp[it], zp); cv8f(wx[it], zn);
                if (rf) {
#pragma unroll
                    for (int e = 0; e < 8; ++e) zp[e] = 0.f; }
                if (rl) {
#pragma unroll
                    for (int e = 0; e < 8; ++e) zn[e] = 0.f; }
#pragma unroll
                for (int e = 0; e < 8; ++e) zs[e] = z0[e] + T[PR_MU + col + e] * (0.5f * (zp[e] + zn[e]) - z0[e]);
                if (it < 2) st8f(p.RS + (size_t)r * RW_W + col, zs);
                else if (it < 4) { const int c2 = col - RW_W;
                    st8f(p.KS + (size_t)r * RW_W + c2, zs);
                    float kk[8], ss = 0.f;
#pragma unroll
                    for (int e = 0; e < 8; ++e) { kk[e] = zs[e] * T[PR_KK + c2 + e]; ss += kk[e] * kk[e]; }
                    ss = sum8(ss);
                    const float rn_ = 1.0f / sqrtf(ss + EPS);
#pragma unroll
                    for (int e = 0; e < 8; ++e) kk[e] *= rn_;
                    st8f(p.KK + (size_t)r * RW_W + c2, kk); }
                else if (it < 6) st8f(p.VS + (size_t)r * RW_W + col - 2 * RW_W, zs);
                else { const int q = col - 3 * RW_W;
#pragma unroll
                    for (int e = 0; e < 8; ++e) zs[e] = q < 2 * RW_DR ? fast_tanh(zs[e]) : (q < 2 * RW_DR + 2 * RW_AR ? zs[e] : 1.0f / (1.0f + __expf(-zs[e])));
                    const int pl = q < 2 * RW_DR ? q / RW_DR : (q < 2 * RW_DR + 2 * RW_AR ? 2 + (q - 2 * RW_DR) / RW_AR : 4), kq = pl < 4 ? q - pl * RW_DR : q - 4 * RW_DR, Kp = pl < 4 ? 128 : 256;
                    bf16_t* lp = p.LOW + (size_t)R_ALL * 128 * pl + (size_t)r * Kp;
                    st8f(lp + kq, zs);
                    if (pl < 4 && kq == RW_DR - 8) {
#pragma unroll
                        for (int e = 0; e < 8; ++e) zs[e] = 0.f;
#pragma unroll
                        for (int z8 = 0; z8 < 4; ++z8) st8f(lp + RW_DR + 8 * z8, zs); } }
            }
        }
    }
}
__device__ __forceinline__ void finish_rows(int wv, const Ptrs& p, int l, int ro) {
    const int G = opaque_grid(), B = opaque_block();
    for (int r = wv * G + B; r < ro; r += G * (MEGA_THREADS / 64)) {
        asm volatile("" ::: "memory");
        const int lane = opaque_lane();
        u32x4 gy0[2], gy1[2], grg[2], ry0[2], ry1[2], rrs[2], rks[2], rvs[2], rgg[2];
        float gn[8], rk[2][8], gng[2][8], gnb[2][8];
#pragma unroll
        for (int it = 0; it < 2; ++it) { const int col = it * 512 + lane * 8;
            gy0[it] = *(const u32x4*)(p.GY + (size_t)r * GLA_V + col); gy1[it] = *(const u32x4*)(p.GY + ((size_t)R_ALL + r) * GLA_V + col); grg[it] = *(const u32x4*)(p.Z + (size_t)r * ZLD + ZO_GR + col); }
#pragma unroll
        for (int it = 0; it < 2; ++it) { const int col = it * 512 + lane * 8; const size_t o = (size_t)r * RW_W + col;
            ry0[it] = *(const u32x4*)(p.RY + o); ry1[it] = *(const u32x4*)(p.RY + (size_t)R_ALL * RW_W + o); rrs[it] = *(const u32x4*)(p.RS + o); rks[it] = *(const u32x4*)(p.KS + o); rvs[it] = *(const u32x4*)(p.VS + o); rgg[it] = *(const u32x4*)(p.G + o); }
#pragma unroll
        for (int e = 0; e < 8; ++e) gn[e] = p.gla_norm_g[(size_t)l * GLA_DV + ((lane * 8) % GLA_DV) + e];
#pragma unroll
        for (int it = 0; it < 2; ++it)
#pragma unroll
            for (int e = 0; e < 8; ++e) { const int col = it * 512 + lane * 8 + e; rk[it][e] = p.rw_r_k[(size_t)l * RW_W + col]; gng[it][e] = p.rw_gn_g[(size_t)l * RW_W + col]; gnb[it][e] = p.rw_gn_b[(size_t)l * RW_W + col]; }
#pragma unroll
        for (int it = 0; it < 2; ++it) {
            const int col = it * 512 + lane * 8;
            float y0[8], y1[8], rg[8];
            cv8f(gy0[it], y0); cv8f(gy1[it], y1); cv8f(grg[it], rg);
            float ss = 0.f;
#pragma unroll
            for (int e = 0; e < 8; ++e) { y0[e] += y1[e]; ss += y0[e] * y0[e]; }
            ss = sum32(ss);
            const float rn = 1.0f / sqrtf(ss / GLA_DV + EPS);
#pragma unroll
            for (int e = 0; e < 8; ++e) y0[e] = y0[e] * rn * gn[e] * (rg[e] / (1.0f + __expf(-rg[e])));
            st8f(p.Y3 + (size_t)R_ALL * BW + (size_t)r * BW + col, y0);
        }
#pragma unroll
        for (int it = 0; it < 2; ++it) {
            const int col = it * 512 + lane * 8;
            float y0[8], y1[8], rs[8], ks[8], vs[8], gg[8];
            cv8f(ry0[it], y0); cv8f(ry1[it], y1); cv8f(rrs[it], rs); cv8f(rks[it], ks); cv8f(rvs[it], vs); cv8f(rgg[it], gg);
            float sm = 0.f, bonus = 0.f;
#pragma unroll
            for (int e = 0; e < 8; ++e) { y0[e] += y1[e]; sm += y0[e]; bonus += rs[e] * ks[e] * rk[it][e]; }
            const float mean = sum8(sm) * (1.0f / RW_HEAD); bonus = sum8(bonus);
            float var = 0.f;
#pragma unroll
            for (int e = 0; e < 8; ++e) { y0[e] -= mean; var += y0[e] * y0[e]; }
            const float rn = 1.0f / sqrtf(sum8(var) * (1.0f / RW_HEAD) + RW_GN_EPS);
#pragma unroll
            for (int e = 0; e < 8; ++e) y0[e] = (y0[e] * rn * gng[it][e] + gnb[it][e] + bonus * vs[e]) * gg[e];
            st8f(p.Y3 + (size_t)2 * R_ALL * BW + (size_t)r * BW + col, y0);
        }
    }
}
struct EpiRw {
    static constexpr bool PERM = true, AFTER_DRAIN = false, CARRY = false;
    float* DEC; bf16_t *AA, *Gt; const float *w0, *a0; int cb, pad_;
    __device__ __forceinline__ void operator()(const pg8::f32x4 (&acc)[2][2][4][2], const pg8::Unit& u, int wr, int wc, int fr, int fq) const {
        const int row0 = u.pm * 256 + wr * 64 + fr, col0 = u.pn * 256 + wc * 32 + 8 * fq;
        float bias[2][8];
#pragma unroll
        for (int bj = 0; bj < 2; ++bj)
#pragma unroll
            for (int e = 0; e < 8; ++e) bias[bj][e] = cb < 2 ? w0[cb * RW_W + col0 + bj * 128 + e] : (cb < 4 ? a0[(cb - 2) * RW_W + col0 + bj * 128 + e] : 0.f);
#pragma unroll
        for (int ai = 0; ai < 2; ++ai)
#pragma unroll
            for (int m = 0; m < 4; ++m) { const size_t row = (size_t)(row0 + ai * 128 + m * 16);
#pragma unroll
                for (int bj = 0; bj < 2; ++bj) { const int j = col0 + bj * 128;
                    float v[8];
#pragma unroll
                    for (int e = 0; e < 4; ++e) { v[e] = acc[ai][bj][m][0][e]; v[4 + e] = acc[ai][bj][m][1][e]; }
                    if (cb < 2) { f32x4 d0, d1;
#pragma unroll
                        for (int e = 0; e < 4; ++e) { d0[e] = __expf(-0.60653065971f * __builtin_amdgcn_rcpf(1.0f + __expf(-(v[e] + bias[bj][e]))));
                                                      d1[e] = __expf(-0.60653065971f * __builtin_amdgcn_rcpf(1.0f + __expf(-(v[4 + e] + bias[bj][4 + e])))); }
                        f32x4* dp = (f32x4*)(DEC + ((size_t)cb * R_ALL + row) * RW_W + j); dp[0] = d0; dp[1] = d1; }
                    else if (cb < 4) { const int d = cb - 2;
#pragma unroll
                        for (int e = 0; e < 8; ++e) v[e] = 1.0f / (1.0f + __expf(-(v[e] + bias[bj][e])));
                        st8f(AA + ((size_t)d * R_ALL + row) * RW_W + j, v); }
                    else st8f(Gt + row * RW_W + j, v);
                } }
    }
};
static_assert(sizeof(EpiRw) % 8 == 0, "kernel-argument padding");
typedef float f32x2m __attribute__((ext_vector_type(2)));
__device__ __forceinline__ void mod_phase(int wv, const Ptrs& p, LAS unsigned char* lds) {
    const int tid = opaque_tid(wv), lane = tid & 63, w = tid >> 6; const int G = opaque_grid(), B = opaque_block();
    LAS float* sc = (LAS float*)lds;
    LAS float* red = sc + NMOD * D_MODEL;
    __syncthreads();
    for (int i = tid; i < NMOD * D_MODEL; i += MEGA_THREADS) { const int bt = i / D_MODEL, k = i % D_MODEL; const float c = bt < BATCH ? p.c[(size_t)bt * D_MODEL + k] : p.c_ctx[k]; sc[i] = c / (1.0f + __expf(-c)); }
    __syncthreads();
    constexpr int NCB = D6 / 128, KW = D_MODEL / 8;
    for (int u = B; u < DEPTH * NCB; u += G) {
        const int l = u / NCB, cb = u % NCB;
        const f32x2m* wp = (const f32x2m*)(p.ada_w + ((size_t)l * D_MODEL + w * KW) * D6 + cb * 128) + lane;
        f32x2m acc[NMOD];
#pragma unroll
        for (int bt = 0; bt < NMOD; ++bt) acc[bt] = (f32x2m){0.f, 0.f};
#pragma unroll 8
        for (int k = 0; k < KW; ++k) { const f32x2m wv2 = wp[(size_t)k * (D6 / 2)];
#pragma unroll
            for (int bt = 0; bt < NMOD; ++bt) acc[bt] += wv2 * sc[bt * D_MODEL + w * KW + k]; }
#pragma unroll
        for (int bt = 0; bt < NMOD; ++bt) { red[(w * NMOD + bt) * 128 + 2 * lane] = acc[bt][0]; red[(w * NMOD + bt) * 128 + 2 * lane + 1] = acc[bt][1]; }
        __syncthreads();
        for (int o = tid; o < NMOD * 128; o += MEGA_THREADS) { const int bt = o / 128, cl = o % 128; float s = p.ada_b[(size_t)l * D6 + cb * 128 + cl];
#pragma unroll
            for (int ww = 0; ww < 8; ++ww) s += red[(ww * NMOD + bt) * 128 + cl];
            p.MOD[((size_t)l * NMOD + bt) * D6 + cb * 128 + cl] = s; }
        __syncthreads();
    }
}

__device__ __forceinline__ void norm_rows(int wv, const Ptrs& p, int l, int which, int nrows, bool addmoe, LAS unsigned char* lds) {
    static_assert(D_MODEL == 2048, "norm_rows lane mapping");
    const int tid = opaque_tid(wv); const int lane = tid & 63, w = tid >> 6;
    const float* gain = (which ? p.norm2_g : p.norm1_g) + (size_t)l * D_MODEL;
    LAS f32x4* rwl = (LAS f32x4*)lds;
    if (which) {
        static_assert(D_MODEL * N_EXPERTS * 4 <= pg8::STAGE_BYTES, "router matrix fits the LDS stage region");
        __syncthreads();
        for (int i = tid; i < D_MODEL * N_EXPERTS / 4; i += MEGA_THREADS) { const int row = i >> 2, j = i & 3, c = row >> 2, k = row & 3;
            rwl[(k * 4 + j) * (D_MODEL / 4) + c] = ((const f32x4*)p.router_w)[i]; }
        __syncthreads();
    }
    const int G = opaque_grid(), B = opaque_block();
    for (int r = w * G + B; r < nrows; r += G * (MEGA_THREADS / 64)) {
        const f32x4* xr = (const f32x4*)((l == 0 && which == 0) ? (r < R_LAT ? p.x + (size_t)r * D_MODEL : p.ctx + (size_t)(r - R_LAT) * D_MODEL) : p.X + (size_t)r * D_MODEL);
        asm volatile("" ::: "memory");
        const int ln = opaque_lane();
        f32x4 v[8]; float ss = 0.f;
        const int bt = row_bt(r);
        const f32x4* sh = (const f32x4*)modp(p, l, bt, which ? 3 : 0); const f32x4* sc = (const f32x4*)modp(p, l, bt, which ? 4 : 1); const f32x4* g4 = (const f32x4*)gain;
        f32x4 gs[8], bb[8];
#pragma unroll
        for (int i = 0; i < 8; ++i) v[i] = xr[ln + 64 * i];
        if (addmoe) {
            const f32x4* g2p = (const f32x4*)modp(p, l - 1, bt, 5);
            u32x2 ya[8], yb[8]; f32x4 g2[8];
#pragma unroll
            for (int i = 0; i < 8; ++i) { const int c = ln + 64 * i; ya[i] = *(const u32x2*)(p.YK + (size_t)r * D_MODEL + 4 * c); yb[i] = *(const u32x2*)(p.YK + ((size_t)R_ALL + r) * D_MODEL + 4 * c); g2[i] = g2p[c]; }
#pragma unroll
            for (int i = 0; i < 8; ++i) { const int c = ln + 64 * i; const u32x2 a = ya[i], b = yb[i]; const f32x4 g = g2[i];
                v[i][0] += g[0] * (__uint_as_float(a[0] << 16) + __uint_as_float(b[0] << 16)); v[i][1] += g[1] * (__uint_as_float(a[0] & 0xffff0000u) + __uint_as_float(b[0] & 0xffff0000u));
                v[i][2] += g[2] * (__uint_as_float(a[1] << 16) + __uint_as_float(b[1] << 16)); v[i][3] += g[3] * (__uint_as_float(a[1] & 0xffff0000u) + __uint_as_float(b[1] & 0xffff0000u));
                ((f32x4*)(p.X + (size_t)r * D_MODEL))[c] = v[i]; }
        }
        if (l == 0 && which == 0) {
#pragma unroll
            for (int i = 0; i < 8; ++i) ((f32x4*)(p.X + (size_t)r * D_MODEL))[ln + 64 * i] = v[i]; }
#pragma unroll
        for (int i = 0; i < 8; ++i) { const int c = ln + 64 * i; const f32x4 g = g4[c], s = sc[c]; bb[i] = sh[c];
#pragma unroll
            for (int k = 0; k < 4; ++k) gs[i][k] = g[k] * (1.0f + s[k]); }
#pragma unroll
        for (int i = 0; i < 8; ++i) ss += v[i][0] * v[i][0] + v[i][1] * v[i][1] + v[i][2] * v[i][2] + v[i][3] * v[i][3];
        ss = wave_sum(ss);
        const float rstd = 1.0f / sqrtf(ss / D_MODEL + EPS);
        float lg[N_EXPERTS];
#pragma unroll
        for (int e = 0; e < N_EXPERTS; ++e) lg[e] = 0.f;
#pragma unroll
        for (int i = 0; i < 8; ++i) {
            const int c = ln + 64 * i; f32x4 h;
#pragma unroll
            for (int k = 0; k < 4; ++k) h[k] = v[i][k] * rstd * gs[i][k] + bb[i][k];
            u32x2 pk; pk[0] = pg8::cvt_pk_bf16(h[0], h[1]); pk[1] = pg8::cvt_pk_bf16(h[2], h[3]);
            *(u32x2*)(p.H + (size_t)r * D_MODEL + 4 * c) = pk;
            if (which) {
#pragma unroll
                for (int k = 0; k < 4; ++k) {
#pragma unroll
                    for (int q = 0; q < 4; ++q) { const f32x4 wv = rwl[(k * 4 + q) * (D_MODEL / 4) + c]; lg[4 * q] += h[k] * wv[0]; lg[4 * q + 1] += h[k] * wv[1]; lg[4 * q + 2] += h[k] * wv[2]; lg[4 * q + 3] += h[k] * wv[3]; } }
            }
        }
        if (which) {
#pragma unroll
            for (int e = 0; e < N_EXPERTS; ++e) lg[e] = wave_sum(lg[e]);
            if (ln == 0) { int i1, i2; float s1, s2; route_select(lg, p.router_bias, i1, i2, s1, s2); const float inv = 1.0f / (s1 + s2);
                p.SELI[2 * r] = i1; p.SELI[2 * r + 1] = i2; p.SELW[2 * r] = s1 * inv; p.SELW[2 * r + 1] = s2 * inv;
                unsigned* cnt = p.BAR + CNT_WORD0 + l * N_EXPERTS * 16;
                p.POS[2 * r] = (int)__hip_atomic_fetch_add(cnt + i1 * 16, 1u, __ATOMIC_RELAXED, __HIP_MEMORY_SCOPE_AGENT);
                p.POS[2 * r + 1] = (int)__hip_atomic_fetch_add(cnt + i2 * 16, 1u, __ATOMIC_RELAXED, __HIP_MEMORY_SCOPE_AGENT); }
        }
    }
}

__device__ __forceinline__ float tr16_reduce(const float (&a)[16], int cg) {
    const bool c0 = cg & 1, c1 = cg & 2, c2 = cg & 4, c3 = cg & 8;
    float b[8], c[4], d[2];
#pragma unroll
    for (int j = 0; j < 8; ++j) { const float keep = c0 ? a[2 * j + 1] : a[2 * j], send = c0 ? a[2 * j] : a[2 * j + 1]; b[j] = keep + dpp_mov<0xB1>(send); }
#pragma unroll
    for (int j = 0; j < 4; ++j) { const float keep = c1 ? b[2 * j + 1] : b[2 * j], send = c1 ? b[2 * j] : b[2 * j + 1]; c[j] = keep + dpp_mov<0x4E>(send); }
#pragma unroll
    for (int j = 0; j < 2; ++j) { const float keep = c2 ? c[2 * j + 1] : c[2 * j], send = c2 ? c[2 * j] : c[2 * j + 1];
        const float r4 = dpp_mov<0x124>(send), r12 = dpp_mov<0x12C>(send); d[j] = keep + (c2 ? r4 : r12); }
    const float keep = c3 ? d[1] : d[0], send = c3 ? d[0] : d[1];
    return keep + dpp_mov<0x128>(send);
}

__device__ __forceinline__ void conv_block(const float* __restrict__ W  , int ldw, bool valid, bf16_t* __restrict__ dst  , int ldt) {
#pragma unroll 1
    for (int kc = 0; kc < 4; ++kc) {
        f32x4 v[16];
#pragma unroll
        for (int j = 0; j < 16; ++j) v[j] = valid ? *(const f32x4*)(W + (size_t)(kc * 16 + j) * ldw) : (f32x4){0.f, 0.f, 0.f, 0.f};
#pragma unroll
        for (int e = 0; e < 4; ++e) {
            u32x4 w0, w1;
#pragma unroll
            for (int q = 0; q < 4; ++q) { w0[q] = pg8::cvt_pk_bf16(v[2 * q][e], v[2 * q + 1][e]); w1[q] = pg8::cvt_pk_bf16(v[8 + 2 * q][e], v[9 + 2 * q][e]); }
            u32x4* o = (u32x4*)(dst + (size_t)e * ldt + kc * 16); o[0] = w0; o[1] = w1;
        }
    }
}
__device__ __forceinline__ void conv_dense(int wv, const Ptrs& p, int l, int parts, int wg0, int f0 = 0, int f1 = 1024) {
    const int tid = opaque_tid(wv), lane = tid & 63; const int G = opaque_grid() - wg0, B = opaque_block() - wg0;
    if (B < 0) return;
    constexpr int KT = D_MODEL / 64, NB_IN = ZLD / 256, N_IN = NB_IN * KT, NB_D = D_MODEL / 256, N_BR = 3 * NB_D * (BW / 64), N_OUT = NB_D * KT;
    static_assert(ZLD % 256 == 0 && D_MODEL % 256 == 0 && D_IN % 4 == 0, "conv_dense blocks");
    const int ulo = (parts & 1) ? (int)((long)N_IN * f0 / 1024) : N_IN, uhi = (parts & 2) ? N_IN + N_BR + N_OUT : (int)((long)N_IN * f1 / 1024);
    for (int u = ulo + wv * G + B; u < uhi; u += G * (MEGA_THREADS / 64)) {
        if (u < N_IN) { const int nb = u % NB_IN, kb = u / NB_IN, n = nb * 256 + lane * 4;
            conv_block(p.w_in + ((size_t)l * D_MODEL + kb * 64) * D_IN + n, D_IN, n < D_IN, p.WT_IN + (size_t)n * D_MODEL + kb * 64, D_MODEL); }
        else if (u < N_IN + N_BR) { const int v = u - N_IN, br = v / (NB_D * (BW / 64)), q = v % (NB_D * (BW / 64)), nb = q % NB_D, kb = q / NB_D, n = nb * 256 + lane * 4;
            conv_block(p.w_branch + (((size_t)l * 3 + br) * BW + kb * 64) * D_MODEL + n, D_MODEL, true, p.WT_BR + ((size_t)br * D_MODEL + n) * BW + kb * 64, BW); }
        else { const int v = u - N_IN - N_BR, nb = v % NB_D, kb = v / NB_D, n = nb * 256 + lane * 4;
            conv_block(p.w_out + ((size_t)l * D_MODEL + kb * 64) * D_MODEL + n, D_MODEL, true, p.WT_OUT + (size_t)n * D_MODEL + kb * 64, D_MODEL); }
    }
}
__device__ __forceinline__ void conv_dyn(const Ptrs& p, int l, unsigned* ctr, bool all) {
    constexpr int KT = D_MODEL / 64, NB_IN = ZLD / 256, N_IN = NB_IN * KT, NB_D = D_MODEL / 256, N_BR = 3 * NB_D * (BW / 64), N_OUT = NB_D * KT;
    const int lane = opaque_lane(); const int nu = all ? N_IN + N_BR + N_OUT : N_IN;
    for (;;) {
        int u = 0;
        if (lane == 0) u = (int)__hip_atomic_fetch_add(ctr, 1u, __ATOMIC_RELAXED, __HIP_MEMORY_SCOPE_AGENT);
        u = __builtin_amdgcn_readfirstlane(u);
        if (u >= nu) break;
        if (u < N_IN) { const int nb = u % NB_IN, kb = u / NB_IN, n = nb * 256 + lane * 4;
            conv_block(p.w_in + ((size_t)l * D_MODEL + kb * 64) * D_IN + n, D_IN, n < D_IN, p.WT_IN + (size_t)n * D_MODEL + kb * 64, D_MODEL); }
        else if (u < N_IN + N_BR) { const int v = u - N_IN, br = v / (NB_D * (BW / 64)), q = v % (NB_D * (BW / 64)), nb = q % NB_D, kb = q / NB_D, n = nb * 256 + lane * 4;
            conv_block(p.w_branch + (((size_t)l * 3 + br) * BW + kb * 64) * D_MODEL + n, D_MODEL, true, p.WT_BR + ((size_t)br * D_MODEL + n) * BW + kb * 64, BW); }
        else { const int v = u - N_IN - N_BR, nb = v % NB_D, kb = v / NB_D, n = nb * 256 + lane * 4;
            conv_block(p.w_out + ((size_t)l * D_MODEL + kb * 64) * D_MODEL + n, D_MODEL, true, p.WT_OUT + (size_t)n * D_MODEL + kb * 64, D_MODEL); }
    }
}
__device__ __forceinline__ void conv_moe(int wv, const Ptrs& p, int l, int f0, int f1, int wg0) {
    const int tid = opaque_tid(wv), lane = tid & 63; const int G = opaque_grid() - wg0, B = opaque_block() - wg0;
    if (B < 0) return;
    constexpr int KT = D_MODEL / 64, RT = 2 * D_EXPERT / 256, N_GU = N_EXPERTS * RT * KT, KTD = D_EXPERT / 64, NB_D = D_MODEL / 256, N_D = N_EXPERTS * NB_D * KTD;
    const int ulo = (int)((long)(N_GU + N_D) * f0 / 1024), uhi = (int)((long)(N_GU + N_D) * f1 / 1024);
    for (int u = ulo + wv * G + B; u < uhi; u += G * (MEGA_THREADS / 64)) {
        if (u < N_GU) { const int pn = u % RT, kb = (u / RT) % KT, e = u / (RT * KT);
            const int up = lane >> 5, c0 = pn * 128 + (lane & 31) * 4;
            const float* W = (up ? p.moe_w_up : p.moe_w_gate) + (((size_t)l * N_EXPERTS + e) * D_MODEL + kb * 64) * D_EXPERT + c0;
            conv_block(W, D_EXPERT, true, p.WGU + ((size_t)e * 2 * D_EXPERT + pn * 256 + lane * 4) * D_MODEL + kb * 64, D_MODEL); }
        else { const int v = u - N_GU, nb = v % NB_D, kb = (v / NB_D) % KTD, e = v / (NB_D * KTD), n = nb * 256 + lane * 4;
            conv_block(p.moe_w_down + (((size_t)l * N_EXPERTS + e) * D_EXPERT + kb * 64) * D_MODEL + n, D_MODEL, true, p.WD + ((size_t)e * D_MODEL + n) * D_EXPERT + kb * 64, D_EXPERT); }
    }
}

struct EpiZ {
    static constexpr bool PERM = true, AFTER_DRAIN = false, CARRY = false;
    bf16_t* O;
    __device__ __forceinline__ void operator()(const f32x4 (&acc)[2][2][4][2], const pg8::Unit& u, int wr, int wc, int fr, int fq) const {
        const int row0 = u.pm * 256 + wr * 64 + fr, col0 = u.pn * 256 + wc * 32 + 8 * fq;
#pragma unroll
        for (int ai = 0; ai < 2; ++ai)
#pragma unroll
            for (int m = 0; m < 4; ++m) { bf16_t* rowp = O + (size_t)(row0 + ai * 128 + m * 16) * ZLD + col0;
#pragma unroll
                for (int bj = 0; bj < 2; ++bj) { const f32x4 v0 = acc[ai][bj][m][0], v1 = acc[ai][bj][m][1];
                    u32x4 pk; pk[0] = pg8::cvt_pk_bf16(v0[0], v0[1]); pk[1] = pg8::cvt_pk_bf16(v0[2], v0[3]); pk[2] = pg8::cvt_pk_bf16(v1[0], v1[1]); pk[3] = pg8::cvt_pk_bf16(v1[2], v1[3]);
                    *(u32x4*)(rowp + bj * 128) = pk; } }
    }
};
struct BranchOrder {
    pg8::StaticOrder S; int rt;
    __device__ __forceinline__ bool next(int i, pg8::Unit& u) const { pg8::Unit t; if (!S.next(i / 3, t)) return false; const int br = i % 3; u.pm = br * rt + t.pm; u.pn = br * (D_MODEL / 256) + t.pn; return true; }
    __device__ __forceinline__ void a_ready(const pg8::Unit&) const {}
    __device__ __forceinline__ void done(const pg8::Unit&) const {}
};
template <bool WT  > struct EpiBranch3T {
    static constexpr bool PERM = false, AFTER_DRAIN = false, CARRY = true;
    const bf16_t* Z; bf16_t* MB; int rt;
    __device__ __forceinline__ f32x4 gate4(size_t row, int br, int col) const { const u32x2 gz = *(const u32x2*)(Z + row * ZLD + ZO_GATE + br * D_MODEL + col);
        f32x4 g; g[0] = __uint_as_float(gz[0] << 16); g[1] = __uint_as_float(gz[0] & 0xffff0000u); g[2] = __uint_as_float(gz[1] << 16); g[3] = __uint_as_float(gz[1] & 0xffff0000u); return g; }
    __device__ __forceinline__ void carry(f32x4 (&acc)[2][2][4][2], const pg8::Unit& u, int wr, int wc, int fr, int fq) const {
        const int br = u.pm / rt, brn = br < 2 ? br + 1 : 2;
        const int row0 = (u.pm - br * rt) * 256 + wr * 64 + fr, col0 = (u.pn - br * (D_MODEL / 256)) * 256 + wc * 32 + 4 * fq;
        u32x2 gz[2][2][2][2];
        auto ldg = [&](int g, int buf) { const unsigned rowo = (unsigned)(row0 + (g >> 2) * 128 + (g & 3) * 16) * (unsigned)ZLD + ZO_GATE;
#pragma unroll
            for (int bj = 0; bj < 2; ++bj)
#pragma unroll
                for (int n = 0; n < 2; ++n) { const int col = col0 + bj * 128 + n * 16;
                    gz[buf][bj][n][0] = *(const u32x2*)((const char*)Z + (rowo + (unsigned)(br * D_MODEL + col)) * 2u); gz[buf][bj][n][1] = *(const u32x2*)((const char*)Z + (rowo + (unsigned)(brn * D_MODEL + col)) * 2u); } };
#pragma unroll
        for (int g = 0; g < 8; ++g) { const int ai = g >> 2, m = g & 3; const size_t row = (size_t)(row0 + ai * 128 + m * 16);
            if ((g & 1) == 0) { ldg(g, 0); ldg(g + 1, 1); asm volatile("" ::: "memory"); }
#pragma unroll
            for (int bj = 0; bj < 2; ++bj)
#pragma unroll
                for (int n = 0; n < 2; ++n) { const int col = col0 + bj * 128 + n * 16; const u32x2 za = gz[g & 1][bj][n][0], zb = gz[g & 1][bj][n][1]; f32x4 ga, gb, v;
                    ga[0] = __uint_as_float(za[0] << 16); ga[1] = __uint_as_float(za[0] & 0xffff0000u); ga[2] = __uint_as_float(za[1] << 16); ga[3] = __uint_as_float(za[1] & 0xffff0000u);
                    gb[0] = __uint_as_float(zb[0] << 16); gb[1] = __uint_as_float(zb[0] & 0xffff0000u); gb[2] = __uint_as_float(zb[1] << 16); gb[3] = __uint_as_float(zb[1] & 0xffff0000u);
#pragma unroll
                    for (int k = 0; k < 4; ++k) { const float num = br < 2 ? 1.0f + __expf(-gb[k]) : 1.0f; v[k] = acc[ai][bj][m][n][k] * num * __builtin_amdgcn_rcpf(1.0f + __expf(-ga[k])); }
                    if (br < 2) acc[ai][bj][m][n] = v;
                    else { u32x2 pk; pk[0] = pg8::cvt_pk_bf16(v[0], v[1]); pk[1] = pg8::cvt_pk_bf16(v[2], v[3]);
                        if constexpr (WT) __hip_atomic_store((unsigned long long*)(MB + row * D_MODEL + col), (unsigned long long)pk[0] | ((unsigned long long)pk[1] << 32), __ATOMIC_RELAXED, __HIP_MEMORY_SCOPE_AGENT);
                        else *(u32x2*)(MB + row * D_MODEL + col) = pk;
                        acc[ai][bj][m][n] = (f32x4){0.f, 0.f, 0.f, 0.f}; } }
            if (g & 1) asm volatile("" ::: "memory"); }
    }
    __device__ __forceinline__ void operator()(const f32x4 (&)[2][2][4][2], const pg8::Unit&, int, int, int, int) const {}
};
typedef EpiBranch3T<false> EpiBranch3;
constexpr unsigned CH_SPIN_CAP = 1u << 20;
static_assert(R_ALL / 256 == 36 && D_MODEL / 256 == 8, "chained layer-0 branch / output GEMM orders");
struct BranchOrderL0 {
    int c, rt; unsigned* cnt;
    __device__ __forceinline__ bool next(int i, pg8::Unit& u) const { const int ti = i / 3, br = i - 3 * ti; int pm, pn;
        if (ti == 0) { const int x = c & 7, k = c >> 3; pm = 4 * x + (k & 3); pn = k >> 2; } else if (ti == 1 && c < 32) { pm = 32 + (c >> 3); pn = c & 7; } else return false;
        u.pm = br * rt + pm; u.pn = br * (D_MODEL / 256) + pn; return true; }
    __device__ __forceinline__ void a_ready(const pg8::Unit&) const {}
    __device__ __forceinline__ void done(const pg8::Unit& u) const {
        if (u.pm >= 2 * rt) {
            asm volatile("s_waitcnt vmcnt(0)" ::: "memory");
            if (opaque_lane() == 0) (void)__hip_atomic_fetch_add(cnt + (u.pm - 2 * rt) * 16, 1u, __ATOMIC_RELAXED, __HIP_MEMORY_SCOPE_AGENT); } }
};
struct OutOrderL0 {
    int c; unsigned* cnt;
    __device__ __forceinline__ bool next(int i, pg8::Unit& u) const {
        if (c >= 32) { const int cc = c - 32, x = cc & 7, k = cc >> 3, ux = k + 28 * i; if (i > 1 || ux >= 32) return false; u.pm = 4 * x + (ux & 3); u.pn = ux >> 2; return true; }
        if (i > 0) return false; u.pm = 32 + (c >> 3); u.pn = c & 7; return true; }
    __device__ __forceinline__ void a_ready(const pg8::Unit& u) const {
        unsigned* cp = cnt + u.pm * 16; unsigned sp = 0u;
        for (;;) { unsigned v = 0u; if (opaque_lane() == 0) v = __hip_atomic_load(cp, __ATOMIC_RELAXED, __HIP_MEMORY_SCOPE_AGENT);
            v = (unsigned)__builtin_amdgcn_readfirstlane((int)v); if (v >= 64u) break; __builtin_amdgcn_s_sleep(8); if (++sp > CH_SPIN_CAP) break; }
        __builtin_amdgcn_fence(__ATOMIC_ACQUIRE, "agent");
        asm volatile("s_waitcnt vmcnt(0)" ::: "memory"); }
    __device__ __forceinline__ void done(const pg8::Unit&) const {}
};
struct EpiOut {
    static constexpr bool PERM = false, AFTER_DRAIN = false, CARRY = false;
    float* X; const float* MODL;
    __device__ __forceinline__ void operator()(const f32x4 (&acc)[2][2][4][2], const pg8::Unit& u, int wr, int wc, int fr, int fq) const {
        const int row0 = u.pm * 256 + wr * 64 + fr, col0 = u.pn * 256 + wc * 32 + 4 * fq;
        static_assert(SEQ % 256 == 0 && R_LAT % 256 == 0, "one modulation row per tile");
        const float* g1 = MODL + ((size_t)row_bt(u.pm * 256) * 6 + 2) * D_MODEL;
        f32x4 gv[2][2];
#pragma unroll
        for (int bj = 0; bj < 2; ++bj)
#pragma unroll
            for (int n = 0; n < 2; ++n) gv[bj][n] = *(const f32x4*)(g1 + col0 + bj * 128 + n * 16);
#pragma unroll
        for (int ai = 0; ai < 2; ++ai) {
            f32x4 xv[4][2][2];
#pragma unroll
            for (int mm = 0; mm < 4; ++mm)
#pragma unroll
                for (int bj = 0; bj < 2; ++bj)
#pragma unroll
                    for (int n = 0; n < 2; ++n) xv[mm][bj][n] = *(const f32x4*)(X + (size_t)(row0 + ai * 128 + mm * 16) * D_MODEL + col0 + bj * 128 + n * 16);
#pragma unroll
            for (int mm = 0; mm < 4; ++mm)
#pragma unroll
                for (int bj = 0; bj < 2; ++bj)
#pragma unroll
                    for (int n = 0; n < 2; ++n) *(f32x4*)(X + (size_t)(row0 + ai * 128 + mm * 16) * D_MODEL + col0 + bj * 128 + n * 16) = xv[mm][bj][n] + gv[bj][n] * acc[ai][bj][mm][n];
        }
    }
};


constexpr int RC = 16, RC_NCH = (CTX_LEN + SEQ) / RC, RC_ITERS = RC_NCH / 4;
constexpr int RI_AR = 0, RI_BK = 4096, RI_NN = 8192, RI_GV = 9216, RI_GC = 9728, RI_BYTES = 9984;
constexpr int RS_ROW = 144, RS_BT = 0, RS_KT = 16 * RS_ROW, RS_AT = 32 * RS_ROW, RS_RT = 48 * RS_ROW, RS_MB = 64 * RS_ROW, RS_MK = RS_MB + 1024, RS_BYTES = RS_MK + 1024;
constexpr int RC_SCR0 = 8 * RI_BYTES;
static_assert(RC_SCR0 + 4 * RS_BYTES <= pg8::STAGE_BYTES && RC_NCH % 4 == 0 && CTX_LEN % RC == 0 && SEQ % RC == 0 && RW_HEAD == 64 && MEGA_THREADS == 512, "chunked RWKV scan layout");
#define MFMA16(a, b, c) __builtin_amdgcn_mfma_f32_16x16x32_bf16((a), (b), (c), 0, 0, 0)
struct RcRaw { float dec[RC]; unsigned kk[RC], bb[RC], kd[RC], rs[RC]; };
__device__ __forceinline__ void rc_load(const Ptrs& p, int b, int h, int d, int c, int lane, RcRaw& rw) {
    const size_t od = (size_t)d * R_ALL * RW_W, o0 = (size_t)scan_row(b, d, c * RC) * RW_W + h * RW_HEAD + lane;
    const long dr = d ? -(long)RW_W : (long)RW_W;
    const float* dp = p.DEC + od + o0; const bf16_t *kp = p.KK + o0, *bp = p.BB + od + o0  , *dkp = p.KS + o0  , *rp = p.RS + o0;
#pragma unroll
    for (int s = 0; s < RC; ++s) { rw.dec[s] = dp[s * dr]; rw.kk[s] = kp[s * dr]; rw.bb[s] = bp[s * dr]; rw.kd[s] = dkp[s * dr]; rw.rs[s] = rp[s * dr]; }
}
__device__ __forceinline__ float rc_bf(unsigned v) { return __uint_as_float(v << 16); }
__device__ __forceinline__ void rc_st16(LAS unsigned char* a, float v) { *(LAS unsigned short*)a = (unsigned short)pk2(v, 0.f); }
__device__ __forceinline__ void rc_wave_sync() { __builtin_amdgcn_fence(__ATOMIC_RELEASE, "wavefront"); __builtin_amdgcn_wave_barrier(); __builtin_amdgcn_fence(__ATOMIC_ACQUIRE, "wavefront"); }
__device__ __forceinline__ void rc_stage_a(const RcRaw& rw, float ka, LAS unsigned char* img, LAS unsigned char* sc, int lane, float (&X)[RC]) {
    float g[RC];
    { float a = 1.f;
#pragma unroll
      for (int s = 0; s < RC; ++s) { a *= rw.dec[s]; g[s] = a; } }
    const float gC = g[RC - 1];
    *(LAS float*)(img + RI_GC + lane * 4) = gC;
    const int arw = (lane >> 5) * 1024 + ((lane >> 2) & 3) * 256 + (((lane >> 4) & 1) * 4 + (lane & 3)) * 2;
    unsigned bh[RC / 2], kh[RC / 2]; float bprev = 0.f, kprev = 0.f;
#pragma unroll
    for (int s = 0; s < RC; ++s) {
        const float gp = s ? g[s - 1] : 1.f, ig = __builtin_amdgcn_rcpf(g[s]);
        const float kkf = rc_bf(rw.kk[s]), af = rc_bf(rw.bb[s]);
        const float at = gp * kkf, bt = kkf * af * ig, kt = rc_bf(rw.kd[s]) * (1.0f + (af - 1.0f) * ka) * ig, rt = g[s] * rc_bf(rw.rs[s]);
        X[s] = at;
        rc_st16(sc + RS_BT + s * RS_ROW + lane * 2, bt); rc_st16(sc + RS_KT + s * RS_ROW + lane * 2, kt); rc_st16(sc + RS_AT + s * RS_ROW + lane * 2, at); rc_st16(sc + RS_RT + s * RS_ROW + lane * 2, rt);
        rc_st16(img + RI_AR + 2048 + arw + s * 16, rt);
        const float bhat = gC * bt, khat = gC * kt;
        if (s & 1) { bh[s >> 1] = pk2(-bprev, -bhat); kh[s >> 1] = pk2(kprev, khat); } else { bprev = bhat; kprev = khat; }
    }
#pragma unroll
    for (int gq = 0; gq < 4; ++gq) { u32x4 w; w[0] = bh[2 * gq]; w[1] = bh[2 * gq + 1]; w[2] = kh[2 * gq]; w[3] = kh[2 * gq + 1];
        *(LAS u32x4*)(img + RI_BK + ((lane >> 4) * 64 + (lane & 15) + 16 * gq) * 16) = w; }
}
__device__ __forceinline__ void rc_stage_bc(LAS unsigned char* img, LAS unsigned char* sc, int lane, const float (&X)[RC]) {
    rc_wave_sync();
    const int i = lane & 15, kg = lane >> 4;
    { const LAS unsigned char* rowp = sc + i * RS_ROW + kg * 16;
      const bf16x8 bA0 = *(const LAS bf16x8*)(rowp + RS_BT), bA1 = *(const LAS bf16x8*)(rowp + RS_BT + 64), kA0 = *(const LAS bf16x8*)(rowp + RS_KT), kA1 = *(const LAS bf16x8*)(rowp + RS_KT + 64),
                   aB0 = *(const LAS bf16x8*)(rowp + RS_AT), aB1 = *(const LAS bf16x8*)(rowp + RS_AT + 64), rB0 = *(const LAS bf16x8*)(rowp + RS_RT), rB1 = *(const LAS bf16x8*)(rowp + RS_RT + 64);
      const f32x4 z = {0.f, 0.f, 0.f, 0.f};
      f32x4 Mb = MFMA16(bA0, aB0, z), Mk = MFMA16(kA0, aB0, z), Nb = MFMA16(bA0, rB0, z), Nk = MFMA16(kA0, rB0, z);
      Mb = MFMA16(bA1, aB1, Mb); Mk = MFMA16(kA1, aB1, Mk); Nb = MFMA16(bA1, rB1, Nb); Nk = MFMA16(kA1, rB1, Nk);
#pragma unroll
      for (int e = 0; e < 4; ++e) { const int s = 4 * kg + e; if (!(s < i)) { Mb[e] = 0.f; Mk[e] = 0.f; } if (!(s <= i)) { Nb[e] = 0.f; Nk[e] = 0.f; } }
      u32x4 nn; nn[0] = pk2(-Nb[0], -Nb[1]); nn[1] = pk2(-Nb[2], -Nb[3]); nn[2] = pk2(Nk[0], Nk[1]); nn[3] = pk2(Nk[2], Nk[3]);
      *(LAS u32x4*)(img + RI_NN + lane * 16) = nn;
#pragma unroll
      for (int e = 0; e < 4; ++e) { *(LAS float*)(sc + RS_MB + ((4 * kg + e) * 16 + i) * 4) = Mb[e]; *(LAS float*)(sc + RS_MK + ((4 * kg + e) * 16 + i) * 4) = Mk[e]; }
    }
    rc_wave_sync();
    float X2[RC];
#pragma unroll
    for (int q = 0; q < 4; ++q) { const f32x4 v = *(const LAS f32x4*)(sc + RS_MK + (i * 16 + 4 * q) * 4); X2[4 * q] = v[0]; X2[4 * q + 1] = v[1]; X2[4 * q + 2] = v[2]; X2[4 * q + 3] = v[3]; }
    const int arw = (lane >> 5) * 1024 + ((lane >> 2) & 3) * 256 + (((lane >> 4) & 1) * 4 + (lane & 3)) * 2;
    float x[RC];
#pragma unroll
    for (int t = 0; t < RC; ++t) x[t] = X[t];
#pragma unroll
    for (int s = 0; s < RC; ++s) {
        const float hs = x[s], h2s = X2[s];
        rc_st16(img + RI_AR + arw + s * 16, hs);
        if (lane < 16) rc_st16(img + RI_GV + (s + 16 * (lane >> 2)) * 8 + (lane & 3) * 2, h2s);
#pragma unroll
        for (int q = (s + 1) / 4; q < 4; ++q) { const f32x4 mv = *(const LAS f32x4*)(sc + RS_MB + (s * 16 + 4 * q) * 4);
#pragma unroll
            for (int e = 0; e < 4; ++e) if (4 * q + e > s) { x[4 * q + e] -= hs * mv[e]; X2[4 * q + e] -= h2s * mv[e]; } }
    }
}
__device__ __forceinline__ u32x2 rc_load_v(const Ptrs& p, int b, int h, int d, int c, int col, int g) {
    const bf16_t* vp = p.VS + (size_t)scan_row(b, d, c * RC + 4 * g) * RW_W + h * RW_HEAD + col;
    const long dr = d ? -(long)RW_W : (long)RW_W;
    const unsigned a0 = vp[0], a1 = vp[dr], a2 = vp[2 * dr], a3 = vp[3 * dr];
    u32x2 r; r[0] = a0 | (a1 << 16); r[1] = a2 | (a3 << 16); return r;
}
__device__ __forceinline__ f32x4 rc_consume(f32x4 (&S)[4], const LAS unsigned char* img, int lane, u32x2 vpk) {
    const int g = lane >> 4;
    const bf16x8 sb0 = pack8(S[0][0], S[0][1], S[0][2], S[0][3], S[1][0], S[1][1], S[1][2], S[1][3]), sb1 = pack8(S[2][0], S[2][1], S[2][2], S[2][3], S[3][0], S[3][1], S[3][2], S[3][3]);
    const LAS unsigned char* ar = img + RI_AR + lane * 16;
    f32x4 u = {0.f, 0.f, 0.f, 0.f}, y = {0.f, 0.f, 0.f, 0.f};
    u = MFMA16(*(const LAS bf16x8*)(ar), sb0, u); y = MFMA16(*(const LAS bf16x8*)(ar + 2048), sb0, y);
    u = MFMA16(*(const LAS bf16x8*)(ar + 1024), sb1, u); y = MFMA16(*(const LAS bf16x8*)(ar + 3072), sb1, y);
    const u32x2 gv = *(const LAS u32x2*)(img + RI_GV + lane * 8);
    u32x4 ga, vb; ga[0] = 0u; ga[1] = 0u; ga[2] = gv[0]; ga[3] = gv[1]; vb[0] = 0u; vb[1] = 0u; vb[2] = vpk[0]; vb[3] = vpk[1];
    u = MFMA16(__builtin_bit_cast(bf16x8, ga), __builtin_bit_cast(bf16x8, vb), u);
    u32x4 uvw; uvw[0] = pk2(u[0], u[1]); uvw[1] = pk2(u[2], u[3]); uvw[2] = vpk[0]; uvw[3] = vpk[1];
    const bf16x8 uv = __builtin_bit_cast(bf16x8, uvw);
    y = MFMA16(*(const LAS bf16x8*)(img + RI_NN + lane * 16), uv, y);
#pragma unroll
    for (int tr = 0; tr < 4; ++tr) { const f32x4 gc = *(const LAS f32x4*)(img + RI_GC + (16 * tr + 4 * g) * 4);
        S[tr] = MFMA16(*(const LAS bf16x8*)(img + RI_BK + (tr * 64 + lane) * 16), uv, S[tr] * gc); }
    return y;
}
__device__ __forceinline__ void rwc_chain(int wv, const Ptrs& p, int l, int chain, LAS unsigned char* lds) {
    const int lane = opaque_lane();
    const int d = chain & 1, h = (chain >> 1) % RW_HEADS, b = chain / (2 * RW_HEADS);
    const int w4 = wv & 3;
    __syncthreads();
    if (wv >= 4) {
        LAS unsigned char* sc = lds + RC_SCR0 + w4 * RS_BYTES;
        RcRaw rw;
        const float ka = p.rw_k_a[(size_t)l * RW_W + h * RW_HEAD + lane];
        rc_load(p, b, h, d, w4, lane, rw);
        for (int it = 0; it < RC_ITERS; ++it) {
            LAS unsigned char* img = lds + ((it & 1) * 4 + w4) * RI_BYTES;
            float X[RC];
            rc_stage_a(rw, ka, img, sc, lane, X);
            if (it + 1 < RC_ITERS) rc_load(p, b, h, d, 4 * (it + 1) + w4, lane, rw);
            rc_stage_bc(img, sc, lane, X);
            lds_barrier();
        }
        lds_barrier();
    } else {
        f32x4 S[4]; u32x2 vc[4];
#pragma unroll
        for (int tr = 0; tr < 4; ++tr) S[tr] = (f32x4){0.f, 0.f, 0.f, 0.f};
        const int col = 16 * w4 + (lane & 15), g = lane >> 4;
#pragma unroll
        for (int q = 0; q < 4; ++q) vc[q] = rc_load_v(p, b, h, d, q, col, g);
        lds_barrier();
        for (int it = 0; it < RC_ITERS; ++it) {
            u32x2 vn[4];
            if (it + 1 < RC_ITERS) {
#pragma unroll
                for (int q = 0; q < 4; ++q) vn[q] = rc_load_v(p, b, h, d, 4 * (it + 1) + q, col, g); }
#pragma unroll
            for (int q = 0; q < 4; ++q) { const int c = 4 * it + q;
                const f32x4 y = rc_consume(S, lds + ((it & 1) * 4 + q) * RI_BYTES, lane, vc[q]);
                bf16_t* yp = p.RY + (size_t)d * R_ALL * RW_W + (size_t)scan_row(b, d, c * RC + 4 * g) * RW_W + h * RW_HEAD + col;
                const long dr = d ? -(long)RW_W : (long)RW_W;
#pragma unroll
                for (int e = 0; e < 4; ++e) yp[e * dr] = (bf16_t)pk2(y[e], 0.f); }
            if (it + 1 < RC_ITERS) {
#pragma unroll
                for (int q = 0; q < 4; ++q) vc[q] = vn[q]; }
            lds_barrier();
        }
    }
}

__device__ __forceinline__ void moe_gather(int wv, const Ptrs& p, int l, int ro, int* so  , bool copy  ) {
    const int tid = opaque_tid(wv), lane = tid & 63, w = tid >> 6;
    const unsigned* cnt = p.BAR + CNT_WORD0 + l * N_EXPERTS * 16;
    __syncthreads();
    if (tid == 0) { int o = 0; for (int e = 0; e < N_EXPERTS; ++e) { so[e] = o; const int c = (int)__hip_atomic_load(cnt + e * 16, __ATOMIC_RELAXED, __HIP_MEMORY_SCOPE_AGENT); so[32 + e] = c; o += (c + 255) & ~255; } so[N_EXPERTS] = o; }
    __syncthreads();
    const int ntiles = so[N_EXPERTS] / 256;
    if (opaque_block() == 0) {
        for (int t = tid; t < ntiles; t += MEGA_THREADS) { int e = 0; for (int q = 1; q < N_EXPERTS; ++q) if (so[q] <= t * 256) e = q; p.TILE_E[t] = e; }
        if (tid == 0) p.TILE_E[MOE_TILES] = ntiles;
    }
    if (opaque_block() < N_EXPERTS) { const int e = opaque_block(); for (int rr = so[e] + so[32 + e] + tid; rr < so[e + 1]; rr += MEGA_THREADS) { p.ROWTOK[rr] = -1; p.ROWW[rr] = 0.f; } }
    const int G = opaque_grid(), B = opaque_block();
    for (int it = w * G + B; it < ro * 2; it += G * (MEGA_THREADS / 64)) {
        const int e = p.SELI[it], dst = so[e] + p.POS[it];
        if (copy) { const u32x4* src = (const u32x4*)(p.H + (size_t)(it >> 1) * D_MODEL); u32x4* d = (u32x4*)(p.HS + (size_t)dst * D_MODEL);
#pragma unroll
            for (int i = 0; i < 4; ++i) d[lane + 64 * i] = src[lane + 64 * i]; }
        if (lane == 0) { p.ROWTOK[dst] = it; p.ROWW[dst] = p.SELW[it]; }
    }
}
struct MoeOrder {
    int ntiles, nN, G, c; const int* tile_e;
    __device__ __forceinline__ bool next(int i, pg8::Unit& u) const { const long L = (long)i * G + c; if (L >= (long)ntiles * nN) return false; const int t = (int)(L / nN); u.pm = t; u.pn = tile_e[t] * nN + (int)(L % nN); return true; }
    __device__ __forceinline__ void a_ready(const pg8::Unit&) const {}
    __device__ __forceinline__ void done(const pg8::Unit&) const {}
};
template <bool WT  > struct EpiMoeUpT {
    static constexpr bool PERM = true, AFTER_DRAIN = false, CARRY = false;
    bf16_t* ACTB; const float* ROWW;
    __device__ __forceinline__ void operator()(const f32x4 (&acc)[2][2][4][2], const pg8::Unit& u, int wr, int wc, int fr, int fq) const {
        const int row0 = u.pm * 256 + wr * 64 + fr, col0 = (u.pn & 3) * 128 + wc * 32 + 8 * fq;
        static_assert(2 * D_EXPERT / 256 == 4, "EpiMoeUp column tiles");
        float rw8[2][4];
#pragma unroll
        for (int ai = 0; ai < 2; ++ai)
#pragma unroll
            for (int m = 0; m < 4; ++m) rw8[ai][m] = ROWW[row0 + ai * 128 + m * 16];
#pragma unroll
        for (int ai = 0; ai < 2; ++ai)
#pragma unroll
            for (int m = 0; m < 4; ++m) { const int row = row0 + ai * 128 + m * 16; const float w = rw8[ai][m];
                float a[8];
#pragma unroll
                for (int n = 0; n < 2; ++n)
#pragma unroll
                    for (int k = 0; k < 4; ++k) { const float g = acc[ai][0][m][n][k], uu = acc[ai][1][m][n][k]; a[4 * n + k] = g / (1.0f + __expf(-g)) * uu * w; }
                u32x4 pk; pk[0] = pg8::cvt_pk_bf16(a[0], a[1]); pk[1] = pg8::cvt_pk_bf16(a[2], a[3]); pk[2] = pg8::cvt_pk_bf16(a[4], a[5]); pk[3] = pg8::cvt_pk_bf16(a[6], a[7]);
                if constexpr (WT) { unsigned long long* dq = (unsigned long long*)(ACTB + (size_t)row * D_EXPERT + col0);
                    __hip_atomic_store(dq, (unsigned long long)pk[0] | ((unsigned long long)pk[1] << 32), __ATOMIC_RELAXED, __HIP_MEMORY_SCOPE_AGENT);
                    __hip_atomic_store(dq + 1, (unsigned long long)pk[2] | ((unsigned long long)pk[3] << 32), __ATOMIC_RELAXED, __HIP_MEMORY_SCOPE_AGENT); }
                else *(u32x4*)(ACTB + (size_t)row * D_EXPERT + col0) = pk; }
    }
};
typedef EpiMoeUpT<false> EpiMoeUp;
struct EpiMoeDown {
    static constexpr bool PERM = true, AFTER_DRAIN = false, CARRY = false;
    bf16_t* YK; const int* ROWTOK;
    __device__ __forceinline__ void operator()(const f32x4 (&acc)[2][2][4][2], const pg8::Unit& u, int wr, int wc, int fr, int fq) const {
        static_assert(D_MODEL / 256 == 8, "EpiMoeDown column tiles");
        const int row0 = u.pm * 256 + wr * 64 + fr, col0 = (u.pn & 7) * 256 + wc * 32 + 8 * fq;
        int tk[2][4];
#pragma unroll
        for (int ai = 0; ai < 2; ++ai)
#pragma unroll
            for (int m = 0; m < 4; ++m) tk[ai][m] = ROWTOK[row0 + ai * 128 + m * 16];
#pragma unroll
        for (int ai = 0; ai < 2; ++ai)
#pragma unroll
            for (int m = 0; m < 4; ++m) { const int tok = tk[ai][m];
                if (tok >= 0) { bf16_t* rowp = YK + ((size_t)(tok & 1) * R_ALL + (tok >> 1)) * D_MODEL + col0;
#pragma unroll
                    for (int bj = 0; bj < 2; ++bj) { const f32x4 v0 = acc[ai][bj][m][0], v1 = acc[ai][bj][m][1];
                        u32x4 pk; pk[0] = pg8::cvt_pk_bf16(v0[0], v0[1]); pk[1] = pg8::cvt_pk_bf16(v0[2], v0[3]); pk[2] = pg8::cvt_pk_bf16(v1[0], v1[1]); pk[3] = pg8::cvt_pk_bf16(v1[2], v1[3]);
                        *(u32x4*)(rowp + bj * 128) = pk; } } }
    }
};
template <class Epi> __device__ __forceinline__ void moe_gemm_call(int wv, LAS unsigned char* lds, const Ptrs& p, const bf16_t* A, const bf16_t* Bt, int nN, int K, const Epi& E) {
    pg8::Gemm g{A, Bt, 0, 0, K}; MoeOrder S{p.TILE_E[MOE_TILES], nN, opaque_grid(), opaque_block(), p.TILE_E};
    pg8::gemm_phase<Epi, MoeOrder, true, true>(lds, g, S, E, wv);
}
__device__ __forceinline__ void final_out(int wv, const Ptrs& p) {
    const int tid = opaque_tid(wv);
    const size_t n4 = (size_t)R_LAT * D_MODEL / 4;
    const int G = opaque_grid(), B = opaque_block();
    for (size_t i = (size_t)B * MEGA_THREADS + tid; i < n4; i += (size_t)G * MEGA_THREADS) {
        const int r = (int)(i / (D_MODEL / 4)), c = (int)(i % (D_MODEL / 4));
        const f32x4 g = ((const f32x4*)modp(p, DEPTH - 1, row_bt(r), 5))[c]; f32x4 v = ((const f32x4*)p.X)[i];
        const u32x2 a = *(const u32x2*)(p.YK + i * 4), b = *(const u32x2*)(p.YK + (size_t)R_ALL * D_MODEL + i * 4);
        v[0] += g[0] * (__uint_as_float(a[0] << 16) + __uint_as_float(b[0] << 16)); v[1] += g[1] * (__uint_as_float(a[0] & 0xffff0000u) + __uint_as_float(b[0] & 0xffff0000u));
        v[2] += g[2] * (__uint_as_float(a[1] << 16) + __uint_as_float(b[1] << 16)); v[3] += g[3] * (__uint_as_float(a[1] & 0xffff0000u) + __uint_as_float(b[1] & 0xffff0000u));
        ((f32x4*)p.out)[i] = v;
    }
}

template <class Epi, bool ALIGN = true> __device__ __forceinline__ void gemm_call(int wv, LAS unsigned char* lds, const bf16_t* A, const bf16_t* Bt, int M, int N, int K, const Epi& E, int wg0 = 0) {
    const int Bq = opaque_block(); if (Bq < wg0) return;
    pg8::Gemm g{A, Bt, M, N, K}; pg8::StaticOrder S; S.init(M, N, opaque_grid() - wg0, Bq - wg0);
    pg8::gemm_phase<Epi, pg8::StaticOrder, ALIGN, true>(lds, g, S, E, wv);
}

__global__ void __launch_bounds__(MEGA_THREADS, 2) mega_fwd(Ptrs p) {
    extern __shared__ __attribute__((aligned(16))) unsigned char smem[];
    LAS unsigned char* lds = (LAS unsigned char*)smem;
    volatile LAS unsigned* stw = (volatile LAS unsigned*)(lds + pg8::STAGE_BYTES);
    const int wv = __builtin_amdgcn_readfirstlane(threadIdx.x >> 6);
    if (threadIdx.x < 4) stw[threadIdx.x] = 0u;
    __syncthreads();
    const XcdBarrier bar = xcd_barrier_post(p.BAR, stw);
#define GRID_SYNC() xcd_barrier(bar)
#if PROBE_SET
    unsigned long long pr_t0 = 0;
#define PB(g) do { if ((PROBE_SET >> (g)) & 1) pr_t0 = __builtin_amdgcn_s_memrealtime(); } while (0)
#define PE(g) do { if ((PROBE_SET >> (g)) & 1) { const unsigned long long pr_t1 = __builtin_amdgcn_s_memrealtime(); while (__builtin_amdgcn_s_memrealtime() - pr_t1 < pr_t1 - pr_t0) __builtin_amdgcn_s_sleep(8); } } while (0)
#else
#define PB(g) do {} while (0)
#define PE(g) do {} while (0)
#endif

    PB(0); { mod_phase(wv, p, lds); }
    { run_items(wv, FRope{p}, (long)GRID_W * (GLA_DK / 4)); } PE(0);
#pragma unroll
    for (int l = 0; l < DEPTH; ++l) {
        const int ro = rows_out(l);
        PB(1); { conv_dense(wv, p, l, 3, 0, l == 0 ? 0 : CONV_EARLY); }
        { run_items(wv, FRwWt{p, l}, (long)RWP_ITEMS); } PE(1);
        if (l == 0) GRID_SYNC();
        PB(2); { norm_rows(wv, p, l, 0, R_ALL, l > 0, lds); } PE(2);
        GRID_SYNC();
        PB(3); { gemm_call<EpiZ, false>(wv, lds, p.H, p.WT_IN, R_ALL, ZLD, D_MODEL, EpiZ{p.Z}); } PE(3);
        GRID_SYNC();
        PB(4); PB(20); { prep_rows(wv, p, l, lds); } PE(20); PB(21);
        { run_items(wv, FVt{p, p.VTG, ZO_GV, GLA_HEADS, GLA_DV}, (long)BATCH * (GLA_V / 4) * (T_ALL / 8)); } PE(21); PE(4);
        GRID_SYNC();
        PB(5); PB(17); { run_items(wv, FGlaChunk{p}, (long)2 * BATCH * GLA_NCH * (GLA_QK / 4) * 8); } PE(17);
        PB(16); {
#pragma unroll 1
            for (int pl = 0; pl < 5; ++pl) {
                const int G = opaque_grid(), rot = ((pl * (R_ALL / 256) * (RW_W / 256)) % G) & ~7;
                pg8::Gemm gq{p.LOW + (size_t)R_ALL * 128 * pl, p.WT_RW + (size_t)RW_W * 128 * pl, R_ALL, RW_W, pl < 4 ? 128 : 256}; pg8::StaticOrder S; S.init(R_ALL, RW_W, G, (opaque_block() + G - rot) % G);
                pg8::gemm_phase<EpiRw, pg8::StaticOrder, true, true>(lds, gq, S, EpiRw{p.DEC, p.BB, p.G, p.rw_w0 + (size_t)l * 2 * RW_W, p.rw_a0 + (size_t)l * 2 * RW_W, pl, 0}, wv); } } PE(16); PE(5);
        GRID_SYNC();
        PB(6); PB(13); { for (int ch = opaque_block(); ch < BATCH * RW_HEADS * 2; ch += opaque_grid()) rwc_chain(wv, p, l, ch, lds); } PE(13);
        const bool wide = opaque_grid() >= 256;
        PB(14); { gla_phase(wv, p, lds, wide ? 128 : 0); } PE(14);
        PB(15); { na_phase(wv, p, l, lds, NA_LAT_UNITS + (l < DEPTH - 1 ? NA_CTX_UNITS : 0), p.BAR + NA_CTR_WORD0 + l * 16, (wide && opaque_block() < 192) ? 4 : 8); } PE(15);
        if (l + 1 < DEPTH) { conv_dyn(p, l + 1, p.BAR + NA_CTR_WORD0 + 32 + l * 16, false); } PE(6);
        GRID_SYNC();
        PB(7); { finish_rows(wv, p, l, ro); } PE(7);
        GRID_SYNC();
        PB(8);
        if (l == 0 && opaque_grid() == 256) {
            unsigned* chc = p.BAR + CH_WORD0 + 4096;
            { pg8::Gemm gq{p.Y3, p.WT_BR, 0, 0, BW}; BranchOrderL0 S{opaque_block(), R_ALL / 256, chc};
              pg8::gemm_phase<EpiBranch3T<true>, BranchOrderL0, true, true>(lds, gq, S, EpiBranch3T<true>{p.Z, p.MB, R_ALL / 256}, wv); }
            { pg8::Gemm gq{p.MB, p.WT_OUT, ro, D_MODEL, D_MODEL}; OutOrderL0 S{opaque_block(), chc};
              pg8::gemm_phase<EpiOut, OutOrderL0, true, true>(lds, gq, S, EpiOut{p.X, p.MOD + (size_t)l * NMOD * D6}, wv); }
            { conv_moe(wv, p, l, 0, 1024, 64); }
        } else {
            { pg8::Gemm gq{p.Y3, p.WT_BR, 0, 0, BW}; BranchOrder S; S.S.init(ro, D_MODEL, opaque_grid(), opaque_block()); S.rt = R_ALL / 256;
              pg8::gemm_phase<EpiBranch3, BranchOrder, true, true>(lds, gq, S, EpiBranch3{p.Z, p.MB, R_ALL / 256}, wv); }
            GRID_SYNC();
            { gemm_call(wv, lds, p.MB, p.WT_OUT, ro, D_MODEL, D_MODEL, EpiOut{p.X, p.MOD + (size_t)l * NMOD * D6}); }
        }
        PE(8);
        GRID_SYNC();
        PB(9); PB(18); { norm_rows(wv, p, l, 1, ro, false, lds); } PE(18);
        PB(19); { if (!(l == 0 && opaque_grid() == 256)) conv_moe(wv, p, l, 0, 1024, 0); } PE(19); PE(9);
        GRID_SYNC();
        const bool gath = opaque_grid() * 2 >= MOE_TILES * 4;
        PB(10); { moe_gather(wv, p, l, ro, (int*)smem, !gath); } PE(10);
        GRID_SYNC();
        PB(11); { if (gath) { pg8::Gemm gq{p.H, p.WGU, 0, 0, D_MODEL}; MoeOrder S{p.TILE_E[MOE_TILES], 4, opaque_grid(), opaque_block(), p.TILE_E};
                      pg8::gemm_phase<EpiMoeUp, MoeOrder, true, true, true>(lds, gq, S, EpiMoeUp{p.ACTB, p.ROWW}, wv, p.ROWTOK); }
                  else moe_gemm_call(wv, lds, p, p.HS, p.WGU, 4, D_MODEL, EpiMoeUp{p.ACTB, p.ROWW}); } PE(11);
        GRID_SYNC();
        PB(11); { moe_gemm_call(wv, lds, p, p.ACTB, p.WD, 8, D_EXPERT, EpiMoeDown{p.YK, p.ROWTOK}); } PE(11);
        GRID_SYNC();
    }
    PB(12); { final_out(wv, p); } PE(12);
#undef GRID_SYNC
}

extern "C" void kernel_launch(void* const* d_in, const int* in_sizes, int n_in, void* d_out, int out_size, void* d_ws, size_t ws_size, hipStream_t stream) {
    static int grid = 0;
    Ptrs p{};
    fill_inputs(p, d_in);
    p.out = (float*)d_out;
    const size_t need = ws_carve(p, (char*)d_ws);
    if (grid == 0) {
        if (need > ws_size || n_in != 33) { fprintf(stderr, "kernel_launch: workspace %zu < %zu or n_in %d != 33; nothing launched\n", ws_size, need, n_in); grid = -1; return; }
        int dev = 0, cus = 0, per_cu = 0;
        if (hipGetDevice(&dev) != hipSuccess || hipDeviceGetAttribute(&cus, hipDeviceAttributeMultiprocessorCount, dev) != hipSuccess) { grid = -1; return; }
        if (hipFuncSetAttribute((const void*)mega_fwd, hipFuncAttributeMaxDynamicSharedMemorySize, LDS_BYTES) != hipSuccess) { fprintf(stderr, "kernel_launch: hipFuncSetAttribute failed\n"); grid = -1; return; }
        if (hipOccupancyMaxActiveBlocksPerMultiprocessor(&per_cu, (const void*)mega_fwd, MEGA_THREADS, LDS_BYTES) != hipSuccess || per_cu < 1) { fprintf(stderr, "kernel_launch: occupancy query says %d blocks per CU; nothing launched\n", per_cu); (void)hipGetLastError(); grid = -1; return; }
        grid = cus;
    }
    if (grid < 0) return;
    (void)hipMemsetAsync(p.BAR, 0, BAR_BYTES, stream);
    hipLaunchKernelGGL(mega_fwd, dim3(grid), dim3(MEGA_THREADS), LDS_BYTES, stream, p);
}
#endif
```
